# Optimizing an MI355X kernel written in HIP

```python
import math
import jax, jax.numpy as jnp
from jax import lax
import numpy as np

D_MODEL = 4096
BATCH = 32
SEQ = 256
DEPTH = 1
DEC_BATCH = 4
DEC_SEQ = 1024
PAST_LEN = 256

GRID_W = 64
N_HEADS = D_MODEL // 512
QK_DIM = 128
V_DIM = 2 * QK_DIM
D_ATT = N_HEADS * V_DIM
D_CONV = D_MODEL - D_ATT
D_MIX = D_ATT + D_CONV
PROJ_W = 3 * D_ATT + 3 * D_CONV
CONV_K = 3
D_FF = 4 * D_MODEL
N_MOD = 6
ROPE_AXIS_DIM = QK_DIM // 2
ROPE_THETA = 10000.0
Q_BLOCK = 128
EPS = 1e-6

kernel_name = 'hybrid_diffattn_shortconv_dit_step'


def rmsnorm(x, g):
    xf = x.astype(jnp.float32)
    y = xf * lax.rsqrt(jnp.mean(xf * xf, axis=-1, keepdims=True) + EPS)
    return (y * g.astype(jnp.float32)).astype(x.dtype)


def axial_angles(n_tokens):
    rows = n_tokens // GRID_W
    row = jnp.repeat(jnp.arange(rows, dtype=jnp.float32), GRID_W)
    col = jnp.tile(jnp.arange(GRID_W, dtype=jnp.float32), rows)
    inv = jnp.power(ROPE_THETA, -jnp.arange(0, ROPE_AXIS_DIM, 2, dtype=jnp.float32) / ROPE_AXIS_DIM)
    return row[:, None] * inv, col[:, None] * inv


def rotate_axis(xp, ang):
    cos = jnp.cos(ang)[:, None, None, :].astype(xp.dtype)
    sin = jnp.sin(ang)[:, None, None, :].astype(xp.dtype)
    x1, x2 = jnp.split(xp, 2, axis=-1)
    return jnp.concatenate([x1 * cos - x2 * sin, x1 * sin + x2 * cos], axis=-1)


def apply_axial_rope(x, row_ang, col_ang):
    return jnp.concatenate([rotate_axis(x[..., :ROPE_AXIS_DIM], row_ang),
                            rotate_axis(x[..., ROPE_AXIS_DIM:], col_ang)], axis=-1)


def modulation(cond, w_ada, b_ada):
    s = jax.nn.silu(cond) @ w_ada + b_ada
    return s.reshape(cond.shape[:-1] + (N_MOD, D_MODEL))


def project_heads(h, w_in, q_norm_g, k_norm_g):
    b, s, _ = h.shape
    proj = h @ w_in
    cuts = [D_ATT, 2 * D_ATT, 3 * D_ATT, 3 * D_ATT + D_CONV, 3 * D_ATT + 2 * D_CONV]
    q, k, v, b_gate, c_gate, u = jnp.split(proj, cuts, axis=-1)
    q = rmsnorm(q.reshape(b, s, N_HEADS, 2, QK_DIM), q_norm_g)
    k = rmsnorm(k.reshape(b, s, N_HEADS, 2, QK_DIM), k_norm_g)
    v = v.reshape(b, s, N_HEADS, V_DIM)
    return q, k, v, b_gate, c_gate, u


def short_conv(b_gate, c_gate, u, conv_w):
    z = c_gate * u
    zp = jnp.pad(z, ((0, 0), (1, 1), (0, 0)))
    y = conv_w[0] * zp[:, :-2] + conv_w[1] * zp[:, 1:-1] + conv_w[2] * zp[:, 2:]
    return b_gate * y


def diff_attention(q, k, v, lam, lam_init, subln_g):
    b, sq = q.shape[0], q.shape[1]
    nb = sq // Q_BLOCK
    qb = q.reshape(b, nb, Q_BLOCK, N_HEADS, 2, QK_DIM).swapaxes(0, 1)
    scale = QK_DIM ** -0.5

    def block(qi):
        s = jnp.einsum('bqhcd,bkhcd->bchqk', qi, k).astype(jnp.float32) * scale
        p = jax.nn.softmax(s, axis=-1)
        a = (p[:, 0] - lam * p[:, 1]).astype(v.dtype)
        return jnp.einsum('bhqk,bkhe->bqhe', a, v)

    o = lax.map(block, qb)
    o = o.swapaxes(0, 1).reshape(b, sq, N_HEADS, V_DIM)
    o = rmsnorm(o, subln_g) * (1.0 - lam_init)
    return o.reshape(b, sq, D_ATT)


def trunk_layer(x, mod, cached_k, cached_v, is_latent, layer_idx,
                norm_attn_g, w_in, q_norm_g, k_norm_g, lam_q1, lam_k1, lam_q2, lam_k2,
                subln_g, conv_w, w_out, norm_mlp_g, w_mlp_in, w_mlp_out):
    shift1, scale1, gate1, shift2, scale2, gate2 = [mod[:, None, i] for i in range(N_MOD)]
    h = rmsnorm(x, norm_attn_g) * (1.0 + scale1) + shift1
    q, k, v, b_gate, c_gate, u = project_heads(h, w_in, q_norm_g, k_norm_g)
    lam_init = 0.8 - 0.6 * math.exp(-0.3 * layer_idx)
    f32 = jnp.float32
    lam = (jnp.exp(jnp.sum(lam_q1.astype(f32) * lam_k1.astype(f32)))
           - jnp.exp(jnp.sum(lam_q2.astype(f32) * lam_k2.astype(f32))) + lam_init)
    if is_latent:
        row_ang, col_ang = axial_angles(x.shape[1])
        q = apply_axial_rope(q, row_ang, col_ang)
        k = apply_axial_rope(k, row_ang, col_ang)
        keys = jnp.concatenate([k, cached_k], axis=1)
        vals = jnp.concatenate([v, cached_v], axis=1)
    else:
        keys, vals = k, v
    attn = diff_attention(q, keys, vals, lam, lam_init, subln_g)
    conv = short_conv(b_gate, c_gate, u, conv_w)
    x = x + gate1 * (jnp.concatenate([attn, conv], axis=-1) @ w_out)
    h2 = rmsnorm(x, norm_mlp_g) * (1.0 + scale2) + shift2
    x = x + gate2 * (jnp.square(jax.nn.relu(h2 @ w_mlp_in)) @ w_mlp_out)
    return x, k, v


def setup_inputs(seed: int = 0) -> dict:
    key = jax.random.key(seed)
    ks = jax.random.split(key, 24)
    f32 = jnp.float32
    nrm = lambda k, shp, s: jax.random.normal(k, shp, f32) * s
    return {
        'x_prompt': nrm(ks[0], (BATCH, SEQ, D_MODEL), 1.0),
        'x_sample': nrm(ks[1], (DEC_BATCH, DEC_SEQ, D_MODEL), 1.0),
        'cache_k': nrm(ks[2], (DEC_BATCH, DEPTH, PAST_LEN, N_HEADS, 2, QK_DIM), 1.0),
        'cache_v': nrm(ks[3], (DEC_BATCH, DEPTH, PAST_LEN, N_HEADS, V_DIM), 1.0),
        'c': nrm(ks[4], (DEC_BATCH, D_MODEL), 1.0),
        'c_ctx': nrm(ks[5], (D_MODEL,), 1.0),
        'w_ada': nrm(ks[6], (DEPTH, D_MODEL, N_MOD * D_MODEL), D_MODEL ** -0.5),
        'b_ada': nrm(ks[7], (DEPTH, N_MOD * D_MODEL), 0.01),
        'norm_attn_g': 1.0 + nrm(ks[8], (DEPTH, D_MODEL), 0.02),
        'w_in': nrm(ks[9], (DEPTH, D_MODEL, PROJ_W), D_MODEL ** -0.5),
        'q_norm_g': 1.0 + nrm(ks[10], (DEPTH, QK_DIM), 0.02),
        'k_norm_g': 1.0 + nrm(ks[11], (DEPTH, QK_DIM), 0.02),
        'lambda_q1': nrm(ks[12], (DEPTH, QK_DIM), 0.1),
        'lambda_k1': nrm(ks[13], (DEPTH, QK_DIM), 0.1),
        'lambda_q2': nrm(ks[14], (DEPTH, QK_DIM), 0.1),
        'lambda_k2': nrm(ks[15], (DEPTH, QK_DIM), 0.1),
        'subln_g': 1.0 + nrm(ks[16], (DEPTH, V_DIM), 0.02),
        'conv_w': nrm(ks[17], (DEPTH, CONV_K, D_CONV), CONV_K ** -0.5),
        'w_out': nrm(ks[18], (DEPTH, D_MIX, D_MODEL), D_MIX ** -0.5),
        'norm_mlp_g': 1.0 + nrm(ks[19], (DEPTH, D_MODEL), 0.02),
        'w_mlp_in': nrm(ks[20], (DEPTH, D_MODEL, D_FF), D_MODEL ** -0.5),
        'w_mlp_out': nrm(ks[21], (DEPTH, D_FF, D_MODEL), D_FF ** -0.5),
    }


def reference(x_prompt, x_sample, cache_k, cache_v, c, c_ctx, w_ada, b_ada, norm_attn_g, w_in,
              q_norm_g, k_norm_g, lambda_q1, lambda_k1, lambda_q2, lambda_k2, subln_g, conv_w,
              w_out, norm_mlp_g, w_mlp_in, w_mlp_out):
    y_p = x_prompt
    y_s = x_sample
    ctx_keys = []
    ctx_vals = []
    for l in range(DEPTH):
        layer_w = (norm_attn_g[l], w_in[l], q_norm_g[l], k_norm_g[l], lambda_q1[l], lambda_k1[l],
                   lambda_q2[l], lambda_k2[l], subln_g[l], conv_w[l], w_out[l], norm_mlp_g[l],
                   w_mlp_in[l], w_mlp_out[l])
        mod_ctx = modulation(c_ctx[None], w_ada[l], b_ada[l])
        y_p, k_l, v_l = trunk_layer(y_p, mod_ctx, None, None, False, l, *layer_w)
        ctx_keys.append(k_l)
        ctx_vals.append(v_l)
        mod_lat = modulation(c, w_ada[l], b_ada[l])
        y_s, _, _ = trunk_layer(y_s, mod_lat, cache_k[:, l], cache_v[:, l], True, l, *layer_w)
    new_k = jnp.stack(ctx_keys, axis=1)
    new_v = jnp.stack(ctx_vals, axis=1)
    return (y_p, y_s, new_k, new_v)
```

```cpp
#include <hip/hip_runtime.h>
#include <cstdio>
#include <cstdint>

#ifndef MK_N_LAUNCHES
#define MK_N_LAUNCHES 1
#endif

namespace pg8 {
#define PG8_LAS __attribute__((address_space(3)))
typedef unsigned short bf16_t;
typedef short bf16x8 __attribute__((ext_vector_type(8)));
typedef float f32x4 __attribute__((ext_vector_type(4)));
typedef unsigned u32x4 __attribute__((ext_vector_type(4)));
constexpr int BM = 256, BK = 64, HALF = 128, HTB = HALF * BK * 2  , STAGE_BYTES = 8 * HTB, NXCD = 8, WGM = 8;

__host__ __device__ __forceinline__ int lds_byte(int r, int c) { const int st = (r >> 4) * 2 + (c >> 5), rr = r & 15, cc = c & 31, ob = rr * 64 + cc * 2; return st * 1024 + (ob ^ (((ob >> 9) & 1) << 5)); }
__host__ __device__ __forceinline__ void stage_rc(int b, int& R, int& C) { const int st = b / 1024, sb = b % 1024, swz = sb ^ (((sb >> 9) & 1) << 5); R = (st >> 1) * 16 + swz / 64; C = (st & 1) * 32 + (swz % 64) / 2; }
__host__ __device__ __forceinline__ int perm32(int rho) { const int n = rho >> 4, i = rho & 15; return 8 * (i >> 2) + 4 * n + (i & 3); }

struct Unit { int pm, pn; };
struct Gemm { const bf16_t* A; const bf16_t* Bt; int M, N, K, lda, ldb; };

struct StaticOrder {
    int nM, nN, nwg, G, c;
    __host__ __device__ void init(int M, int N, int G_, int c_) { nM = M / BM; nN = N / BM; nwg = nM * nN; G = G_; c = c_; }
    __host__ __device__ bool next(int i, Unit& u) const {
        const long L = (long)i * G + c; if (L >= nwg) return false;
        int wgid = (int)L; { const int q = nwg / NXCD, r = nwg % NXCD, xcd = wgid % NXCD, off = wgid / NXCD; wgid = (xcd < r ? xcd * (q + 1) : r * (q + 1) + (xcd - r) * q) + off; }
        const int nig = WGM * nN, gid = wgid / nig, fm = gid * WGM, gsz = (nM - fm) < WGM ? (nM - fm) : WGM;
        u.pm = fm + ((wgid % nig) % gsz); u.pn = (wgid % nig) / gsz; return true;
    }
    __device__ __forceinline__ void a_ready(const Unit&) const {}
    __device__ __forceinline__ void done(const Unit&) const {}
};

__device__ __forceinline__ unsigned cvt_pk_bf16(float lo, float hi) { unsigned r; asm volatile("v_cvt_pk_bf16_f32 %0, %1, %2" : "=v"(r) : "v"(lo), "v"(hi)); return r; }

template <int ACT  > struct EpiBf16 {
    static constexpr bool PERM = true, AFTER_DRAIN = false;
    bf16_t* O; int ldc;
    __device__ __forceinline__ void operator()(const f32x4 (&acc)[2][2][4][2], const Unit& u, int wr, int wc, int fr, int fq) const {
        const int row0 = u.pm * BM + wr * 64 + fr; const int col0 = u.pn * BM + wc * 32 + 8 * fq;
#pragma unroll
        for (int ai = 0; ai < 2; ++ai)
#pragma unroll
            for (int m = 0; m < 4; ++m) { bf16_t* rowp = O + (size_t)(row0 + ai * HALF + m * 16) * ldc + col0;
#pragma unroll
                for (int bj = 0; bj < 2; ++bj) { f32x4 v0 = acc[ai][bj][m][0], v1 = acc[ai][bj][m][1];
                    if (ACT == 1) {
#pragma unroll
                        for (int j = 0; j < 4; ++j) { const float a = fmaxf(v0[j], 0.f), b = fmaxf(v1[j], 0.f); v0[j] = a * a; v1[j] = b * b; } }
                    u32x4 w; w.x = cvt_pk_bf16(v0[0], v0[1]); w.y = cvt_pk_bf16(v0[2], v0[3]); w.z = cvt_pk_bf16(v1[0], v1[1]); w.w = cvt_pk_bf16(v1[2], v1[3]);
                    *(u32x4*)(rowp + bj * HALF) = w; } }
    }
};
struct EpiNull { static constexpr bool PERM = true, AFTER_DRAIN = false;
    __device__ __forceinline__ void operator()(const f32x4 (&acc)[2][2][4][2], const Unit& u, int wr, int wc, int fr, int fq) const { _Pragma("unroll") for (int a = 0; a < 2; ++a) _Pragma("unroll") for (int b = 0; b < 2; ++b) _Pragma("unroll") for (int m = 0; m < 4; ++m) _Pragma("unroll") for (int n = 0; n < 2; ++n) asm volatile("" :: "v"(acc[a][b][m][n])); } };
struct EpiResGate {
    static constexpr bool PERM = false, AFTER_DRAIN = false;
    const float* base_ctx; const float* base_lat; float* out; const float* gate;
    __device__ __forceinline__ void operator()(const f32x4 (&acc)[2][2][4][2], const Unit& u, int wr, int wc, int fr, int fq) const {
        const int mt = u.pm * BM; const bool lat = mt >= 8192; const int b = lat ? 1 + ((mt - 8192) >> 10) : 0;
        const float* bp = lat ? base_lat + (size_t)(mt - 8192) * 4096 : base_ctx + (size_t)mt * 4096;
        const int rl0 = wr * 64 + fr, col0 = u.pn * BM + wc * 32 + 4 * fq;
        float* op = out + (size_t)mt * 4096;
        f32x4 gv[2][2];
#pragma unroll
        for (int bj = 0; bj < 2; ++bj)
#pragma unroll
            for (int n = 0; n < 2; ++n) gv[bj][n] = *(const f32x4*)(gate + (size_t)b * 24576 + col0 + bj * HALF + n * 16);
#pragma unroll
        for (int ai = 0; ai < 2; ++ai) {
            f32x4 bs[4][2][2];
#pragma unroll
            for (int m = 0; m < 4; ++m) { const size_t off = (size_t)(rl0 + ai * HALF + m * 16) * 4096 + col0;
#pragma unroll
                for (int bj = 0; bj < 2; ++bj)
#pragma unroll
                    for (int n = 0; n < 2; ++n) bs[m][bj][n] = *(const f32x4*)(bp + off + bj * HALF + n * 16); }
            __builtin_amdgcn_sched_barrier(0);
#pragma unroll
            for (int m = 0; m < 4; ++m) { const size_t off = (size_t)(rl0 + ai * HALF + m * 16) * 4096 + col0;
#pragma unroll
                for (int bj = 0; bj < 2; ++bj)
#pragma unroll
                    for (int n = 0; n < 2; ++n) *(f32x4*)(op + off + bj * HALF + n * 16) = bs[m][bj][n] + gv[bj][n] * acc[ai][bj][m][n]; }
            asm volatile("" ::: "memory");
        }
    }
};

template <class Epi, class Sched, bool ALIGN_EPI = false, bool SP2 = false>
__device__ __forceinline__ void gemm_phase(PG8_LAS unsigned char* lds, const Gemm g, const Sched& S, const Epi& E) {
    int tid_l = threadIdx.x; asm volatile("" : "+v"(tid_l));
    const int tid = tid_l, wid = __builtin_amdgcn_readfirstlane(tid >> 6), lane = tid & 63, wr = wid >> 2, wc = wid & 3, fr = lane & 15, fq = lane >> 4;
    const int K = g.K, nt = K / BK;
    unsigned voffA[2], voffB[2];
#pragma unroll
    for (int i = 0; i < 2; ++i) { int R, C; stage_rc(tid * 16 + i * 8192, R, C); const int Rb = Epi::PERM ? ((R & ~31) + perm32(R & 31)) : R;
        voffA[i] = (unsigned)(R * g.lda + C) * 2u; voffB[i] = (unsigned)(Rb * g.ldb + C) * 2u; }
    const size_t kstep = (size_t)(BK * 2);
    const size_t hstepA = (size_t)HALF * g.lda * 2, hstepB = (size_t)HALF * g.ldb * 2;
    const size_t tstepA = 2 * hstepA, tstepB = 2 * hstepB;
    const unsigned ldsw = (unsigned)wid * 1024u;
    const int aoff = lds_byte(wr * 64 + fr, fq * 8), boff = lds_byte(wc * 32 + fr, fq * 8);
#define PG8_SA(b, h) (((b) * 2 + (h)) * HTB)
#define PG8_SB(b, h) ((4 + (b) * 2 + (h)) * HTB)
#define PG8_STAGE(bufoff, gbase, voff) do { _Pragma("unroll") for (int _i = 0; _i < 2; ++_i) \
        __builtin_amdgcn_global_load_lds((const unsigned*)((const char*)(gbase) + (voff)[_i]), (PG8_LAS unsigned*)(lds + (bufoff) + ldsw + _i * 8192), 16, 0, 0); } while (0)
#define PG8_LDA(dst, b, h) do { _Pragma("unroll") for (int m = 0; m < 4; ++m) _Pragma("unroll") for (int k = 0; k < 2; ++k) dst[m][k] = *(const PG8_LAS bf16x8*)(lds + PG8_SA(b, h) + aoff + m * 2048 + k * 1024); } while (0)
#define PG8_LDB(dst, b, h) do { _Pragma("unroll") for (int n = 0; n < 2; ++n) _Pragma("unroll") for (int k = 0; k < 2; ++k) dst[n][k] = *(const PG8_LAS bf16x8*)(lds + PG8_SB(b, h) + boff + n * 2048 + k * 1024); } while (0)
#define PG8_MMA(ai, bj, At, Bt) do { __builtin_amdgcn_s_setprio(1); _Pragma("unroll") for (int m = 0; m < 4; ++m) _Pragma("unroll") for (int n = 0; n < 2; ++n) _Pragma("unroll") for (int k = 0; k < 2; ++k) \
        acc[ai][bj][m][n] = __builtin_amdgcn_mfma_f32_16x16x32_bf16(Bt[n][k], At[m][k], acc[ai][bj][m][n], 0, 0, 0); __builtin_amdgcn_s_setprio(0); } while (0)
#define PG8_WAIT_V(n) asm volatile("s_waitcnt vmcnt(" #n ")" ::: "memory")
#define PG8_WAIT_L(n) asm volatile("s_waitcnt lgkmcnt(" #n ")" ::: "memory")
#define PG8_BAR __builtin_amdgcn_s_barrier()
#define PG8_SCHED __builtin_amdgcn_sched_barrier(0)
    Unit cur, nxt; int ui = 0;
    if (!S.next(0, cur)) return;
    f32x4 acc[2][2][4][2];
#pragma unroll
    for (int a = 0; a < 2; ++a)
#pragma unroll
        for (int b = 0; b < 2; ++b)
#pragma unroll
            for (int m = 0; m < 4; ++m)
#pragma unroll
                for (int n = 0; n < 2; ++n) acc[a][b][m][n] = (f32x4){0.f, 0.f, 0.f, 0.f};
    bf16x8 At[4][2], B0[2][2], B1[2][2];
    const char* cA = (const char*)g.A + (size_t)cur.pm * tstepA; const char* cB = (const char*)g.Bt + (size_t)cur.pn * tstepB;
    S.a_ready(cur);
    if constexpr (SP2) {
        PG8_STAGE(PG8_SB(0, 0), cB, voffB); PG8_STAGE(PG8_SB(0, 1), cB + hstepB, voffB); PG8_STAGE(PG8_SA(0, 0), cA, voffA); PG8_STAGE(PG8_SA(0, 1), cA + hstepA, voffA);
        if (wr == 1) PG8_BAR;
        PG8_WAIT_V(2); PG8_BAR;
        PG8_STAGE(PG8_SB(1, 0), cB + kstep, voffB); PG8_STAGE(PG8_SA(1, 0), cA + kstep, voffA); PG8_STAGE(PG8_SB(1, 1), cB + hstepB + kstep, voffB);
        PG8_WAIT_V(6); PG8_BAR;
    } else {
        PG8_STAGE(PG8_SB(0, 0), cB, voffB); PG8_STAGE(PG8_SA(0, 0), cA, voffA); PG8_STAGE(PG8_SB(0, 1), cB + hstepB, voffB); PG8_STAGE(PG8_SA(0, 1), cA + hstepA, voffA);
        if (wr == 1) PG8_BAR;
        PG8_WAIT_V(4); PG8_BAR;
        PG8_STAGE(PG8_SB(1, 0), cB + kstep, voffB); PG8_STAGE(PG8_SA(1, 0), cA + kstep, voffA); PG8_STAGE(PG8_SB(1, 1), cB + hstepB + kstep, voffB);
        PG8_WAIT_V(6); PG8_BAR;
    }
    for (;;) {
        const bool has_next = S.next(ui + 1, nxt);
        const char* nA = has_next ? (const char*)g.A + (size_t)nxt.pm * tstepA : cA; const char* nB = has_next ? (const char*)g.Bt + (size_t)nxt.pn * tstepB : cB;
        for (int t = 0; t < nt; t += 2) {
            const bool last = (t == nt - 2);
            const char* a1 = cA + (size_t)(t + 1) * kstep;
            const char* a2 = last ? nA : cA + (size_t)(t + 2) * kstep; const char* b2 = last ? nB : cB + (size_t)(t + 2) * kstep;
            const char* a3 = a2 + kstep; const char* b3 = b2 + kstep;
            if (last && has_next) S.a_ready(nxt);
            if constexpr (SP2) {
            PG8_LDB(B0, 0, 0); PG8_LDB(B1, 0, 1); PG8_SCHED; PG8_LDA(At, 0, 0); PG8_STAGE(PG8_SA(1, 1), a1 + hstepA, voffA);
            PG8_WAIT_V(8); PG8_WAIT_L(0); PG8_BAR; PG8_MMA(0, 0, At, B0); PG8_MMA(0, 1, At, B1); PG8_BAR; PG8_SCHED;
            PG8_LDA(At, 0, 1); PG8_STAGE(PG8_SB(0, 0), b2, voffB); PG8_STAGE(PG8_SB(0, 1), b2 + hstepB, voffB); PG8_STAGE(PG8_SA(0, 0), a2, voffA);
            PG8_WAIT_V(8); PG8_WAIT_L(0); PG8_BAR; PG8_MMA(1, 0, At, B0); PG8_MMA(1, 1, At, B1); PG8_BAR; PG8_SCHED;
            PG8_LDB(B0, 1, 0); PG8_LDB(B1, 1, 1); PG8_SCHED; PG8_LDA(At, 1, 0); PG8_STAGE(PG8_SA(0, 1), a2 + hstepA, voffA);
            PG8_WAIT_V(8); PG8_WAIT_L(0); PG8_BAR; PG8_MMA(0, 0, At, B0); PG8_MMA(0, 1, At, B1); PG8_BAR; PG8_SCHED;
            PG8_LDA(At, 1, 1); PG8_STAGE(PG8_SB(1, 0), b3, voffB); PG8_STAGE(PG8_SB(1, 1), b3 + hstepB, voffB); PG8_STAGE(PG8_SA(1, 0), a3, voffA);
            PG8_WAIT_V(8); PG8_WAIT_L(0); PG8_BAR; PG8_MMA(1, 0, At, B0); PG8_MMA(1, 1, At, B1); PG8_BAR; PG8_SCHED;
            } else {
            PG8_LDB(B0, 0, 0); PG8_SCHED; PG8_LDA(At, 0, 0); PG8_STAGE(PG8_SA(1, 1), a1 + hstepA, voffA);
            PG8_WAIT_L(8); PG8_BAR; PG8_WAIT_L(0); PG8_MMA(0, 0, At, B0); PG8_BAR; PG8_SCHED;
            PG8_LDB(B1, 0, 1); PG8_STAGE(PG8_SB(0, 0), b2, voffB);
            PG8_BAR; PG8_WAIT_L(0); PG8_MMA(0, 1, At, B1); PG8_BAR;
            PG8_LDA(At, 0, 1); PG8_STAGE(PG8_SA(0, 0), a2, voffA);
            PG8_BAR; PG8_WAIT_L(0); PG8_MMA(1, 0, At, B0); PG8_BAR; PG8_SCHED;
            PG8_STAGE(PG8_SB(0, 1), b2 + hstepB, voffB);
            PG8_WAIT_V(6); PG8_BAR; PG8_MMA(1, 1, At, B1); PG8_BAR;
            PG8_LDB(B0, 1, 0); PG8_SCHED; PG8_LDA(At, 1, 0); PG8_STAGE(PG8_SA(0, 1), a2 + hstepA, voffA);
            PG8_WAIT_L(8); PG8_BAR; PG8_WAIT_L(0); PG8_MMA(0, 0, At, B0); PG8_BAR; PG8_SCHED;
            PG8_LDB(B1, 1, 1); PG8_STAGE(PG8_SB(1, 0), b3, voffB);
            PG8_BAR; PG8_WAIT_L(0); PG8_MMA(0, 1, At, B1); PG8_BAR;
            PG8_LDA(At, 1, 1); PG8_STAGE(PG8_SA(1, 0), a3, voffA);
            PG8_BAR; PG8_WAIT_L(0); PG8_MMA(1, 0, At, B0); PG8_BAR; PG8_SCHED;
            PG8_STAGE(PG8_SB(1, 1), b3 + hstepB, voffB);
            PG8_WAIT_V(6); PG8_BAR; PG8_MMA(1, 1, At, B1); PG8_BAR;
            }
        }
        if constexpr (ALIGN_EPI) { if (wr == 0) PG8_BAR; }
        if constexpr (!Epi::AFTER_DRAIN) { E(acc, cur, wr, wc, fr, fq); S.done(cur); }
        if (!has_next) break;
#pragma unroll
        for (int a = 0; a < 2; ++a)
#pragma unroll
            for (int b = 0; b < 2; ++b)
#pragma unroll
                for (int m = 0; m < 4; ++m)
#pragma unroll
                    for (int n = 0; n < 2; ++n) acc[a][b][m][n] = (f32x4){0.f, 0.f, 0.f, 0.f};
        cur = nxt; cA = nA; cB = nB; ++ui;
        if constexpr (ALIGN_EPI) { if (wr == 1) PG8_BAR; }
    }
    PG8_WAIT_V(0);
    if constexpr (!ALIGN_EPI) { if (wr == 0) PG8_BAR; }
    PG8_BAR;
#undef PG8_SA
#undef PG8_SB
#undef PG8_STAGE
#undef PG8_LDA
#undef PG8_LDB
#undef PG8_MMA
#undef PG8_WAIT_V
#undef PG8_WAIT_L
#undef PG8_BAR
#undef PG8_SCHED
}
}

#ifndef PG8_SP2
#define PG8_SP2 true
#endif
#ifndef PG8_ALIGN
#define PG8_ALIGN true
#endif

constexpr int NWAVES = 8;
constexpr int DM = 4096, M_CTX = 8192, M_LAT = 4096, MTOT = M_CTX + M_LAT, NPROJ = 12288, DFF = 16384, DATT = 2048, NMODW = 6 * DM;
constexpr int LAT_SEQ = 1024, CTX_SEQ = 256, PAST = 256, NHEAD = 8, KV_LAT = LAT_SEQ + PAST;
constexpr int KB_ROWS = M_CTX + 4 * KV_LAT;
constexpr int LDX = DM + 64, LDH = DFF + 64, LDP = NPROJ + 64;
constexpr float EPS = 1e-6f;
constexpr int N_PHASES = 9;
constexpr int N_LAUNCHES = MK_N_LAUNCHES;

constexpr size_t MiB = 1u << 20;
constexpr size_t WS_CTL = 0, CTL_ZERO_BYTES = 1 * MiB;
constexpr size_t WS_MOD = 1 * MiB;
constexpr size_t WS_WIN = 2 * MiB;
constexpr size_t WS_WOUT = 100 * MiB;
constexpr size_t WS_W1 = 133 * MiB;
constexpr size_t WS_W2 = 263 * MiB;
constexpr size_t WS_XN = 392 * MiB;
constexpr size_t WS_CV = 490 * MiB;
constexpr size_t WS_PARK = 494 * MiB;
constexpr size_t WS_R = 526 * MiB;
constexpr size_t WS_PROJ = WS_R;
constexpr size_t WS_QB = WS_R + 290 * MiB;
constexpr size_t WS_KB = WS_R + 338 * MiB;
constexpr size_t WS_MIX = WS_R + 390 * MiB;
constexpr size_t WS_H = WS_R;
constexpr size_t WS_END = WS_R + 488 * MiB;
static_assert((size_t)MTOT * LDX * 2 <= 98 * MiB && (size_t)DM * LDX * 2 <= 33 * MiB && (size_t)DFF * LDX * 2 <= 130 * MiB && (size_t)DM * LDH * 2 <= 129 * MiB && (size_t)MTOT * LDP * 2 <= 290 * MiB, "ws map 1");
static_assert((size_t)KB_ROWS * DATT * 2 <= 52 * MiB && (size_t)MTOT * LDH * 2 <= 386 * MiB && WS_H + 386 * MiB <= WS_MIX, "ws map 2");
constexpr int CW_TMO = 0, CW_CODE = 1;
constexpr int CW_BAR = 4096;

constexpr int RING_OFF = 0, RING_BYTES = 131072;
constexpr int LDSCTL_OFF = RING_BYTES, MISC_OFF = LDSCTL_OFF + 320;
constexpr int LDS_BYTES = 147456;
static_assert(MISC_OFF + 128 <= LDS_BYTES, "LDS map");

#define GAS __attribute__((address_space(1)))
#define LAS __attribute__((address_space(3)))
typedef unsigned short bf16;
typedef unsigned v4u __attribute__((ext_vector_type(4)));
typedef unsigned v2u __attribute__((ext_vector_type(2)));
typedef float f32x4 __attribute__((ext_vector_type(4)));
typedef short bf16x8 __attribute__((ext_vector_type(8)));
typedef GAS unsigned gu32;
#define RLX_AGENT __ATOMIC_RELAXED, __HIP_MEMORY_SCOPE_AGENT
#define LDS_WAIT() asm volatile("s_waitcnt lgkmcnt(0)" ::: "memory")
#define VM_WAIT() asm volatile("s_waitcnt vmcnt(0)" ::: "memory")
__device__ __forceinline__ unsigned pk2(float lo, float hi) { return pg8::cvt_pk_bf16(lo, hi); }
__device__ __forceinline__ float bflo(unsigned w) { return __uint_as_float(w << 16); }
__device__ __forceinline__ float bfhi(unsigned w) { return __uint_as_float(w & 0xffff0000u); }

#define XB_TMO      128
#define XB_XCNT(j)  (256  + 64 * (j))
#define XB_XSUB(j)  (1280 + 64 * (j))
#define XB_XGEN(j)  (2304 + 64 * (j))
#define XB_TOP      3328
#define XB_TOPGEN   3392
#define XCD_BAR_WORDS 3456
#define XB_SPIN_CAP (1u << 18)

__device__ __forceinline__ unsigned xb_ld(unsigned* p)              { return __hip_atomic_load(p, __ATOMIC_RELAXED, __HIP_MEMORY_SCOPE_AGENT); }
__device__ __forceinline__ unsigned xb_add(unsigned* p, unsigned v) { return __hip_atomic_fetch_add(p, v, __ATOMIC_RELAXED, __HIP_MEMORY_SCOPE_AGENT); }
__device__ __forceinline__ unsigned xb_xcc_id() { return (unsigned)__builtin_amdgcn_s_getreg((3 << 11) | 20) & 0xFu; }
#define XB_SPIN(cond, bar) do { unsigned _sp = 0; while (cond) { __builtin_amdgcn_s_sleep(1); \
    if ((++_sp & 255u) == 0u) { if (xb_ld(&(bar)[XB_TMO])) break; if (_sp > XB_SPIN_CAP) { atomicAdd(&(bar)[XB_TMO], 1u); break; } } } } while (0)

struct XcdBarrier {
    unsigned* bar; unsigned x;
    volatile LAS unsigned* st;
};
__device__ __forceinline__ XcdBarrier xcd_barrier_post(unsigned* bar, volatile LAS unsigned* st) {
    XcdBarrier b; b.bar = bar; b.x = xb_xcc_id(); b.st = st;
    if (threadIdx.x == 0) (void)xb_add(&bar[XB_XCNT(b.x)], 1u);
    return b;
}
__device__ __forceinline__ void xcd_barrier_complete(unsigned* bar, unsigned x, unsigned& nloc, unsigned& nx) {
    const unsigned G = gridDim.x * gridDim.y * gridDim.z;
    unsigned sum, cnt, mine, sp = 0u;
    for (;;) {
        sum = 0u; cnt = 0u; mine = 0u;
#pragma unroll
        for (unsigned j = 0; j < 16; ++j) { const unsigned c = xb_ld(&bar[XB_XCNT(j)]); sum += c; cnt += (c > 0u) ? 1u : 0u; mine = (j == x) ? c : mine; }
        if (sum == G) break;
        __builtin_amdgcn_s_sleep(1);
        if ((++sp & 255u) == 0u) { if (xb_ld(&bar[XB_TMO])) break; if (sp > XB_SPIN_CAP) { atomicAdd(&bar[XB_TMO], 1u); break; } }
    }
    nloc = mine > 0u ? mine : 1u; nx = cnt > 0u ? cnt : 1u;
}
__device__ __forceinline__ void xcd_barrier(const XcdBarrier& b) {
    asm volatile("s_waitcnt vmcnt(0)" ::: "memory");
    __syncthreads();
    if (threadIdx.x == 0) {
        unsigned* bar = b.bar;
        __builtin_amdgcn_s_waitcnt(0);
        unsigned nloc = b.st[0], nx = b.st[1];
        if (nloc == 0u) { xcd_barrier_complete(bar, b.x, nloc, nx); b.st[0] = nloc; b.st[1] = nx; }
        const unsigned old = xb_add(&bar[XB_XSUB(b.x)], 1u);
        const unsigned gen = old / nloc;
        if (old + 1u == (gen + 1u) * nloc) {
            __builtin_amdgcn_fence(__ATOMIC_RELEASE, "agent");
            asm volatile("s_waitcnt vmcnt(0)" ::: "memory");
            const unsigned og = xb_add(&bar[XB_TOP], 1u);
            const unsigned tg = og / nx;
            if (og + 1u == (tg + 1u) * nx) xb_add(&bar[XB_TOPGEN], 1u);
            else XB_SPIN(xb_ld(&bar[XB_TOPGEN]) == tg, bar);
            __builtin_amdgcn_fence(__ATOMIC_ACQUIRE, "agent");
            xb_add(&bar[XB_XGEN(b.x)], 1u);
            asm volatile("s_waitcnt vmcnt(0)" ::: "memory");
        } else {
            XB_SPIN(xb_ld(&bar[XB_XGEN(b.x)]) == gen, bar);
            __builtin_amdgcn_fence(__ATOMIC_ACQUIRE, "agent");
            asm volatile("s_waitcnt vmcnt(0)" ::: "memory");
        }
    }
    __syncthreads();
}

struct Frame {
    LAS unsigned char* lds;
    volatile LAS unsigned* MISC;
    gu32* ctl;
    int tid, lane, wave;
    int vcu, G;
    const float *x_prompt, *x_sample, *cache_k, *cache_v, *c, *c_ctx, *w_ada, *b_ada, *norm_attn_g, *w_in, *q_norm_g, *k_norm_g;
    const float *lq1, *lk1, *lq2, *lk2, *subln_g, *conv_w, *w_out, *norm_mlp_g, *w_mlp_in, *w_mlp_out;
    float* out;
    float* MOD; float* PARK;
    bf16 *Win_t, *Wout_t, *W1_t, *W2_t, *XN, *CV, *PROJ, *QB, *KB, *MIX, *HB;
};

#define RELAUNDER(F) do { int t_ = threadIdx.x; asm volatile("" : "+v"(t_)); F.tid = t_; F.lane = t_ & 63; F.wave = __builtin_amdgcn_readfirstlane(t_ >> 6); } while (0)
__device__ __forceinline__ float wave_sum(float v) {
#pragma unroll
    for (int o = 1; o < 64; o <<= 1) v += __shfl_xor(v, o);
    return v;
}

__device__ __forceinline__ void p0_transpose_item(const float* W, int K, int N, bf16* WT, LAS float* scr, int item, int lane) {
    const int nblk = N / 32, kb = item / nblk, nb = item % nblk, k0 = 64 * kb, n0 = 32 * nb;
#pragma unroll 8
    for (int i = 0; i < 32; ++i) { const int kk = 2 * i + (lane >> 5); scr[kk * 33 + (lane & 31)] = W[(size_t)(k0 + kk) * N + n0 + (lane & 31)]; }
    LDS_WAIT(); asm volatile("" ::: "memory");
    const int c = lane & 7;
#pragma unroll
    for (int j = 0; j < 4; ++j) { const int n = (lane >> 3) + 8 * j; const LAS float* s = scr + (8 * c) * 33 + n;
        v4u o; o.x = pk2(s[0 * 33], s[1 * 33]); o.y = pk2(s[2 * 33], s[3 * 33]); o.z = pk2(s[4 * 33], s[5 * 33]); o.w = pk2(s[6 * 33], s[7 * 33]);
        *(GAS v4u*)(WT + (size_t)(n0 + n) * K + k0 + 8 * c) = o; }
    LDS_WAIT(); asm volatile("" ::: "memory");
}
__device__ __forceinline__ void cvt_row2048(const float* src, bf16* dst, int lane) {
#pragma unroll
    for (int j = 0; j < 4; ++j) { const int col = 8 * (lane + 64 * j);
        const f32x4 a = *(const GAS f32x4*)(src + col), b = *(const GAS f32x4*)(src + col + 4);
        v4u o; o.x = pk2(a.x, a.y); o.y = pk2(a.z, a.w); o.z = pk2(b.x, b.y); o.w = pk2(b.z, b.w);
        *(GAS v4u*)(dst + col) = o; }
}
__device__ __forceinline__ float silu_f(float v) { return v / (1.f + __expf(-v)); }

__device__ __forceinline__ void p0_gemv(Frame& F) {
    RELAUNDER(F);
    LAS float* sl = (LAS float*)(F.lds);
    LAS float* red = (LAS float*)(F.lds + 81920);
    for (int i = F.tid; i < 5 * DM; i += NWAVES * 64) { const int b = i / DM, k = i % DM; const float v = (b == 0) ? F.c_ctx[k] : F.c[(b - 1) * DM + k]; sl[i] = silu_f(v); }
    __syncthreads();
    for (int jt = blockIdx.x; jt < NMODW / 96; jt += F.G) {
        const int jl = F.lane % 24, rg = F.lane / 24; const bool act = F.lane < 48;
        const float* wp = F.w_ada + (size_t)(2 * F.wave + (act ? rg : 0)) * NMODW + 96 * jt + 4 * jl;
        f32x4 acc[5];
#pragma unroll
        for (int b = 0; b < 5; ++b) acc[b] = (f32x4){0.f, 0.f, 0.f, 0.f};
        for (int it = 0; it < 256; it += 16) {
            f32x4 w[16];
#pragma unroll
            for (int u = 0; u < 16; ++u) w[u] = *(const GAS f32x4*)(wp + (size_t)(it + u) * 16 * NMODW);
            __builtin_amdgcn_sched_barrier(0);
#pragma unroll
            for (int u = 0; u < 16; ++u) { const int k = 2 * F.wave + (act ? rg : 0) + 16 * (it + u);
#pragma unroll
                for (int b = 0; b < 5; ++b) { const float s = sl[b * DM + k]; acc[b] += w[u] * s; } }
        }
        if (act) {
#pragma unroll
            for (int b = 0; b < 5; ++b)
#pragma unroll
                for (int e = 0; e < 4; ++e) red[(F.wave * 48 + F.lane) * 20 + b * 4 + e] = acc[b][e];
        }
        __syncthreads();
        RELAUNDER(F);
        if (F.tid < 480) { const int b = F.tid / 96, jj = F.tid % 96, jl2 = jj >> 2, e = jj & 3; float s = 0.f;
#pragma unroll
            for (int w = 0; w < 8; ++w) s += red[(w * 48 + jl2) * 20 + b * 4 + e] + red[(w * 48 + 24 + jl2) * 20 + b * 4 + e];
            F.MOD[(size_t)b * NMODW + 96 * jt + jj] = s + F.b_ada[96 * jt + jj]; }
        __syncthreads();
    }
    __syncthreads();
}
__device__ __forceinline__ void p0_weights(Frame& F) {
    RELAUNDER(F);
    LAS float* scr = (LAS float*)(F.lds + RING_OFF + F.wave * 16384);
    const int gw = F.vcu * NWAVES + F.wave, NGW = F.G * NWAVES;
    constexpr int I_IN = (DM / 64) * (NPROJ / 32), I_O = (DM / 64) * (DM / 32), I_1 = (DM / 64) * (DFF / 32), I_2 = (DFF / 64) * (DM / 32);
    constexpr int NITEMS = I_IN + I_O + I_1 + I_2;
#define P0_DECODE(it_, src_, N_, dst_, K_) do { int r_ = (it_); const float* W_; bf16* T_; \
        if (r_ < I_IN) { W_ = F.w_in; T_ = F.Win_t; K_ = LDX; N_ = NPROJ; } else { r_ -= I_IN; \
        if (r_ < I_O) { W_ = F.w_out; T_ = F.Wout_t; K_ = LDX; N_ = DM; } else { r_ -= I_O; \
        if (r_ < I_1) { W_ = F.w_mlp_in; T_ = F.W1_t; K_ = LDX; N_ = DFF; } else { r_ -= I_1; W_ = F.w_mlp_out; T_ = F.W2_t; K_ = LDH; N_ = DM; } } } \
        const int nblk_ = N_ / 32, kb_ = r_ / nblk_, nb_ = r_ % nblk_; src_ = W_ + (size_t)(64 * kb_) * N_ + 32 * nb_; dst_ = T_ + (size_t)(32 * nb_) * K_ + 64 * kb_; } while (0)
#define P0_LOAD(v_, src_, N_) do { const float* p_ = (src_) + (size_t)(F.lane >> 5) * (N_) + (F.lane & 31); _Pragma("unroll") for (int i_ = 0; i_ < 32; ++i_) v_[i_] = *(const GAS float*)(p_ + (size_t)(2 * i_) * (N_)); __builtin_amdgcn_sched_barrier(0); } while (0)
    {
        int it = gw; bool have = it < NITEMS; float cur[32], nxt[32];
        const float* src = F.w_in; bf16* dst = F.Win_t; int K = LDX, N = NPROJ;
        if (have) { P0_DECODE(it, src, N, dst, K); P0_LOAD(cur, src, N); }
        while (have) {
            const int itn = it + NGW; const bool hn = itn < NITEMS;
            const float* srcn = src; bf16* dstn = dst; int Kn = K, Nn = N;
            if (hn) { P0_DECODE(itn, srcn, Nn, dstn, Kn); P0_LOAD(nxt, srcn, Nn); }
#pragma unroll
            for (int i = 0; i < 32; ++i) scr[(2 * i + (F.lane >> 5)) * 33 + (F.lane & 31)] = cur[i];
            LDS_WAIT(); asm volatile("" ::: "memory");
            const int c = F.lane & 7;
#pragma unroll
            for (int j = 0; j < 4; ++j) { const int n = (F.lane >> 3) + 8 * j; const LAS float* sp = scr + (8 * c) * 33 + n;
                v4u o; o.x = pk2(sp[0 * 33], sp[1 * 33]); o.y = pk2(sp[2 * 33], sp[3 * 33]); o.z = pk2(sp[4 * 33], sp[5 * 33]); o.w = pk2(sp[6 * 33], sp[7 * 33]);
                *(GAS v4u*)(dst + (size_t)n * K + 8 * c) = o; }
            LDS_WAIT(); asm volatile("" ::: "memory");
#pragma unroll
            for (int i = 0; i < 32; ++i) cur[i] = nxt[i];
            it = itn; have = hn; dst = dstn; K = Kn;
        }
    }
#undef P0_DECODE
#undef P0_LOAD
    for (int r = gw; r < 2 * 4 * PAST; r += NGW) {
        if (r < 4 * PAST) { const int b = r / PAST, j = r % PAST; cvt_row2048(F.cache_k + (size_t)r * DATT, F.KB + (size_t)(M_CTX + b * KV_LAT + LAT_SEQ + j) * DATT, F.lane); }
        else { const int rr = r - 4 * PAST; cvt_row2048(F.cache_v + (size_t)rr * DATT, F.CV + (size_t)rr * DATT, F.lane); }
    }
}

template <int WHICH> __device__ __forceinline__ void norm_mod_phase(Frame& F) {
    RELAUNDER(F);
    LAS float* gs = (LAS float*)(F.lds);
    LAS float* sh = (LAS float*)(F.lds + 16384);
    const float* g = WHICH ? F.norm_mlp_g : F.norm_attn_g;
    const int NR = MTOT / 8;
    const int r_lo = (int)(((long)blockIdx.x * NR) / F.G), r_hi = (int)(((long)(blockIdx.x + 1) * NR) / F.G);
    int cur_b = -1;
    for (int r8 = r_lo; r8 < r_hi; ++r8) {
        const int m0 = r8 * 8; const int b = m0 < M_CTX ? 0 : 1 + ((m0 - M_CTX) >> 10);
        if (b != cur_b) {
            __syncthreads();
            const float* scp = F.MOD + (size_t)b * NMODW + (WHICH ? 4 : 1) * DM; const float* shp = F.MOD + (size_t)b * NMODW + (WHICH ? 3 : 0) * DM;
            for (int i = F.tid; i < DM; i += NWAVES * 64) { gs[i] = g[i] * (1.f + scp[i]); sh[i] = shp[i]; }
            __syncthreads(); cur_b = b;
        }
        const int m = m0 + F.wave;
        const float* xrow = WHICH ? (F.out + (size_t)m * DM) : (m < M_CTX ? F.x_prompt + (size_t)m * DM : F.x_sample + (size_t)(m - M_CTX) * DM);
        const GAS f32x4* xr = (const GAS f32x4*)xrow + F.lane;
        f32x4 v[16]; float s = 0.f;
#pragma unroll
        for (int j = 0; j < 16; ++j) { v[j] = xr[64 * j]; }
#pragma unroll
        for (int j = 0; j < 16; ++j) { s += (v[j].x * v[j].x + v[j].y * v[j].y) + (v[j].z * v[j].z + v[j].w * v[j].w); }
        const float rstd = 1.f / sqrtf(wave_sum(s) * (1.f / DM) + EPS);
        GAS v2u* o8 = (GAS v2u*)(F.XN + (size_t)m * LDX) + F.lane;
#pragma unroll
        for (int j = 0; j < 16; ++j) { const f32x4 gg = *(const LAS f32x4*)(gs + 4 * (F.lane + 64 * j)), ss = *(const LAS f32x4*)(sh + 4 * (F.lane + 64 * j));
            const f32x4 y = v[j] * rstd * gg + ss; v2u w; w.x = pk2(y.x, y.y); w.y = pk2(y.z, y.w); o8[64 * j] = w; }
    }
}

__device__ __forceinline__ void unpack8(const v4u w, float (&f)[8]) { f[0] = bflo(w.x); f[1] = bfhi(w.x); f[2] = bflo(w.y); f[3] = bfhi(w.y); f[4] = bflo(w.z); f[5] = bfhi(w.z); f[6] = bflo(w.w); f[7] = bfhi(w.w); }
__device__ __forceinline__ v4u pack8(const float (&f)[8]) { v4u o; o.x = pk2(f[0], f[1]); o.y = pk2(f[2], f[3]); o.z = pk2(f[4], f[5]); o.w = pk2(f[6], f[7]); return o; }

__device__ __forceinline__ void post_proj_phase(Frame& F) {
    RELAUNDER(F);
    float* new_k = F.out + (size_t)MTOT * DM; float* new_v = new_k + (size_t)M_CTX * DATT;
    const int l8 = F.lane & 7, ax = l8 >> 2, i0 = (l8 & 3) * 8;
    float inv[8];
#pragma unroll
    for (int j = 0; j < 8; ++j) inv[j] = exp2f(-(float)(2 * (i0 + j)) * (13.287712379549449f / 64.f));
    const int NR = MTOT / 8;
    const int r_lo = (int)(((long)blockIdx.x * NR) / F.G), r_hi = (int)(((long)(blockIdx.x + 1) * NR) / F.G);
    for (int r8 = r_lo; r8 < r_hi; ++r8) {
        const int m = r8 * 8 + F.wave; const bool lat = m >= M_CTX;
        const int t = lat ? ((m - M_CTX) & (LAT_SEQ - 1)) : (m & (CTX_SEQ - 1)); const int L = lat ? LAT_SEQ : CTX_SEQ;
        const int krow = lat ? (M_CTX + ((m - M_CTX) >> 10) * KV_LAT + t) : m;
        const bf16* prow = F.PROJ + (size_t)m * LDP;
#pragma unroll
        for (int part = 0; part < 2; ++part) {
            const float* gn = part ? F.k_norm_g : F.q_norm_g;
            float g1[8], g2[8];
#pragma unroll
            for (int j = 0; j < 8; ++j) { g1[j] = gn[ax * 64 + i0 + j]; g2[j] = gn[ax * 64 + 32 + i0 + j]; }
#pragma unroll
            for (int pass = 0; pass < 2; ++pass) {
                const int gidx = pass * 8 + (F.lane >> 3); const int cb = gidx * 128 + ax * 64 + i0;
                float x1[8], x2[8];
                unpack8(*(const GAS v4u*)(prow + part * DATT + cb), x1); unpack8(*(const GAS v4u*)(prow + part * DATT + cb + 32), x2);
                float ss = 0.f;
#pragma unroll
                for (int j = 0; j < 8; ++j) ss += x1[j] * x1[j] + x2[j] * x2[j];
                ss += __shfl_xor(ss, 1); ss += __shfl_xor(ss, 2); ss += __shfl_xor(ss, 4);
                const float rstd = 1.f / sqrtf(ss * (1.f / 128.f) + EPS);
#pragma unroll
                for (int j = 0; j < 8; ++j) { x1[j] = x1[j] * rstd * g1[j]; x2[j] = x2[j] * rstd * g2[j]; }
                if (part == 1 && !lat) {
                    float* nk = new_k + (size_t)m * DATT + cb;
                    *(GAS f32x4*)(nk) = (f32x4){x1[0], x1[1], x1[2], x1[3]}; *(GAS f32x4*)(nk + 4) = (f32x4){x1[4], x1[5], x1[6], x1[7]};
                    *(GAS f32x4*)(nk + 32) = (f32x4){x2[0], x2[1], x2[2], x2[3]}; *(GAS f32x4*)(nk + 36) = (f32x4){x2[4], x2[5], x2[6], x2[7]};
                }
                if (lat) {
                    const float pos = (float)(ax == 0 ? (t >> 6) : (t & 63));
#pragma unroll
                    for (int j = 0; j < 8; ++j) { const float ang = pos * inv[j]; const float cs = __cosf(ang), sn = __sinf(ang);
                        const float a = x1[j], b = x2[j]; x1[j] = a * cs - b * sn; x2[j] = a * sn + b * cs; }
                }
                bf16* dst = part ? (F.KB + (size_t)krow * DATT + cb) : (F.QB + (size_t)m * DATT + cb);
                *(GAS v4u*)(dst) = pack8(x1); *(GAS v4u*)(dst + 32) = pack8(x2);
            }
        }
        if (!lat) {
#pragma unroll
            for (int j = 0; j < 4; ++j) { const int col = 8 * (F.lane + 64 * j); float f[8]; unpack8(*(const GAS v4u*)(prow + 2 * DATT + col), f);
                float* nv = new_v + (size_t)m * DATT + col;
                *(GAS f32x4*)(nv) = (f32x4){f[0], f[1], f[2], f[3]}; *(GAS f32x4*)(nv + 4) = (f32x4){f[4], f[5], f[6], f[7]}; }
        }
#pragma unroll
        for (int p = 0; p < 4; ++p) {
            const int ch = 8 * (F.lane + 64 * p);
            float bg[8], c0[8], u0[8], cm[8], um[8], cp[8], up[8];
            unpack8(*(const GAS v4u*)(prow + 3 * DATT + ch), bg);
            unpack8(*(const GAS v4u*)(prow + 4 * DATT + ch), c0); unpack8(*(const GAS v4u*)(prow + 5 * DATT + ch), u0);
            const bool hm = t > 0, hp = t < L - 1;
            const bf16* pm_ = hm ? prow - LDP : prow; const bf16* pp_ = hp ? prow + LDP : prow;
            unpack8(*(const GAS v4u*)(pm_ + 4 * DATT + ch), cm); unpack8(*(const GAS v4u*)(pm_ + 5 * DATT + ch), um);
            unpack8(*(const GAS v4u*)(pp_ + 4 * DATT + ch), cp); unpack8(*(const GAS v4u*)(pp_ + 5 * DATT + ch), up);
            const float fm = hm ? 1.f : 0.f, fp = hp ? 1.f : 0.f;
            const f32x4 w0a = *(const GAS f32x4*)(F.conv_w + ch), w0b = *(const GAS f32x4*)(F.conv_w + ch + 4);
            const f32x4 w1a = *(const GAS f32x4*)(F.conv_w + DATT + ch), w1b = *(const GAS f32x4*)(F.conv_w + DATT + ch + 4);
            const f32x4 w2a = *(const GAS f32x4*)(F.conv_w + 2 * DATT + ch), w2b = *(const GAS f32x4*)(F.conv_w + 2 * DATT + ch + 4);
            float y[8];
#pragma unroll
            for (int j = 0; j < 8; ++j) { const float w0 = j < 4 ? w0a[j & 3] : w0b[j & 3], w1 = j < 4 ? w1a[j & 3] : w1b[j & 3], w2 = j < 4 ? w2a[j & 3] : w2b[j & 3];
                y[j] = bg[j] * (w0 * (cm[j] * um[j]) * fm + w1 * (c0[j] * u0[j]) + w2 * (cp[j] * up[j]) * fp); }
            *(GAS v4u*)(F.MIX + (size_t)m * LDX + DATT + ch) = pack8(y);
        }
    }
}

namespace att {
using s16x4  = __attribute__((ext_vector_type(4))) short;
using f32x16 = __attribute__((ext_vector_type(16))) float;
constexpr int KVBLK = 64;
constexpr float SCALE = 0.088388347648318440f;
constexpr float THR = 8.f;
constexpr int SHM_K = KVBLK * 128 * 2, SHM_V = KVBLK * 256 * 2;
constexpr int OFF_V = 0, OFF_K = 2 * SHM_V, OFF_WS = OFF_K + 2 * SHM_K, OFF_SSQ = OFF_WS + NWAVES * 256, ATT_LDS = OFF_SSQ + 128 * 2 * 4;
static_assert(ATT_LDS <= RING_BYTES, "attention LDS");
#define KSWZ(row, colB) ((row) * 256 + ((colB) ^ (((row) & 7) << 4)))
#define SBAR() __builtin_amdgcn_sched_barrier(0)
__device__ __forceinline__ int crow(int r, int hi) { return (r & 3) + 8 * (r >> 2) + 4 * hi; }
__device__ __forceinline__ unsigned cvtpk(float lo, float hi) { unsigned r; asm volatile("v_cvt_pk_bf16_f32 %0, %1, %2" : "=v"(r) : "v"(lo), "v"(hi)); return r; }

__device__ __forceinline__ void partialSM(f32x16& p0, f32x16& p1, float& m_reg, float& mn, float& alpha) {
  constexpr float C = SCALE * 1.4426950408889634f;
  float pmax = p0[0];
#pragma unroll
  for (int r = 1; r < 16; ++r) pmax = fmaxf(pmax, p0[r]);
#pragma unroll
  for (int r = 0; r < 16; ++r) pmax = fmaxf(pmax, p1[r]);
  { auto rr = __builtin_amdgcn_permlane32_swap(__float_as_uint(pmax), __float_as_uint(pmax), false, false);
    pmax = fmaxf(__uint_as_float(rr[0]), __uint_as_float(rr[1])); }
  if (__builtin_expect(__all(pmax - m_reg <= THR / SCALE), 1)) { mn = m_reg; alpha = 1.f; }
  else { mn = fmaxf(m_reg, pmax); alpha = __builtin_amdgcn_exp2f((m_reg - mn) * C); m_reg = mn; }
  float mnC = -mn * C;
#pragma unroll
  for (int r = 0; r < 16; ++r) p0[r] = fmaf(p0[r], C, mnC);
#pragma unroll
  for (int r = 0; r < 16; ++r) p1[r] = fmaf(p1[r], C, mnC);
#pragma unroll
  for (int r = 0; r < 16; ++r) p0[r] = __builtin_amdgcn_exp2f(p0[r]);
}
__device__ __forceinline__ void finishSM(f32x16& p0, f32x16& p1, float alpha, float& l_reg, bf16x8& pa0, bf16x8& pa1, bf16x8& pa2, bf16x8& pa3) {
#pragma unroll
  for (int r = 0; r < 16; ++r) p1[r] = __builtin_amdgcn_exp2f(p1[r]);
  float ps = 0;
#pragma unroll
  for (int r = 0; r < 16; ++r) ps += p0[r];
#pragma unroll
  for (int r = 0; r < 16; ++r) ps += p1[r];
  { auto rr = __builtin_amdgcn_permlane32_swap(__float_as_uint(ps), __float_as_uint(ps), false, false);
    ps = __uint_as_float(rr[0]) + __uint_as_float(rr[1]); }
  l_reg = l_reg * alpha + ps;
#define PK4(P, BASE, OUT) do { unsigned a0 = cvtpk(P[BASE + 0], P[BASE + 1]), a1 = cvtpk(P[BASE + 2], P[BASE + 3]);   \
    unsigned b0 = cvtpk(P[BASE + 4], P[BASE + 5]), b1 = cvtpk(P[BASE + 6], P[BASE + 7]);                              \
    auto r0 = __builtin_amdgcn_permlane32_swap(a0, b0, false, false); auto r1 = __builtin_amdgcn_permlane32_swap(a1, b1, false, false); \
    v4u w = {r0[0], r1[0], r0[1], r1[1]}; OUT = *reinterpret_cast<bf16x8*>(&w); } while (0)
  PK4(p0, 0, pa0); PK4(p0, 8, pa1); PK4(p1, 0, pa2); PK4(p1, 8, pa3);
#undef PK4
}
__device__ __forceinline__ void qkt(f32x16& p0, f32x16& p1, const LAS char* Ks, const bf16x8* qr, int r32, int hi) {
  p0 = f32x16{}; p1 = f32x16{};
#pragma unroll
  for (int d0 = 0; d0 < 8; ++d0) { int cb = (d0 * 16 + hi * 8) * 2;
    bf16x8 b0 = *reinterpret_cast<const LAS bf16x8*>(Ks + KSWZ(r32, cb));
    bf16x8 b1 = *reinterpret_cast<const LAS bf16x8*>(Ks + KSWZ(32 + r32, cb));
    p0 = __builtin_amdgcn_mfma_f32_32x32x16_bf16(b0, qr[d0], p0, 0, 0, 0);
    p1 = __builtin_amdgcn_mfma_f32_32x32x16_bf16(b1, qr[d0], p1, 0, 0, 0); }
}
__device__ __forceinline__ int v_st(int k, int c) { const int kk = (k & ~0xC) | ((k & 4) << 1) | ((k & 8) >> 1); return ((kk >> 3) * 4 + (c >> 5)) * 512 + ((kk & 7) * 32 + (c & 31)) * 2; }
__device__ __forceinline__ int v_rd_base(int lane) { return ((lane & 3) << 3) | (((lane >> 2) & 3) << 6) | (((lane >> 4) & 1) << 5) | (((lane >> 5) & 1) << 8); }
constexpr int v_rd_off(int d0, int ks, int half) { return d0 * 512 + ks * 4096 + half * 2048; }
template <int OFF> __device__ __forceinline__ s16x4 tr_read(int vb) {
  s16x4 r; asm volatile("ds_read_b64_tr_b16 %0, %1 offset:%2" : "=&v"(r) : "v"(vb), "i"(OFF) : "memory"); return r;
}
template <int D0> __device__ __forceinline__ void pv_one(f32x16& od, int vb, bf16x8 pa0, bf16x8 pa1, bf16x8 pa2, bf16x8 pa3) {
  const s16x4 l0 = tr_read<v_rd_off(D0, 0, 0)>(vb), h0 = tr_read<v_rd_off(D0, 0, 1)>(vb), l1 = tr_read<v_rd_off(D0, 1, 0)>(vb), h1 = tr_read<v_rd_off(D0, 1, 1)>(vb);
  const s16x4 l2 = tr_read<v_rd_off(D0, 2, 0)>(vb), h2 = tr_read<v_rd_off(D0, 2, 1)>(vb), l3 = tr_read<v_rd_off(D0, 3, 0)>(vb), h3 = tr_read<v_rd_off(D0, 3, 1)>(vb);
  asm volatile("s_waitcnt lgkmcnt(0)" ::: "memory"); SBAR();
#define PK(L, H) (bf16x8){L[0], L[1], L[2], L[3], H[0], H[1], H[2], H[3]}
  od = __builtin_amdgcn_mfma_f32_32x32x16_bf16(pa0, PK(l0, h0), od, 0, 0, 0);
  od = __builtin_amdgcn_mfma_f32_32x32x16_bf16(pa1, PK(l1, h1), od, 0, 0, 0);
  od = __builtin_amdgcn_mfma_f32_32x32x16_bf16(pa2, PK(l2, h2), od, 0, 0, 0);
  od = __builtin_amdgcn_mfma_f32_32x32x16_bf16(pa3, PK(l3, h3), od, 0, 0, 0);
#undef PK
}
__device__ __forceinline__ void pv_d0(f32x16* o, int vb, bf16x8 pa0, bf16x8 pa1, bf16x8 pa2, bf16x8 pa3) {
  pv_one<0>(o[0], vb, pa0, pa1, pa2, pa3); pv_one<1>(o[1], vb, pa0, pa1, pa2, pa3); pv_one<2>(o[2], vb, pa0, pa1, pa2, pa3); pv_one<3>(o[3], vb, pa0, pa1, pa2, pa3);
}

__device__ __forceinline__ void attn_unit(const bf16* Qp, const bf16* Kp, const bf16* V0p, int nself, const bf16* V1p, int nkeys, bf16* Op,
                                          float* park, const float* subln_g, float lam, float oscale, LAS char* lds) {
  int tid_l = threadIdx.x; asm volatile("" : "+v"(tid_l));
  const int tid = tid_l, wid = __builtin_amdgcn_readfirstlane(tid >> 6), lane = tid & 63, r32 = lane & 31, hi = lane >> 5, rg = wid >> 1, e = wid & 1;
  LAS char* V_lds = lds + OFF_V; LAS char* K_lds = lds + OFF_K;
  LAS float* wsf = (LAS float*)(lds + OFF_WS) + wid * 64; LAS float* li_l = wsf; LAS float* al_l = wsf + 32;
  LAS float* ssq = (LAS float*)(lds + OFF_SSQ);
  const int sr = tid >> 4, sc = (tid & 15) * 8, vst0 = v_st(sr, sc), vst1 = v_st(32 + sr, sc);
  const int vb0 = (int)(unsigned)(uintptr_t)(V_lds + e * (SHM_V / 2)) + v_rd_base(lane);
  const int NT = nkeys / KVBLK;
  const unsigned voS = (unsigned)(sr * LDP + sc), voC = (unsigned)(sr * DATT + sc);
  f32x16 o[4];
  float rli[16];
  for (int c = 0; c < 2; ++c) {
    float m_reg = -1e30f, l_reg = 0;
#pragma unroll
    for (int d = 0; d < 4; ++d) o[d] = f32x16{};
    bf16x8 qr[8];
    { const bf16* Qw = Qp + (size_t)(rg * 32 + r32) * DATT + c * 128 + hi * 8;
#pragma unroll
      for (int d0 = 0; d0 < 8; ++d0) qr[d0] = *(const GAS bf16x8*)(Qw + d0 * 16); }
    const bf16* Kh = Kp + c * 128;
    bf16x8 vs0, vs1, vs2, vs3, ks0, ks1;
#define SLOAD(k0) do { const int kk_ = (k0); const bool self_ = kk_ < nself; \
    const bf16* vu_ = self_ ? V0p + (size_t)kk_ * LDP : V1p + (size_t)(kk_ - nself) * DATT; const unsigned vo_ = self_ ? voS : voC, vst_ = self_ ? 32u * LDP : 32u * DATT; \
    vs0 = *(const GAS bf16x8*)(vu_ + vo_); vs1 = *(const GAS bf16x8*)(vu_ + (vo_ + 128u)); vs2 = *(const GAS bf16x8*)(vu_ + (vo_ + vst_)); vs3 = *(const GAS bf16x8*)(vu_ + (vo_ + vst_ + 128u)); \
    const bf16* ku_ = Kh + (size_t)kk_ * DATT; ks0 = *(const GAS bf16x8*)(ku_ + voC); ks1 = *(const GAS bf16x8*)(ku_ + (voC + 32u * DATT)); } while (0)
#define SWRITE(b) do { LAS char* vb_ = V_lds + (b) * SHM_V; LAS char* kb_ = K_lds + (b) * SHM_K; const int kc = sc * 2; \
    *(LAS bf16x8*)(vb_ + vst0) = vs0; *(LAS bf16x8*)(vb_ + SHM_V / 2 + vst0) = vs1; *(LAS bf16x8*)(vb_ + vst1) = vs2; *(LAS bf16x8*)(vb_ + SHM_V / 2 + vst1) = vs3; \
    *(LAS bf16x8*)(kb_ + KSWZ(sr, kc)) = ks0; *(LAS bf16x8*)(kb_ + KSWZ(32 + sr, kc)) = ks1; } while (0)
#define SWAIT() asm volatile("s_waitcnt vmcnt(0)" ::: "memory")
#define RESC(a) do { if (__any((a) < 1.f)) { if (hi == 0) al_l[r32] = (a); asm volatile("s_waitcnt lgkmcnt(0)" ::: "memory"); \
    _Pragma("unroll") for (int d = 0; d < 4; ++d) _Pragma("unroll") for (int r = 0; r < 16; ++r) o[d][r] *= al_l[crow(r, hi)]; } } while (0)
    f32x16 p0, p1; float mn, al; bf16x8 pa0, pa1, pa2, pa3;
    __syncthreads();
    SLOAD(0); SWAIT(); SWRITE(0); __syncthreads();
    for (int j = 0; j < NT; ++j) {
      const int buf = j & 1; const bool more = j + 1 < NT;
      if (more) SLOAD((j + 1) * KVBLK);
      SBAR(); qkt(p0, p1, K_lds + buf * SHM_K, qr, r32, hi);
      partialSM(p0, p1, m_reg, mn, al);
      RESC(al);
      finishSM(p0, p1, al, l_reg, pa0, pa1, pa2, pa3); SBAR();
      pv_d0(o, vb0 + buf * SHM_V, pa0, pa1, pa2, pa3);
      if (more) { SWAIT(); SWRITE(buf ^ 1); }
      __syncthreads();
    }
#undef SLOAD
#undef SWRITE
#undef SWAIT
#undef RESC
    int hi_ = hi, r32_ = r32, wid_ = wid; asm volatile("" : "+v"(hi_), "+v"(r32_), "+s"(wid_));
    LAS float* li2 = (LAS float*)(lds + OFF_WS) + wid_ * 64;
    if (hi_ == 0) li2[r32_] = l_reg; asm volatile("s_waitcnt lgkmcnt(0)" ::: "memory");
#pragma unroll
    for (int r = 0; r < 16; ++r) rli[r] = __builtin_amdgcn_rcpf(li2[crow(r, hi_)]);
    if (c == 0) {
      float* pk = park + (size_t)wid_ * 4096 + (hi_ * 32 + r32_);
#pragma unroll
      for (int d = 0; d < 4; ++d)
#pragma unroll
        for (int r = 0; r < 16; ++r) pk[(d * 16 + r) * 64] = o[d][r] * rli[r];
    }
  }
  int hi_ = hi, r32_ = r32, wid_ = wid; asm volatile("" : "+v"(hi_), "+v"(r32_), "+s"(wid_));
  const int rg_ = wid_ >> 1, e_ = wid_ & 1;
  const float* pk = park + (size_t)wid_ * 4096 + (hi_ * 32 + r32_);
  asm volatile("s_waitcnt vmcnt(0)" ::: "memory");
  float q[16];
#pragma unroll
  for (int r = 0; r < 16; ++r) q[r] = 0.f;
#pragma unroll
  for (int d = 0; d < 4; ++d) {
#pragma unroll
    for (int r = 0; r < 16; ++r) { const float v = pk[(d * 16 + r) * 64] - lam * (o[d][r] * rli[r]); o[d][r] = v; q[r] += v * v; }
    asm volatile("" ::: "memory"); }
#pragma unroll
  for (int r = 0; r < 16; ++r) { float s = q[r]; s += __shfl_xor(s, 1); s += __shfl_xor(s, 2); s += __shfl_xor(s, 4); s += __shfl_xor(s, 8); s += __shfl_xor(s, 16); q[r] = s; }
  if (r32_ == 0) {
#pragma unroll
    for (int r = 0; r < 16; ++r) ssq[(rg_ * 32 + crow(r, hi_)) * 2 + e_] = q[r];
  }
  __syncthreads();
  float g4[4];
#pragma unroll
  for (int d = 0; d < 4; ++d) g4[d] = subln_g[e_ * 128 + d * 32 + r32_] * oscale;
  bf16* ob = Op + (size_t)(rg_ * 32 + 4 * hi_) * LDX + e_ * 128 + r32_;
  const LAS float* sq = ssq + (rg_ * 32 + 4 * hi_) * 2;
#pragma unroll
  for (int r = 0; r < 16; ++r) { const int rr = (r & 3) + 8 * (r >> 2); const float tot = sq[rr * 2] + sq[rr * 2 + 1]; const float rstd = __builtin_amdgcn_rsqf(tot * (1.f / 256.f) + EPS);
    bf16* orow = ob + (size_t)rr * LDX;
#pragma unroll
    for (int d = 0; d < 4; ++d) { const unsigned w = cvtpk(o[d][r] * rstd * g4[d], 0.f); orow[d * 32] = (bf16)(w & 0xffffu); } }
}
#undef KSWZ
#undef SBAR
}

__device__ __forceinline__ void attention_phase(Frame& F) {
    RELAUNDER(F);
    const float d1 = wave_sum(F.lq1[F.lane] * F.lk1[F.lane] + F.lq1[F.lane + 64] * F.lk1[F.lane + 64]);
    const float d2 = wave_sum(F.lq2[F.lane] * F.lk2[F.lane] + F.lq2[F.lane + 64] * F.lk2[F.lane + 64]);
    const float lam_init = 0.2f; const float lam = __expf(d1) - __expf(d2) + lam_init; const float oscale = 1.f - lam_init;
    float* park = F.PARK + (size_t)blockIdx.x * (NWAVES * 4096);
    LAS char* lds = (LAS char*)(F.lds + RING_OFF);
    for (int idx = F.vcu; idx < 768; idx += F.G) {
        const bool lat = idx < 256; const int u = lat ? idx : idx - 256;
        const int b = lat ? (u >> 6) : (u >> 4), h = lat ? ((u >> 3) & 7) : ((u >> 1) & 7), qb = lat ? (u & 7) : (u & 1);
        const int m0 = lat ? M_CTX + b * LAT_SEQ : b * CTX_SEQ; const int k0row = lat ? M_CTX + b * KV_LAT : m0;
        att::attn_unit(F.QB + (size_t)(m0 + qb * 128) * DATT + h * 256, F.KB + (size_t)k0row * DATT + h * 256,
                       F.PROJ + (size_t)m0 * LDP + 2 * DATT + h * 256, lat ? LAT_SEQ : CTX_SEQ, F.CV + (size_t)(b & 3) * PAST * DATT + h * 256, lat ? KV_LAT : CTX_SEQ,
                       F.MIX + (size_t)(m0 + qb * 128) * LDX + h * 256, park, F.subln_g, lam, oscale, lds);
    }
}

struct Args { const float* in[22]; float* out; unsigned char* ws; int ph_lo, ph_hi; };
__global__ void __launch_bounds__(NWAVES * 64, 2) mk_fwd(Args args) {
    extern __shared__ __attribute__((aligned(16))) unsigned char lds[];
    Frame F;
    F.lds = (LAS unsigned char*)lds;
    F.MISC = (volatile LAS unsigned*)(F.lds + MISC_OFF);
    F.tid = threadIdx.x; F.lane = F.tid & 63; F.wave = __builtin_amdgcn_readfirstlane(F.tid >> 6);
    F.G = gridDim.x; { const int bx = blockIdx.x; F.vcu = (F.G % 8 == 0) ? (bx % 8) * (F.G / 8) + bx / 8 : bx; }
    unsigned char* ws = args.ws;
    F.ctl = (gu32*)(ws + WS_CTL);
    F.x_prompt = args.in[0]; F.x_sample = args.in[1]; F.cache_k = args.in[2]; F.cache_v = args.in[3]; F.c = args.in[4]; F.c_ctx = args.in[5];
    F.w_ada = args.in[6]; F.b_ada = args.in[7]; F.norm_attn_g = args.in[8]; F.w_in = args.in[9]; F.q_norm_g = args.in[10]; F.k_norm_g = args.in[11];
    F.lq1 = args.in[12]; F.lk1 = args.in[13]; F.lq2 = args.in[14]; F.lk2 = args.in[15]; F.subln_g = args.in[16]; F.conv_w = args.in[17];
    F.w_out = args.in[18]; F.norm_mlp_g = args.in[19]; F.w_mlp_in = args.in[20]; F.w_mlp_out = args.in[21];
    F.out = args.out;
    F.MOD = (float*)(ws + WS_MOD); F.PARK = (float*)(ws + WS_PARK);
    F.Win_t = (bf16*)(ws + WS_WIN); F.Wout_t = (bf16*)(ws + WS_WOUT); F.W1_t = (bf16*)(ws + WS_W1); F.W2_t = (bf16*)(ws + WS_W2);
    F.XN = (bf16*)(ws + WS_XN); F.CV = (bf16*)(ws + WS_CV); F.PROJ = (bf16*)(ws + WS_PROJ); F.QB = (bf16*)(ws + WS_QB); F.KB = (bf16*)(ws + WS_KB);
    F.MIX = (bf16*)(ws + WS_MIX); F.HB = (bf16*)(ws + WS_H);
    for (int u = F.tid; u < (LDS_BYTES - LDSCTL_OFF) / 4; u += NWAVES * 64) ((LAS unsigned*)(F.lds + LDSCTL_OFF))[u] = 0u;
    __syncthreads();
    XcdBarrier bar; bar.bar = (unsigned*)(F.ctl + CW_BAR); bar.x = 0; bar.st = nullptr;
    if (N_LAUNCHES == 1) bar = xcd_barrier_post((unsigned*)(F.ctl + CW_BAR), F.MISC + 8);
#define GRID_BAR(seam) do { if (N_LAUNCHES == 1) { xcd_barrier(bar); } } while (0)
    const int lo = args.ph_lo, hi = args.ph_hi;
#ifndef PH_MASK
#define PH_MASK 0x1ff
#endif
#define IN(k) (((PH_MASK >> (k)) & 1) && lo <= (k) && (k) < hi)
#define BOTH(k) (IN(k) && IN((k) + 1))
#ifndef PROBE_DUP
#define PROBE_DUP 0
#endif
#define DUP(k) ((PROBE_DUP >> (k)) & 1)

    if (IN(0)) { p0_gemv(F); if (DUP(10)) { __syncthreads(); p0_gemv(F); } p0_weights(F); if (DUP(11)) { __syncthreads(); p0_weights(F); } if (BOTH(0)) GRID_BAR(0); }
    if (IN(1)) { norm_mod_phase<0>(F); if (DUP(1)) { __syncthreads(); norm_mod_phase<0>(F); } if (BOTH(1)) GRID_BAR(1); }
    if (IN(2)) {
        pg8::Gemm g{F.XN, F.Win_t, MTOT, NPROJ, DM, LDX, LDX}; pg8::StaticOrder S; S.init(MTOT, NPROJ, F.G, (int)blockIdx.x);
        pg8::EpiBf16<0> E{F.PROJ, LDP};
        pg8::gemm_phase<pg8::EpiBf16<0>, pg8::StaticOrder, PG8_ALIGN, PG8_SP2>(F.lds + RING_OFF, g, S, E);
        if (DUP(2)) { __syncthreads(); pg8::gemm_phase<pg8::EpiBf16<0>, pg8::StaticOrder, PG8_ALIGN, PG8_SP2>(F.lds + RING_OFF, g, S, E); }
        if (DUP(9)) { __syncthreads(); pg8::EpiNull EN; pg8::gemm_phase<pg8::EpiNull, pg8::StaticOrder, PG8_ALIGN, PG8_SP2>(F.lds + RING_OFF, g, S, EN); }
        if (BOTH(2)) GRID_BAR(2);
    }
    if (IN(3)) { post_proj_phase(F); if (DUP(3)) { __syncthreads(); post_proj_phase(F); } if (BOTH(3)) GRID_BAR(3); }
    if (IN(4)) { attention_phase(F); if (DUP(4)) { __syncthreads(); attention_phase(F); } if (BOTH(4)) GRID_BAR(4); }
    if (IN(5)) {
        pg8::Gemm g{F.MIX, F.Wout_t, MTOT, DM, DM, LDX, LDX}; pg8::StaticOrder S; S.init(MTOT, DM, F.G, (int)blockIdx.x);
        pg8::EpiResGate E{F.x_prompt, F.x_sample, F.out, F.MOD + 2 * DM};
        pg8::gemm_phase<pg8::EpiResGate, pg8::StaticOrder, PG8_ALIGN, PG8_SP2>(F.lds + RING_OFF, g, S, E);
        if (DUP(5)) { __syncthreads(); pg8::gemm_phase<pg8::EpiResGate, pg8::StaticOrder, PG8_ALIGN, PG8_SP2>(F.lds + RING_OFF, g, S, E); }
        if (BOTH(5)) GRID_BAR(5);
    }
    if (IN(6)) { norm_mod_phase<1>(F); if (DUP(6)) { __syncthreads(); norm_mod_phase<1>(F); } if (BOTH(6)) GRID_BAR(6); }
    if (IN(7)) {
        pg8::Gemm g{F.XN, F.W1_t, MTOT, DFF, DM, LDX, LDX}; pg8::StaticOrder S; S.init(MTOT, DFF, F.G, (int)blockIdx.x);
        pg8::EpiBf16<1> E{F.HB, LDH};
        pg8::gemm_phase<pg8::EpiBf16<1>, pg8::StaticOrder, PG8_ALIGN, PG8_SP2>(F.lds + RING_OFF, g, S, E);
        if (DUP(7)) { __syncthreads(); pg8::gemm_phase<pg8::EpiBf16<1>, pg8::StaticOrder, PG8_ALIGN, PG8_SP2>(F.lds + RING_OFF, g, S, E); }
        if (BOTH(7)) GRID_BAR(7);
    }
    if (IN(8)) {
        pg8::Gemm g{F.HB, F.W2_t, MTOT, DM, DFF, LDH, LDH}; pg8::StaticOrder S; S.init(MTOT, DM, F.G, (int)blockIdx.x);
        pg8::EpiResGate E{F.out, F.out + (size_t)M_CTX * DM, F.out, F.MOD + 5 * DM};
        pg8::gemm_phase<pg8::EpiResGate, pg8::StaticOrder, PG8_ALIGN, PG8_SP2>(F.lds + RING_OFF, g, S, E);
    }
#undef IN
#undef BOTH
}

extern "C" void kernel_launch(void* const* d_in, const int* in_sizes, int n_in, void* d_out, int out_size, void* d_ws, size_t ws_size, hipStream_t stream) {
    static int grid = 0;
    if (grid == 0) {
        if (n_in != 22 || ws_size < WS_END) { fprintf(stderr, "kernel_launch: expected 22 inputs and >= %zu bytes of workspace; got n_in %d, ws %zu; nothing launched\n", (size_t)WS_END, n_in, ws_size); grid = -1; return; }
        int dev = 0, cus = 0, per_cu = 0;
        if (hipGetDevice(&dev) != hipSuccess || hipDeviceGetAttribute(&cus, hipDeviceAttributeMultiprocessorCount, dev) != hipSuccess) { grid = -1; return; }
        if (hipFuncSetAttribute((const void*)mk_fwd, hipFuncAttributeMaxDynamicSharedMemorySize, LDS_BYTES) != hipSuccess) { fprintf(stderr, "kernel_launch: hipFuncSetAttribute failed\n"); grid = -1; return; }
        if (hipOccupancyMaxActiveBlocksPerMultiprocessor(&per_cu, (const void*)mk_fwd, NWAVES * 64, LDS_BYTES) != hipSuccess || per_cu < 1)
            fprintf(stderr, "kernel_launch: note: occupancy query reports %d workgroups per CU\n", per_cu);
        (void)hipGetLastError();
        grid = cus;
    }
    if (grid < 0) return;
    if (hipMemsetAsync((char*)d_ws + WS_CTL, 0, CTL_ZERO_BYTES, stream) != hipSuccess) { fprintf(stderr, "kernel_launch: memset failed\n"); return; }
    Args a{};
    for (int i = 0; i < 22; ++i) a.in[i] = (const float*)d_in[i];
    a.out = (float*)d_out; a.ws = (unsigned char*)d_ws;
    for (int li = 0; li < N_LAUNCHES; ++li) {
        a.ph_lo = (N_LAUNCHES == 1) ? 0 : li; a.ph_hi = (N_LAUNCHES == 1) ? N_PHASES : li + 1;
        hipLaunchKernelGGL(mk_fwd, dim3(grid), dim3(NWAVES * 64), LDS_BYTES, stream, a);
        const hipError_t le = hipPeekAtLastError();
        if (le != hipSuccess) { fprintf(stderr, "kernel_launch: launch %d failed: %s\n", li, hipGetErrorName(le)); break; }
    }
}
```

```cpp
#include <hip/hip_runtime.h>
#include <cstdio>
#include <cstdint>

#ifndef MK_N_LAUNCHES
#define MK_N_LAUNCHES 1
#endif

namespace pg8 {
#define PG8_LAS __attribute__((address_space(3)))
typedef unsigned short bf16_t;
typedef short bf16x8 __attribute__((ext_vector_type(8)));
typedef float f32x4 __attribute__((ext_vector_type(4)));
typedef unsigned u32x4 __attribute__((ext_vector_type(4)));
constexpr int BM = 256, BK = 64, HALF = 128, HTB = HALF * BK * 2  , STAGE_BYTES = 8 * HTB, NXCD = 8, WGM = 8;

__host__ __device__ __forceinline__ int lds_byte(int r, int c) { const int st = (r >> 4) * 2 + (c >> 5), rr = r & 15, cc = c & 31, ob = rr * 64 + cc * 2; return st * 1024 + (ob ^ (((ob >> 9) & 1) << 5)); }
__host__ __device__ __forceinline__ void stage_rc(int b, int& R, int& C) { const int st = b / 1024, sb = b % 1024, swz = sb ^ (((sb >> 9) & 1) << 5); R = (st >> 1) * 16 + swz / 64; C = (st & 1) * 32 + (swz % 64) / 2; }
__host__ __device__ __forceinline__ int perm32(int rho) { const int n = rho >> 4, i = rho & 15; return 8 * (i >> 2) + 4 * n + (i & 3); }

struct Unit { int pm, pn; };
struct Gemm { const bf16_t* A; const bf16_t* Bt; int M, N, K, lda, ldb; };

struct StaticOrder {
    int nM, nN, nwg, G, c;
    __host__ __device__ void init(int M, int N, int G_, int c_) { nM = M / BM; nN = N / BM; nwg = nM * nN; G = G_; c = c_; }
    __host__ __device__ bool next(int i, Unit& u) const {
        const long L = (long)i * G + c; if (L >= nwg) return false;
        int wgid = (int)L; { const int q = nwg / NXCD, r = nwg % NXCD, xcd = wgid % NXCD, off = wgid / NXCD; wgid = (xcd < r ? xcd * (q + 1) : r * (q + 1) + (xcd - r) * q) + off; }
        const int nig = WGM * nN, gid = wgid / nig, fm = gid * WGM, gsz = (nM - fm) < WGM ? (nM - fm) : WGM;
        u.pm = fm + ((wgid % nig) % gsz); u.pn = (wgid % nig) / gsz; return true;
    }
    __device__ __forceinline__ void a_ready(const Unit&) const {}
    __device__ __forceinline__ void done(const Unit&) const {}
};

__device__ __forceinline__ unsigned cvt_pk_bf16(float lo, float hi) { unsigned r; asm volatile("v_cvt_pk_bf16_f32 %0, %1, %2" : "=v"(r) : "v"(lo), "v"(hi)); return r; }

template <int ACT  > struct EpiBf16 {
    static constexpr bool PERM = true, AFTER_DRAIN = false;
    bf16_t* O; int ldc;
    __device__ __forceinline__ void operator()(const f32x4 (&acc)[2][2][4][2], const Unit& u, int wr, int wc, int fr, int fq) const {
        const int row0 = u.pm * BM + wr * 64 + fr; const int col0 = u.pn * BM + wc * 32 + 8 * fq;
#pragma unroll
        for (int ai = 0; ai < 2; ++ai)
#pragma unroll
            for (int m = 0; m < 4; ++m) { bf16_t* rowp = O + (size_t)(row0 + ai * HALF + m * 16) * ldc + col0;
#pragma unroll
                for (int bj = 0; bj < 2; ++bj) { f32x4 v0 = acc[ai][bj][m][0], v1 = acc[ai][bj][m][1];
                    if (ACT == 1) {
#pragma unroll
                        for (int j = 0; j < 4; ++j) { const float a = fmaxf(v0[j], 0.f), b = fmaxf(v1[j], 0.f); v0[j] = a * a; v1[j] = b * b; } }
                    u32x4 w; w.x = cvt_pk_bf16(v0[0], v0[1]); w.y = cvt_pk_bf16(v0[2], v0[3]); w.z = cvt_pk_bf16(v1[0], v1[1]); w.w = cvt_pk_bf16(v1[2], v1[3]);
                    *(u32x4*)(rowp + bj * HALF) = w; } }
    }
};
struct EpiNull { static constexpr bool PERM = true, AFTER_DRAIN = false;
    __device__ __forceinline__ void operator()(const f32x4 (&acc)[2][2][4][2], const Unit& u, int wr, int wc, int fr, int fq) const { _Pragma("unroll") for (int a = 0; a < 2; ++a) _Pragma("unroll") for (int b = 0; b < 2; ++b) _Pragma("unroll") for (int m = 0; m < 4; ++m) _Pragma("unroll") for (int n = 0; n < 2; ++n) asm volatile("" :: "v"(acc[a][b][m][n])); } };
struct EpiRes1 {
    static constexpr bool PERM = true, AFTER_DRAIN = false;
    const float* base_ctx; const float* base_lat; bf16_t* O; int ldo; const float* gate;
    __device__ __forceinline__ void operator()(const f32x4 (&acc)[2][2][4][2], const Unit& u, int wr, int wc, int fr, int fq) const {
        const int mt = u.pm * BM; const bool lat = mt >= 8192; const int b = lat ? 1 + ((mt - 8192) >> 10) : 0;
        const float* bp = lat ? base_lat + (size_t)(mt - 8192) * 4096 : base_ctx + (size_t)mt * 4096;
        const int rl0 = wr * 64 + fr, col0 = u.pn * BM + wc * 32 + 8 * fq;
        bf16_t* op = O + (size_t)mt * ldo;
        f32x4 gv[2][2];
#pragma unroll
        for (int bj = 0; bj < 2; ++bj)
#pragma unroll
            for (int n = 0; n < 2; ++n) gv[bj][n] = *(const f32x4*)(gate + (size_t)b * 24576 + col0 + bj * HALF + n * 4);
#pragma unroll
        for (int ai = 0; ai < 2; ++ai)
#pragma unroll
            for (int m = 0; m < 4; ++m) { const int row = rl0 + ai * HALF + m * 16; const size_t off = (size_t)row * 4096 + col0;
#pragma unroll
                for (int bj = 0; bj < 2; ++bj) { const f32x4 b0 = *(const f32x4*)(bp + off + bj * HALF), b1 = *(const f32x4*)(bp + off + bj * HALF + 4);
                    const f32x4 v0 = b0 + gv[bj][0] * acc[ai][bj][m][0], v1 = b1 + gv[bj][1] * acc[ai][bj][m][1];
                    u32x4 w; w.x = cvt_pk_bf16(v0[0], v0[1]); w.y = cvt_pk_bf16(v0[2], v0[3]); w.z = cvt_pk_bf16(v1[0], v1[1]); w.w = cvt_pk_bf16(v1[2], v1[3]);
                    *(u32x4*)(op + (size_t)row * ldo + col0 + bj * HALF) = w; }
                asm volatile("" ::: "memory"); }
    }
};
struct EpiRes2 {
    static constexpr bool PERM = true, AFTER_DRAIN = false;
    const bf16_t* X; int ldx; float* out; const float* gate;
    __device__ __forceinline__ void operator()(const f32x4 (&acc)[2][2][4][2], const Unit& u, int wr, int wc, int fr, int fq) const {
        const int mt = u.pm * BM; const bool lat = mt >= 8192; const int b = lat ? 1 + ((mt - 8192) >> 10) : 0;
        const int rl0 = wr * 64 + fr, col0 = u.pn * BM + wc * 32 + 8 * fq;
        const bf16_t* xp = X + (size_t)mt * ldx; float* op = out + (size_t)mt * 4096;
        f32x4 gv[2][2];
#pragma unroll
        for (int bj = 0; bj < 2; ++bj)
#pragma unroll
            for (int n = 0; n < 2; ++n) gv[bj][n] = *(const f32x4*)(gate + (size_t)b * 24576 + col0 + bj * HALF + n * 4);
#pragma unroll
        for (int ai = 0; ai < 2; ++ai)
#pragma unroll
            for (int m = 0; m < 4; ++m) { const int row = rl0 + ai * HALF + m * 16; const size_t off = (size_t)row * 4096 + col0;
#pragma unroll
                for (int bj = 0; bj < 2; ++bj) { const u32x4 xb = *(const u32x4*)(xp + (size_t)row * ldx + col0 + bj * HALF);
                    const f32x4 b0 = {__uint_as_float(xb.x << 16), __uint_as_float(xb.x & 0xffff0000u), __uint_as_float(xb.y << 16), __uint_as_float(xb.y & 0xffff0000u)};
                    const f32x4 b1 = {__uint_as_float(xb.z << 16), __uint_as_float(xb.z & 0xffff0000u), __uint_as_float(xb.w << 16), __uint_as_float(xb.w & 0xffff0000u)};
                    *(f32x4*)(op + off + bj * HALF) = b0 + gv[bj][0] * acc[ai][bj][m][0]; *(f32x4*)(op + off + bj * HALF + 4) = b1 + gv[bj][1] * acc[ai][bj][m][1]; }
                asm volatile("" ::: "memory"); }
    }
};

template <class Epi, class Sched, bool ALIGN_EPI = false, bool SP2 = false>
__device__ __forceinline__ void gemm_phase(PG8_LAS unsigned char* lds, const Gemm g, const Sched& S, const Epi& E) {
    int tid_l = threadIdx.x; asm volatile("" : "+v"(tid_l));
    const int tid = tid_l, wid = __builtin_amdgcn_readfirstlane(tid >> 6), lane = tid & 63, wr = wid >> 2, wc = wid & 3, fr = lane & 15, fq = lane >> 4;
    const int K = g.K, nt = K / BK;
    unsigned voffA[2], voffB[2];
#pragma unroll
    for (int i = 0; i < 2; ++i) { int R, C; stage_rc(tid * 16 + i * 8192, R, C); const int Rb = Epi::PERM ? ((R & ~31) + perm32(R & 31)) : R;
        voffA[i] = (unsigned)(R * g.lda + C) * 2u; voffB[i] = (unsigned)(Rb * g.ldb + C) * 2u; }
    const size_t kstep = (size_t)(BK * 2);
    const size_t hstepA = (size_t)HALF * g.lda * 2, hstepB = (size_t)HALF * g.ldb * 2;
    const size_t tstepA = 2 * hstepA, tstepB = 2 * hstepB;
    const unsigned ldsw = (unsigned)wid * 1024u;
    const int aoff = lds_byte(wr * 64 + fr, fq * 8), boff = lds_byte(wc * 32 + fr, fq * 8);
#define PG8_SA(b, h) (((b) * 2 + (h)) * HTB)
#define PG8_SB(b, h) ((4 + (b) * 2 + (h)) * HTB)
#define PG8_STAGE(bufoff, gbase, voff) do { _Pragma("unroll") for (int _i = 0; _i < 2; ++_i) \
        __builtin_amdgcn_global_load_lds((const unsigned*)((const char*)(gbase) + (voff)[_i]), (PG8_LAS unsigned*)(lds + (bufoff) + ldsw + _i * 8192), 16, 0, 0); } while (0)
#define PG8_LDA(dst, b, h) do { _Pragma("unroll") for (int m = 0; m < 4; ++m) _Pragma("unroll") for (int k = 0; k < 2; ++k) dst[m][k] = *(const PG8_LAS bf16x8*)(lds + PG8_SA(b, h) + aoff + m * 2048 + k * 1024); } while (0)
#define PG8_LDB(dst, b, h) do { _Pragma("unroll") for (int n = 0; n < 2; ++n) _Pragma("unroll") for (int k = 0; k < 2; ++k) dst[n][k] = *(const PG8_LAS bf16x8*)(lds + PG8_SB(b, h) + boff + n * 2048 + k * 1024); } while (0)
#define PG8_MMA(ai, bj, At, Bt) do { __builtin_amdgcn_s_setprio(1); _Pragma("unroll") for (int m = 0; m < 4; ++m) _Pragma("unroll") for (int n = 0; n < 2; ++n) _Pragma("unroll") for (int k = 0; k < 2; ++k) \
        acc[ai][bj][m][n] = __builtin_amdgcn_mfma_f32_16x16x32_bf16(Bt[n][k], At[m][k], acc[ai][bj][m][n], 0, 0, 0); __builtin_amdgcn_s_setprio(0); } while (0)
#define PG8_WAIT_V(n) asm volatile("s_waitcnt vmcnt(" #n ")" ::: "memory")
#define PG8_WAIT_L(n) asm volatile("s_waitcnt lgkmcnt(" #n ")" ::: "memory")
#define PG8_BAR __builtin_amdgcn_s_barrier()
#define PG8_SCHED __builtin_amdgcn_sched_barrier(0)
    Unit cur, nxt; int ui = 0;
    if (!S.next(0, cur)) return;
    f32x4 acc[2][2][4][2];
#pragma unroll
    for (int a = 0; a < 2; ++a)
#pragma unroll
        for (int b = 0; b < 2; ++b)
#pragma unroll
            for (int m = 0; m < 4; ++m)
#pragma unroll
                for (int n = 0; n < 2; ++n) acc[a][b][m][n] = (f32x4){0.f, 0.f, 0.f, 0.f};
    bf16x8 At[4][2], B0[2][2], B1[2][2];
    const char* cA = (const char*)g.A + (size_t)cur.pm * tstepA; const char* cB = (const char*)g.Bt + (size_t)cur.pn * tstepB;
    S.a_ready(cur);
    if constexpr (SP2) {
        PG8_STAGE(PG8_SB(0, 0), cB, voffB); PG8_STAGE(PG8_SB(0, 1), cB + hstepB, voffB); PG8_STAGE(PG8_SA(0, 0), cA, voffA); PG8_STAGE(PG8_SA(0, 1), cA + hstepA, voffA);
        if (wr == 1) PG8_BAR;
        PG8_WAIT_V(2); PG8_BAR;
        PG8_STAGE(PG8_SB(1, 0), cB + kstep, voffB); PG8_STAGE(PG8_SA(1, 0), cA + kstep, voffA); PG8_STAGE(PG8_SB(1, 1), cB + hstepB + kstep, voffB);
        PG8_WAIT_V(6); PG8_BAR;
    } else {
        PG8_STAGE(PG8_SB(0, 0), cB, voffB); PG8_STAGE(PG8_SA(0, 0), cA, voffA); PG8_STAGE(PG8_SB(0, 1), cB + hstepB, voffB); PG8_STAGE(PG8_SA(0, 1), cA + hstepA, voffA);
        if (wr == 1) PG8_BAR;
        PG8_WAIT_V(4); PG8_BAR;
        PG8_STAGE(PG8_SB(1, 0), cB + kstep, voffB); PG8_STAGE(PG8_SA(1, 0), cA + kstep, voffA); PG8_STAGE(PG8_SB(1, 1), cB + hstepB + kstep, voffB);
        PG8_WAIT_V(6); PG8_BAR;
    }
    for (;;) {
        const bool has_next = S.next(ui + 1, nxt);
        const char* nA = has_next ? (const char*)g.A + (size_t)nxt.pm * tstepA : cA; const char* nB = has_next ? (const char*)g.Bt + (size_t)nxt.pn * tstepB : cB;
        for (int t = 0; t < nt; t += 2) {
            const bool last = (t == nt - 2);
            const char* a1 = cA + (size_t)(t + 1) * kstep;
            const char* a2 = last ? nA : cA + (size_t)(t + 2) * kstep; const char* b2 = last ? nB : cB + (size_t)(t + 2) * kstep;
            const char* a3 = a2 + kstep; const char* b3 = b2 + kstep;
            if (last && has_next) S.a_ready(nxt);
            if constexpr (SP2) {
            PG8_LDB(B0, 0, 0); PG8_LDB(B1, 0, 1); PG8_SCHED; PG8_LDA(At, 0, 0); PG8_STAGE(PG8_SA(1, 1), a1 + hstepA, voffA);
            PG8_WAIT_V(8); PG8_WAIT_L(0); PG8_BAR; PG8_MMA(0, 0, At, B0); PG8_MMA(0, 1, At, B1); PG8_BAR; PG8_SCHED;
            PG8_LDA(At, 0, 1); PG8_STAGE(PG8_SB(0, 0), b2, voffB); PG8_STAGE(PG8_SB(0, 1), b2 + hstepB, voffB); PG8_STAGE(PG8_SA(0, 0), a2, voffA);
            PG8_WAIT_V(8); PG8_WAIT_L(0); PG8_BAR; PG8_MMA(1, 0, At, B0); PG8_MMA(1, 1, At, B1); PG8_BAR; PG8_SCHED;
            PG8_LDB(B0, 1, 0); PG8_LDB(B1, 1, 1); PG8_SCHED; PG8_LDA(At, 1, 0); PG8_STAGE(PG8_SA(0, 1), a2 + hstepA, voffA);
            PG8_WAIT_V(8); PG8_WAIT_L(0); PG8_BAR; PG8_MMA(0, 0, At, B0); PG8_MMA(0, 1, At, B1); PG8_BAR; PG8_SCHED;
            PG8_LDA(At, 1, 1); PG8_STAGE(PG8_SB(1, 0), b3, voffB); PG8_STAGE(PG8_SB(1, 1), b3 + hstepB, voffB); PG8_STAGE(PG8_SA(1, 0), a3, voffA);
            PG8_WAIT_V(8); PG8_WAIT_L(0); PG8_BAR; PG8_MMA(1, 0, At, B0); PG8_MMA(1, 1, At, B1); PG8_BAR; PG8_SCHED;
            } else {
            PG8_LDB(B0, 0, 0); PG8_SCHED; PG8_LDA(At, 0, 0); PG8_STAGE(PG8_SA(1, 1), a1 + hstepA, voffA);
            PG8_WAIT_L(8); PG8_BAR; PG8_WAIT_L(0); PG8_MMA(0, 0, At, B0); PG8_BAR; PG8_SCHED;
            PG8_LDB(B1, 0, 1); PG8_STAGE(PG8_SB(0, 0), b2, voffB);
            PG8_BAR; PG8_WAIT_L(0); PG8_MMA(0, 1, At, B1); PG8_BAR;
            PG8_LDA(At, 0, 1); PG8_STAGE(PG8_SA(0, 0), a2, voffA);
            PG8_BAR; PG8_WAIT_L(0); PG8_MMA(1, 0, At, B0); PG8_BAR; PG8_SCHED;
            PG8_STAGE(PG8_SB(0, 1), b2 + hstepB, voffB);
            PG8_WAIT_V(6); PG8_BAR; PG8_MMA(1, 1, At, B1); PG8_BAR;
            PG8_LDB(B0, 1, 0); PG8_SCHED; PG8_LDA(At, 1, 0); PG8_STAGE(PG8_SA(0, 1), a2 + hstepA, voffA);
            PG8_WAIT_L(8); PG8_BAR; PG8_WAIT_L(0); PG8_MMA(0, 0, At, B0); PG8_BAR; PG8_SCHED;
            PG8_LDB(B1, 1, 1); PG8_STAGE(PG8_SB(1, 0), b3, voffB);
            PG8_BAR; PG8_WAIT_L(0); PG8_MMA(0, 1, At, B1); PG8_BAR;
            PG8_LDA(At, 1, 1); PG8_STAGE(PG8_SA(1, 0), a3, voffA);
            PG8_BAR; PG8_WAIT_L(0); PG8_MMA(1, 0, At, B0); PG8_BAR; PG8_SCHED;
            PG8_STAGE(PG8_SB(1, 1), b3 + hstepB, voffB);
            PG8_WAIT_V(6); PG8_BAR; PG8_MMA(1, 1, At, B1); PG8_BAR;
            }
        }
        if constexpr (ALIGN_EPI) { if (wr == 0) PG8_BAR; }
        if constexpr (!Epi::AFTER_DRAIN) { E(acc, cur, wr, wc, fr, fq); S.done(cur); }
        if (!has_next) break;
#pragma unroll
        for (int a = 0; a < 2; ++a)
#pragma unroll
            for (int b = 0; b < 2; ++b)
#pragma unroll
                for (int m = 0; m < 4; ++m)
#pragma unroll
                    for (int n = 0; n < 2; ++n) acc[a][b][m][n] = (f32x4){0.f, 0.f, 0.f, 0.f};
        cur = nxt; cA = nA; cB = nB; ++ui;
        if constexpr (ALIGN_EPI) { if (wr == 1) PG8_BAR; }
    }
    PG8_WAIT_V(0);
    if constexpr (!ALIGN_EPI) { if (wr == 0) PG8_BAR; }
    PG8_BAR;
#undef PG8_SA
#undef PG8_SB
#undef PG8_STAGE
#undef PG8_LDA
#undef PG8_LDB
#undef PG8_MMA
#undef PG8_WAIT_V
#undef PG8_WAIT_L
#undef PG8_BAR
#undef PG8_SCHED
}
}

#ifndef PG8_SP2
#define PG8_SP2 true
#endif
#ifndef PG8_ALIGN
#define PG8_ALIGN true
#endif

constexpr int NWAVES = 8;
constexpr int DM = 4096, M_CTX = 8192, M_LAT = 4096, MTOT = M_CTX + M_LAT, NPROJ = 12288, DFF = 16384, DATT = 2048, NMODW = 6 * DM;
constexpr int LAT_SEQ = 1024, CTX_SEQ = 256, PAST = 256, NHEAD = 8, KV_LAT = LAT_SEQ + PAST;
constexpr int KB_ROWS = M_CTX + 4 * KV_LAT;
constexpr int LDX = DM + 64, LDH = DFF + 64, LDP = NPROJ + 64;
constexpr float EPS = 1e-6f;
constexpr int N_PHASES = 9;
constexpr int N_LAUNCHES = MK_N_LAUNCHES;

constexpr size_t MiB = 1u << 20;
constexpr size_t WS_CTL = 0, CTL_ZERO_BYTES = 1 * MiB;
constexpr size_t WS_MOD = 1 * MiB;
constexpr size_t WS_WIN = 2 * MiB;
constexpr size_t WS_WOUT = 100 * MiB;
constexpr size_t WS_W1 = 133 * MiB;
constexpr size_t WS_W2 = 263 * MiB;
constexpr size_t WS_XN = 392 * MiB;
constexpr size_t WS_CV = 490 * MiB;
constexpr size_t WS_PARK = 494 * MiB;
constexpr size_t WS_R = 526 * MiB;
constexpr size_t WS_PROJ = WS_R;
constexpr size_t WS_QB = WS_R + 290 * MiB;
constexpr size_t WS_KB = WS_R + 338 * MiB;
constexpr size_t WS_MIX = WS_R + 390 * MiB;
constexpr size_t WS_H = WS_R;
constexpr size_t WS_X1B = WS_R + 488 * MiB;
constexpr size_t WS_END = WS_X1B + 98 * MiB;
static_assert((size_t)MTOT * LDX * 2 <= 98 * MiB && (size_t)DM * LDX * 2 <= 33 * MiB && (size_t)DFF * LDX * 2 <= 130 * MiB && (size_t)DM * LDH * 2 <= 129 * MiB && (size_t)MTOT * LDP * 2 <= 290 * MiB, "ws map 1");
static_assert((size_t)KB_ROWS * DATT * 2 <= 52 * MiB && (size_t)MTOT * LDH * 2 <= 386 * MiB && WS_H + 386 * MiB <= WS_MIX, "ws map 2");
constexpr int CW_TMO = 0, CW_CODE = 1;
constexpr int CW_BAR = 4096;

constexpr int RING_OFF = 0, RING_BYTES = 131072;
constexpr int LDSCTL_OFF = RING_BYTES, MISC_OFF = LDSCTL_OFF + 320;
constexpr int LDS_BYTES = 147456;
static_assert(MISC_OFF + 128 <= LDS_BYTES, "LDS map");

#define GAS __attribute__((address_space(1)))
#define LAS __attribute__((address_space(3)))
typedef unsigned short bf16;
typedef unsigned v4u __attribute__((ext_vector_type(4)));
typedef unsigned v2u __attribute__((ext_vector_type(2)));
typedef float f32x4 __attribute__((ext_vector_type(4)));
typedef short bf16x8 __attribute__((ext_vector_type(8)));
typedef GAS unsigned gu32;
#define RLX_AGENT __ATOMIC_RELAXED, __HIP_MEMORY_SCOPE_AGENT
#define LDS_WAIT() asm volatile("s_waitcnt lgkmcnt(0)" ::: "memory")
#define VM_WAIT() asm volatile("s_waitcnt vmcnt(0)" ::: "memory")
__device__ __forceinline__ unsigned pk2(float lo, float hi) { return pg8::cvt_pk_bf16(lo, hi); }
__device__ __forceinline__ float bflo(unsigned w) { return __uint_as_float(w << 16); }
__device__ __forceinline__ float bfhi(unsigned w) { return __uint_as_float(w & 0xffff0000u); }

#define XB_TMO      128
#define XB_XCNT(j)  (256  + 64 * (j))
#define XB_XSUB(j)  (1280 + 64 * (j))
#define XB_XGEN(j)  (2304 + 64 * (j))
#define XB_TOP      3328
#define XB_TOPGEN   3392
#define XCD_BAR_WORDS 3456
#define XB_SPIN_CAP (1u << 18)

__device__ __forceinline__ unsigned xb_ld(unsigned* p)              { return __hip_atomic_load(p, __ATOMIC_RELAXED, __HIP_MEMORY_SCOPE_AGENT); }
__device__ __forceinline__ unsigned xb_add(unsigned* p, unsigned v) { return __hip_atomic_fetch_add(p, v, __ATOMIC_RELAXED, __HIP_MEMORY_SCOPE_AGENT); }
__device__ __forceinline__ unsigned xb_xcc_id() { return (unsigned)__builtin_amdgcn_s_getreg((3 << 11) | 20) & 0xFu; }
#define XB_SPIN(cond, bar) do { unsigned _sp = 0; while (cond) { __builtin_amdgcn_s_sleep(1); \
    if ((++_sp & 255u) == 0u) { if (xb_ld(&(bar)[XB_TMO])) break; if (_sp > XB_SPIN_CAP) { atomicAdd(&(bar)[XB_TMO], 1u); break; } } } } while (0)

struct XcdBarrier {
    unsigned* bar; unsigned x;
    volatile LAS unsigned* st;
};
__device__ __forceinline__ XcdBarrier xcd_barrier_post(unsigned* bar, volatile LAS unsigned* st) {
    XcdBarrier b; b.bar = bar; b.x = xb_xcc_id(); b.st = st;
    if (threadIdx.x == 0) (void)xb_add(&bar[XB_XCNT(b.x)], 1u);
    return b;
}
__device__ __forceinline__ void xcd_barrier_complete(unsigned* bar, unsigned x, unsigned& nloc, unsigned& nx) {
    const unsigned G = gridDim.x * gridDim.y * gridDim.z;
    unsigned sum, cnt, mine, sp = 0u;
    for (;;) {
        sum = 0u; cnt = 0u; mine = 0u;
#pragma unroll
        for (unsigned j = 0; j < 16; ++j) { const unsigned c = xb_ld(&bar[XB_XCNT(j)]); sum += c; cnt += (c > 0u) ? 1u : 0u; mine = (j == x) ? c : mine; }
        if (sum == G) break;
        __builtin_amdgcn_s_sleep(1);
        if ((++sp & 255u) == 0u) { if (xb_ld(&bar[XB_TMO])) break; if (sp > XB_SPIN_CAP) { atomicAdd(&bar[XB_TMO], 1u); break; } }
    }
    nloc = mine > 0u ? mine : 1u; nx = cnt > 0u ? cnt : 1u;
}
__device__ __forceinline__ void xcd_barrier(const XcdBarrier& b) {
    asm volatile("s_waitcnt vmcnt(0)" ::: "memory");
    __syncthreads();
    if (threadIdx.x == 0) {
        unsigned* bar = b.bar;
        __builtin_amdgcn_s_waitcnt(0);
        unsigned nloc = b.st[0], nx = b.st[1];
        if (nloc == 0u) { xcd_barrier_complete(bar, b.x, nloc, nx); b.st[0] = nloc; b.st[1] = nx; }
        const unsigned old = xb_add(&bar[XB_XSUB(b.x)], 1u);
        const unsigned gen = old / nloc;
        if (old + 1u == (gen + 1u) * nloc) {
            __builtin_amdgcn_fence(__ATOMIC_RELEASE, "agent");
            asm volatile("s_waitcnt vmcnt(0)" ::: "memory");
            const unsigned og = xb_add(&bar[XB_TOP], 1u);
            const unsigned tg = og / nx;
            if (og + 1u == (tg + 1u) * nx) xb_add(&bar[XB_TOPGEN], 1u);
            else XB_SPIN(xb_ld(&bar[XB_TOPGEN]) == tg, bar);
            __builtin_amdgcn_fence(__ATOMIC_ACQUIRE, "agent");
            xb_add(&bar[XB_XGEN(b.x)], 1u);
            asm volatile("s_waitcnt vmcnt(0)" ::: "memory");
        } else {
            XB_SPIN(xb_ld(&bar[XB_XGEN(b.x)]) == gen, bar);
            __builtin_amdgcn_fence(__ATOMIC_ACQUIRE, "agent");
            asm volatile("s_waitcnt vmcnt(0)" ::: "memory");
        }
    }
    __syncthreads();
}

struct Frame {
    LAS unsigned char* lds;
    volatile LAS unsigned* MISC;
    gu32* ctl;
    int tid, lane, wave;
    int vcu, G;
    const float *x_prompt, *x_sample, *cache_k, *cache_v, *c, *c_ctx, *w_ada, *b_ada, *norm_attn_g, *w_in, *q_norm_g, *k_norm_g;
    const float *lq1, *lk1, *lq2, *lk2, *subln_g, *conv_w, *w_out, *norm_mlp_g, *w_mlp_in, *w_mlp_out;
    float* out;
    float* MOD; float* PARK;
    bf16 *Win_t, *Wout_t, *W1_t, *W2_t, *XN, *CV, *PROJ, *QB, *KB, *MIX, *HB, *X1B;
};

#define RELAUNDER(F) do { int t_ = threadIdx.x; asm volatile("" : "+v"(t_)); F.tid = t_; F.lane = t_ & 63; F.wave = __builtin_amdgcn_readfirstlane(t_ >> 6); } while (0)
__device__ __forceinline__ float wave_sum(float v) {
#pragma unroll
    for (int o = 1; o < 64; o <<= 1) v += __shfl_xor(v, o);
    return v;
}

__device__ __forceinline__ void p0_transpose_item(const float* W, int K, int N, bf16* WT, LAS float* scr, int item, int lane) {
    const int nblk = N / 32, kb = item / nblk, nb = item % nblk, k0 = 64 * kb, n0 = 32 * nb;
#pragma unroll 8
    for (int i = 0; i < 32; ++i) { const int kk = 2 * i + (lane >> 5); scr[kk * 33 + (lane & 31)] = W[(size_t)(k0 + kk) * N + n0 + (lane & 31)]; }
    LDS_WAIT(); asm volatile("" ::: "memory");
    const int c = lane & 7;
#pragma unroll
    for (int j = 0; j < 4; ++j) { const int n = (lane >> 3) + 8 * j; const LAS float* s = scr + (8 * c) * 33 + n;
        v4u o; o.x = pk2(s[0 * 33], s[1 * 33]); o.y = pk2(s[2 * 33], s[3 * 33]); o.z = pk2(s[4 * 33], s[5 * 33]); o.w = pk2(s[6 * 33], s[7 * 33]);
        *(GAS v4u*)(WT + (size_t)(n0 + n) * K + k0 + 8 * c) = o; }
    LDS_WAIT(); asm volatile("" ::: "memory");
}
__device__ __forceinline__ void cvt_row2048(const float* src, bf16* dst, int lane) {
#pragma unroll
    for (int j = 0; j < 4; ++j) { const int col = 8 * (lane + 64 * j);
        const f32x4 a = *(const GAS f32x4*)(src + col), b = *(const GAS f32x4*)(src + col + 4);
        v4u o; o.x = pk2(a.x, a.y); o.y = pk2(a.z, a.w); o.z = pk2(b.x, b.y); o.w = pk2(b.z, b.w);
        *(GAS v4u*)(dst + col) = o; }
}
__device__ __forceinline__ float silu_f(float v) { return v / (1.f + __expf(-v)); }

__device__ __forceinline__ void p0_gemv(Frame& F) {
    RELAUNDER(F);
    LAS float* sl = (LAS float*)(F.lds);
    LAS float* red = (LAS float*)(F.lds + 81920);
    for (int i = F.tid; i < 5 * DM; i += NWAVES * 64) { const int b = i / DM, k = i % DM; const float v = (b == 0) ? F.c_ctx[k] : F.c[(b - 1) * DM + k]; sl[i] = silu_f(v); }
    __syncthreads();
    for (int jt = blockIdx.x; jt < NMODW / 96; jt += F.G) {
        const int jl = F.lane % 24, rg = F.lane / 24; const bool act = F.lane < 48;
        const float* wp = F.w_ada + (size_t)(2 * F.wave + (act ? rg : 0)) * NMODW + 96 * jt + 4 * jl;
        f32x4 acc[5];
#pragma unroll
        for (int b = 0; b < 5; ++b) acc[b] = (f32x4){0.f, 0.f, 0.f, 0.f};
        for (int it = 0; it < 256; it += 16) {
            f32x4 w[16];
#pragma unroll
            for (int u = 0; u < 16; ++u) w[u] = *(const GAS f32x4*)(wp + (size_t)(it + u) * 16 * NMODW);
            __builtin_amdgcn_sched_barrier(0);
#pragma unroll
            for (int u = 0; u < 16; ++u) { const int k = 2 * F.wave + (act ? rg : 0) + 16 * (it + u);
#pragma unroll
                for (int b = 0; b < 5; ++b) { const float s = sl[b * DM + k]; acc[b] += w[u] * s; } }
        }
        if (act) {
#pragma unroll
            for (int b = 0; b < 5; ++b)
#pragma unroll
                for (int e = 0; e < 4; ++e) red[(F.wave * 48 + F.lane) * 20 + b * 4 + e] = acc[b][e];
        }
        __syncthreads();
        RELAUNDER(F);
        if (F.tid < 480) { const int b = F.tid / 96, jj = F.tid % 96, jl2 = jj >> 2, e = jj & 3; float s = 0.f;
#pragma unroll
            for (int w = 0; w < 8; ++w) s += red[(w * 48 + jl2) * 20 + b * 4 + e] + red[(w * 48 + 24 + jl2) * 20 + b * 4 + e];
            F.MOD[(size_t)b * NMODW + 96 * jt + jj] = s + F.b_ada[96 * jt + jj]; }
        __syncthreads();
    }
    __syncthreads();
}
__device__ __forceinline__ void p0_weights(Frame& F) {
    RELAUNDER(F);
    LAS float* scr = (LAS float*)(F.lds + RING_OFF + F.wave * 16384);
    const int gw = F.vcu * NWAVES + F.wave, NGW = F.G * NWAVES;
    constexpr int I_IN = (DM / 64) * (NPROJ / 32), I_O = (DM / 64) * (DM / 32), I_1 = (DM / 64) * (DFF / 32), I_2 = (DFF / 64) * (DM / 32);
    constexpr int NITEMS = I_IN + I_O + I_1 + I_2;
#define P0_DECODE(it_, src_, N_, dst_, K_) do { int r_ = (it_); const float* W_; bf16* T_; \
        if (r_ < I_IN) { W_ = F.w_in; T_ = F.Win_t; K_ = LDX; N_ = NPROJ; } else { r_ -= I_IN; \
        if (r_ < I_O) { W_ = F.w_out; T_ = F.Wout_t; K_ = LDX; N_ = DM; } else { r_ -= I_O; \
        if (r_ < I_1) { W_ = F.w_mlp_in; T_ = F.W1_t; K_ = LDX; N_ = DFF; } else { r_ -= I_1; W_ = F.w_mlp_out; T_ = F.W2_t; K_ = LDH; N_ = DM; } } } \
        const int nblk_ = N_ / 32, kb_ = r_ / nblk_, nb_ = r_ % nblk_; src_ = W_ + (size_t)(64 * kb_) * N_ + 32 * nb_; dst_ = T_ + (size_t)(32 * nb_) * K_ + 64 * kb_; } while (0)
#define P0_LOAD(v_, src_, N_) do { const float* p_ = (src_) + (size_t)(F.lane >> 5) * (N_) + (F.lane & 31); _Pragma("unroll") for (int i_ = 0; i_ < 32; ++i_) v_[i_] = *(const GAS float*)(p_ + (size_t)(2 * i_) * (N_)); __builtin_amdgcn_sched_barrier(0); } while (0)
    {
        int it = gw; bool have = it < NITEMS; float cur[32], nxt[32];
        const float* src = F.w_in; bf16* dst = F.Win_t; int K = LDX, N = NPROJ;
        if (have) { P0_DECODE(it, src, N, dst, K); P0_LOAD(cur, src, N); }
        while (have) {
            const int itn = it + NGW; const bool hn = itn < NITEMS;
            const float* srcn = src; bf16* dstn = dst; int Kn = K, Nn = N;
            if (hn) { P0_DECODE(itn, srcn, Nn, dstn, Kn); P0_LOAD(nxt, srcn, Nn); }
#pragma unroll
            for (int i = 0; i < 32; ++i) scr[(2 * i + (F.lane >> 5)) * 33 + (F.lane & 31)] = cur[i];
            LDS_WAIT(); asm volatile("" ::: "memory");
            const int c = F.lane & 7;
#pragma unroll
            for (int j = 0; j < 4; ++j) { const int n = (F.lane >> 3) + 8 * j; const LAS float* sp = scr + (8 * c) * 33 + n;
                v4u o; o.x = pk2(sp[0 * 33], sp[1 * 33]); o.y = pk2(sp[2 * 33], sp[3 * 33]); o.z = pk2(sp[4 * 33], sp[5 * 33]); o.w = pk2(sp[6 * 33], sp[7 * 33]);
                *(GAS v4u*)(dst + (size_t)n * K + 8 * c) = o; }
            LDS_WAIT(); asm volatile("" ::: "memory");
#pragma unroll
            for (int i = 0; i < 32; ++i) cur[i] = nxt[i];
            it = itn; have = hn; dst = dstn; K = Kn;
        }
    }
#undef P0_DECODE
#undef P0_LOAD
    for (int r = gw; r < 2 * 4 * PAST; r += NGW) {
        if (r < 4 * PAST) { const int b = r / PAST, j = r % PAST; cvt_row2048(F.cache_k + (size_t)r * DATT, F.KB + (size_t)(M_CTX + b * KV_LAT + LAT_SEQ + j) * DATT, F.lane); }
        else { const int rr = r - 4 * PAST; cvt_row2048(F.cache_v + (size_t)rr * DATT, F.CV + (size_t)rr * DATT, F.lane); }
    }
}

__device__ __forceinline__ void unpack8(const v4u w, float (&f)[8]) { f[0] = bflo(w.x); f[1] = bfhi(w.x); f[2] = bflo(w.y); f[3] = bfhi(w.y); f[4] = bflo(w.z); f[5] = bfhi(w.z); f[6] = bflo(w.w); f[7] = bfhi(w.w); }
__device__ __forceinline__ v4u pack8(const float (&f)[8]) { v4u o; o.x = pk2(f[0], f[1]); o.y = pk2(f[2], f[3]); o.z = pk2(f[4], f[5]); o.w = pk2(f[6], f[7]); return o; }
template <int WHICH> __device__ __forceinline__ void norm_mod_phase(Frame& F) {
    RELAUNDER(F);
    LAS float* gs = (LAS float*)(F.lds);
    LAS float* sh = (LAS float*)(F.lds + 16384);
    const float* g = WHICH ? F.norm_mlp_g : F.norm_attn_g;
    const int NR = MTOT / 8;
    const int r_lo = (int)(((long)blockIdx.x * NR) / F.G), r_hi = (int)(((long)(blockIdx.x + 1) * NR) / F.G);
    int cur_b = -1;
    for (int r8 = r_lo; r8 < r_hi; ++r8) {
        const int m0 = r8 * 8; const int b = m0 < M_CTX ? 0 : 1 + ((m0 - M_CTX) >> 10);
        if (b != cur_b) {
            __syncthreads();
            const float* scp = F.MOD + (size_t)b * NMODW + (WHICH ? 4 : 1) * DM; const float* shp = F.MOD + (size_t)b * NMODW + (WHICH ? 3 : 0) * DM;
            for (int i = F.tid; i < DM; i += NWAVES * 64) { gs[i] = g[i] * (1.f + scp[i]); sh[i] = shp[i]; }
            __syncthreads(); cur_b = b;
        }
        const int m = m0 + F.wave;
        if (WHICH == 0) {
            const float* xrow = m < M_CTX ? F.x_prompt + (size_t)m * DM : F.x_sample + (size_t)(m - M_CTX) * DM;
            const GAS f32x4* xr = (const GAS f32x4*)xrow + F.lane;
            f32x4 v[16]; float s = 0.f;
#pragma unroll
            for (int j = 0; j < 16; ++j) { v[j] = xr[64 * j]; }
#pragma unroll
            for (int j = 0; j < 16; ++j) { s += (v[j].x * v[j].x + v[j].y * v[j].y) + (v[j].z * v[j].z + v[j].w * v[j].w); }
            const float rstd = 1.f / sqrtf(wave_sum(s) * (1.f / DM) + EPS);
            GAS v2u* o8 = (GAS v2u*)(F.XN + (size_t)m * LDX) + F.lane;
#pragma unroll
            for (int j = 0; j < 16; ++j) { const f32x4 gg = *(const LAS f32x4*)(gs + 4 * (F.lane + 64 * j)), ss = *(const LAS f32x4*)(sh + 4 * (F.lane + 64 * j));
                const f32x4 y = v[j] * rstd * gg + ss; v2u w; w.x = pk2(y.x, y.y); w.y = pk2(y.z, y.w); o8[64 * j] = w; }
        } else {
            const GAS v4u* xr = (const GAS v4u*)(F.X1B + (size_t)m * LDX) + F.lane;
            v4u xv[8]; float s = 0.f;
#pragma unroll
            for (int j = 0; j < 8; ++j) xv[j] = xr[64 * j];
            float f[8][8];
#pragma unroll
            for (int j = 0; j < 8; ++j) { unpack8(xv[j], f[j]);
#pragma unroll
                for (int e = 0; e < 8; ++e) s += f[j][e] * f[j][e]; }
            const float rstd = 1.f / sqrtf(wave_sum(s) * (1.f / DM) + EPS);
            GAS v4u* o16 = (GAS v4u*)(F.XN + (size_t)m * LDX) + F.lane;
#pragma unroll
            for (int j = 0; j < 8; ++j) { const int col = 8 * (F.lane + 64 * j);
                const f32x4 g0 = *(const LAS f32x4*)(gs + col), g1 = *(const LAS f32x4*)(gs + col + 4), s0 = *(const LAS f32x4*)(sh + col), s1 = *(const LAS f32x4*)(sh + col + 4);
                float y[8];
#pragma unroll
                for (int e = 0; e < 4; ++e) { y[e] = f[j][e] * rstd * g0[e] + s0[e]; y[4 + e] = f[j][4 + e] * rstd * g1[e] + s1[e]; }
                o16[64 * j] = pack8(y); }
        }
    }
}


__device__ __forceinline__ void post_proj_phase(Frame& F) {
    RELAUNDER(F);
    float* new_k = F.out + (size_t)MTOT * DM; float* new_v = new_k + (size_t)M_CTX * DATT;
    const int l8 = F.lane & 7, ax = l8 >> 2, i0 = (l8 & 3) * 8;
    float inv[8];
#pragma unroll
    for (int j = 0; j < 8; ++j) inv[j] = exp2f(-(float)(2 * (i0 + j)) * (13.287712379549449f / 64.f));
    const int NR = MTOT / 8;
    const int r_lo = (int)(((long)blockIdx.x * NR) / F.G), r_hi = (int)(((long)(blockIdx.x + 1) * NR) / F.G);
    for (int r8 = r_lo; r8 < r_hi; ++r8) {
        const int m = r8 * 8 + F.wave; const bool lat = m >= M_CTX;
        const int t = lat ? ((m - M_CTX) & (LAT_SEQ - 1)) : (m & (CTX_SEQ - 1)); const int L = lat ? LAT_SEQ : CTX_SEQ;
        const int krow = lat ? (M_CTX + ((m - M_CTX) >> 10) * KV_LAT + t) : m;
        const bf16* prow = F.PROJ + (size_t)m * LDP;
#pragma unroll
        for (int part = 0; part < 2; ++part) {
            const float* gn = part ? F.k_norm_g : F.q_norm_g;
            float g1[8], g2[8];
#pragma unroll
            for (int j = 0; j < 8; ++j) { g1[j] = gn[ax * 64 + i0 + j]; g2[j] = gn[ax * 64 + 32 + i0 + j]; }
#pragma unroll
            for (int pass = 0; pass < 2; ++pass) {
                const int gidx = pass * 8 + (F.lane >> 3); const int cb = gidx * 128 + ax * 64 + i0;
                float x1[8], x2[8];
                unpack8(*(const GAS v4u*)(prow + part * DATT + cb), x1); unpack8(*(const GAS v4u*)(prow + part * DATT + cb + 32), x2);
                float ss = 0.f;
#pragma unroll
                for (int j = 0; j < 8; ++j) ss += x1[j] * x1[j] + x2[j] * x2[j];
                ss += __shfl_xor(ss, 1); ss += __shfl_xor(ss, 2); ss += __shfl_xor(ss, 4);
                const float rstd = 1.f / sqrtf(ss * (1.f / 128.f) + EPS);
#pragma unroll
                for (int j = 0; j < 8; ++j) { x1[j] = x1[j] * rstd * g1[j]; x2[j] = x2[j] * rstd * g2[j]; }
                if (part == 1 && !lat) {
                    float* nk = new_k + (size_t)m * DATT + cb;
                    *(GAS f32x4*)(nk) = (f32x4){x1[0], x1[1], x1[2], x1[3]}; *(GAS f32x4*)(nk + 4) = (f32x4){x1[4], x1[5], x1[6], x1[7]};
                    *(GAS f32x4*)(nk + 32) = (f32x4){x2[0], x2[1], x2[2], x2[3]}; *(GAS f32x4*)(nk + 36) = (f32x4){x2[4], x2[5], x2[6], x2[7]};
                }
                if (lat) {
                    const float pos = (float)(ax == 0 ? (t >> 6) : (t & 63));
#pragma unroll
                    for (int j = 0; j < 8; ++j) { const float ang = pos * inv[j]; const float cs = __cosf(ang), sn = __sinf(ang);
                        const float a = x1[j], b = x2[j]; x1[j] = a * cs - b * sn; x2[j] = a * sn + b * cs; }
                }
                bf16* dst = part ? (F.KB + (size_t)krow * DATT + cb) : (F.QB + (size_t)m * DATT + cb);
                *(GAS v4u*)(dst) = pack8(x1); *(GAS v4u*)(dst + 32) = pack8(x2);
            }
        }
        if (!lat) {
#pragma unroll
            for (int j = 0; j < 4; ++j) { const int col = 8 * (F.lane + 64 * j); float f[8]; unpack8(*(const GAS v4u*)(prow + 2 * DATT + col), f);
                float* nv = new_v + (size_t)m * DATT + col;
                *(GAS f32x4*)(nv) = (f32x4){f[0], f[1], f[2], f[3]}; *(GAS f32x4*)(nv + 4) = (f32x4){f[4], f[5], f[6], f[7]}; }
        }
#pragma unroll
        for (int p = 0; p < 4; ++p) {
            const int ch = 8 * (F.lane + 64 * p);
            float bg[8], c0[8], u0[8], cm[8], um[8], cp[8], up[8];
            unpack8(*(const GAS v4u*)(prow + 3 * DATT + ch), bg);
            unpack8(*(const GAS v4u*)(prow + 4 * DATT + ch), c0); unpack8(*(const GAS v4u*)(prow + 5 * DATT + ch), u0);
            const bool hm = t > 0, hp = t < L - 1;
            const bf16* pm_ = hm ? prow - LDP : prow; const bf16* pp_ = hp ? prow + LDP : prow;
            unpack8(*(const GAS v4u*)(pm_ + 4 * DATT + ch), cm); unpack8(*(const GAS v4u*)(pm_ + 5 * DATT + ch), um);
            unpack8(*(const GAS v4u*)(pp_ + 4 * DATT + ch), cp); unpack8(*(const GAS v4u*)(pp_ + 5 * DATT + ch), up);
            const float fm = hm ? 1.f : 0.f, fp = hp ? 1.f : 0.f;
            const f32x4 w0a = *(const GAS f32x4*)(F.conv_w + ch), w0b = *(const GAS f32x4*)(F.conv_w + ch + 4);
            const f32x4 w1a = *(const GAS f32x4*)(F.conv_w + DATT + ch), w1b = *(const GAS f32x4*)(F.conv_w + DATT + ch + 4);
            const f32x4 w2a = *(const GAS f32x4*)(F.conv_w + 2 * DATT + ch), w2b = *(const GAS f32x4*)(F.conv_w + 2 * DATT + ch + 4);
            float y[8];
#pragma unroll
            for (int j = 0; j < 8; ++j) { const float w0 = j < 4 ? w0a[j & 3] : w0b[j & 3], w1 = j < 4 ? w1a[j & 3] : w1b[j & 3], w2 = j < 4 ? w2a[j & 3] : w2b[j & 3];
                y[j] = bg[j] * (w0 * (cm[j] * um[j]) * fm + w1 * (c0[j] * u0[j]) + w2 * (cp[j] * up[j]) * fp); }
            *(GAS v4u*)(F.MIX + (size_t)m * LDX + DATT + ch) = pack8(y);
        }
    }
}

namespace att {
using s16x4  = __attribute__((ext_vector_type(4))) short;
using f32x16 = __attribute__((ext_vector_type(16))) float;
constexpr int KVBLK = 64;
constexpr float SCALE = 0.088388347648318440f;
constexpr float THR = 8.f;
constexpr int SHM_K = KVBLK * 128 * 2, SHM_V = KVBLK * 256 * 2;
constexpr int OFF_V = 0, OFF_K = 2 * SHM_V, OFF_WS = OFF_K + 2 * SHM_K, OFF_SSQ = OFF_WS + NWAVES * 256, ATT_LDS = OFF_SSQ + 128 * 2 * 4;
static_assert(ATT_LDS <= RING_BYTES, "attention LDS");
#define KSWZ(row, colB) ((row) * 256 + ((colB) ^ (((row) & 7) << 4)))
#define SBAR() __builtin_amdgcn_sched_barrier(0)
__device__ __forceinline__ int crow(int r, int hi) { return (r & 3) + 8 * (r >> 2) + 4 * hi; }
__device__ __forceinline__ unsigned cvtpk(float lo, float hi) { unsigned r; asm volatile("v_cvt_pk_bf16_f32 %0, %1, %2" : "=v"(r) : "v"(lo), "v"(hi)); return r; }

__device__ __forceinline__ void partialSM(f32x16& p0, f32x16& p1, float& m_reg, float& mn, float& alpha) {
  constexpr float C = SCALE * 1.4426950408889634f;
  float pmax = p0[0];
#pragma unroll
  for (int r = 1; r < 16; ++r) pmax = fmaxf(pmax, p0[r]);
#pragma unroll
  for (int r = 0; r < 16; ++r) pmax = fmaxf(pmax, p1[r]);
  { auto rr = __builtin_amdgcn_permlane32_swap(__float_as_uint(pmax), __float_as_uint(pmax), false, false);
    pmax = fmaxf(__uint_as_float(rr[0]), __uint_as_float(rr[1])); }
  if (__builtin_expect(__all(pmax - m_reg <= THR / SCALE), 1)) { mn = m_reg; alpha = 1.f; }
  else { mn = fmaxf(m_reg, pmax); alpha = __builtin_amdgcn_exp2f((m_reg - mn) * C); m_reg = mn; }
  float mnC = -mn * C;
#pragma unroll
  for (int r = 0; r < 16; ++r) p0[r] = fmaf(p0[r], C, mnC);
#pragma unroll
  for (int r = 0; r < 16; ++r) p1[r] = fmaf(p1[r], C, mnC);
#pragma unroll
  for (int r = 0; r < 16; ++r) p0[r] = __builtin_amdgcn_exp2f(p0[r]);
}
__device__ __forceinline__ void finishSM(f32x16& p0, f32x16& p1, float alpha, float& l_reg, bf16x8& pa0, bf16x8& pa1, bf16x8& pa2, bf16x8& pa3) {
#pragma unroll
  for (int r = 0; r < 16; ++r) p1[r] = __builtin_amdgcn_exp2f(p1[r]);
  float ps = 0;
#pragma unroll
  for (int r = 0; r < 16; ++r) ps += p0[r];
#pragma unroll
  for (int r = 0; r < 16; ++r) ps += p1[r];
  { auto rr = __builtin_amdgcn_permlane32_swap(__float_as_uint(ps), __float_as_uint(ps), false, false);
    ps = __uint_as_float(rr[0]) + __uint_as_float(rr[1]); }
  l_reg = l_reg * alpha + ps;
#define PK4(P, BASE, OUT) do { unsigned a0 = cvtpk(P[BASE + 0], P[BASE + 1]), a1 = cvtpk(P[BASE + 2], P[BASE + 3]);   \
    unsigned b0 = cvtpk(P[BASE + 4], P[BASE + 5]), b1 = cvtpk(P[BASE + 6], P[BASE + 7]);                              \
    auto r0 = __builtin_amdgcn_permlane32_swap(a0, b0, false, false); auto r1 = __builtin_amdgcn_permlane32_swap(a1, b1, false, false); \
    v4u w = {r0[0], r1[0], r0[1], r1[1]}; OUT = *reinterpret_cast<bf16x8*>(&w); } while (0)
  PK4(p0, 0, pa0); PK4(p0, 8, pa1); PK4(p1, 0, pa2); PK4(p1, 8, pa3);
#undef PK4
}
__device__ __forceinline__ void qkt(f32x16& p0, f32x16& p1, const LAS char* Ks, const bf16x8* qr, int r32, int hi) {
  p0 = f32x16{}; p1 = f32x16{};
#pragma unroll
  for (int d0 = 0; d0 < 8; ++d0) { int cb = (d0 * 16 + hi * 8) * 2;
    bf16x8 b0 = *reinterpret_cast<const LAS bf16x8*>(Ks + KSWZ(r32, cb));
    bf16x8 b1 = *reinterpret_cast<const LAS bf16x8*>(Ks + KSWZ(32 + r32, cb));
    p0 = __builtin_amdgcn_mfma_f32_32x32x16_bf16(b0, qr[d0], p0, 0, 0, 0);
    p1 = __builtin_amdgcn_mfma_f32_32x32x16_bf16(b1, qr[d0], p1, 0, 0, 0); }
}
__device__ __forceinline__ int v_st(int k, int c) { const int kk = (k & ~0xC) | ((k & 4) << 1) | ((k & 8) >> 1); return ((kk >> 3) * 4 + (c >> 5)) * 512 + ((kk & 7) * 32 + (c & 31)) * 2; }
__device__ __forceinline__ int v_rd_base(int lane) { return ((lane & 3) << 3) | (((lane >> 2) & 3) << 6) | (((lane >> 4) & 1) << 5) | (((lane >> 5) & 1) << 8); }
constexpr int v_rd_off(int d0, int ks, int half) { return d0 * 512 + ks * 4096 + half * 2048; }
template <int OFF> __device__ __forceinline__ s16x4 tr_read(int vb) {
  s16x4 r; asm volatile("ds_read_b64_tr_b16 %0, %1 offset:%2" : "=&v"(r) : "v"(vb), "i"(OFF) : "memory"); return r;
}
template <int D0> __device__ __forceinline__ void pv_one(f32x16& od, int vb, bf16x8 pa0, bf16x8 pa1, bf16x8 pa2, bf16x8 pa3) {
  const s16x4 l0 = tr_read<v_rd_off(D0, 0, 0)>(vb), h0 = tr_read<v_rd_off(D0, 0, 1)>(vb), l1 = tr_read<v_rd_off(D0, 1, 0)>(vb), h1 = tr_read<v_rd_off(D0, 1, 1)>(vb);
  const s16x4 l2 = tr_read<v_rd_off(D0, 2, 0)>(vb), h2 = tr_read<v_rd_off(D0, 2, 1)>(vb), l3 = tr_read<v_rd_off(D0, 3, 0)>(vb), h3 = tr_read<v_rd_off(D0, 3, 1)>(vb);
  asm volatile("s_waitcnt lgkmcnt(0)" ::: "memory"); SBAR();
#define PK(L, H) (bf16x8){L[0], L[1], L[2], L[3], H[0], H[1], H[2], H[3]}
  od = __builtin_amdgcn_mfma_f32_32x32x16_bf16(pa0, PK(l0, h0), od, 0, 0, 0);
  od = __builtin_amdgcn_mfma_f32_32x32x16_bf16(pa1, PK(l1, h1), od, 0, 0, 0);
  od = __builtin_amdgcn_mfma_f32_32x32x16_bf16(pa2, PK(l2, h2), od, 0, 0, 0);
  od = __builtin_amdgcn_mfma_f32_32x32x16_bf16(pa3, PK(l3, h3), od, 0, 0, 0);
#undef PK
}
__device__ __forceinline__ void pv_d0(f32x16* o, int vb, bf16x8 pa0, bf16x8 pa1, bf16x8 pa2, bf16x8 pa3) {
  pv_one<0>(o[0], vb, pa0, pa1, pa2, pa3); pv_one<1>(o[1], vb, pa0, pa1, pa2, pa3); pv_one<2>(o[2], vb, pa0, pa1, pa2, pa3); pv_one<3>(o[3], vb, pa0, pa1, pa2, pa3);
}

__device__ __forceinline__ void attn_unit(const bf16* Qp, const bf16* Kp, const bf16* V0p, int nself, const bf16* V1p, int nkeys, bf16* Op,
                                          float* park, const float* subln_g, float lam, float oscale, LAS char* lds) {
  int tid_l = threadIdx.x; asm volatile("" : "+v"(tid_l));
  const int tid = tid_l, wid = __builtin_amdgcn_readfirstlane(tid >> 6), lane = tid & 63, r32 = lane & 31, hi = lane >> 5, rg = wid >> 1, e = wid & 1;
  LAS char* V_lds = lds + OFF_V; LAS char* K_lds = lds + OFF_K;
  LAS float* wsf = (LAS float*)(lds + OFF_WS) + wid * 64; LAS float* li_l = wsf; LAS float* al_l = wsf + 32;
  LAS float* ssq = (LAS float*)(lds + OFF_SSQ);
  const int sr = tid >> 4, sc = (tid & 15) * 8, vst0 = v_st(sr, sc), vst1 = v_st(32 + sr, sc);
  const int vb0 = (int)(unsigned)(uintptr_t)(V_lds + e * (SHM_V / 2)) + v_rd_base(lane);
  const int NT = nkeys / KVBLK;
  const unsigned voS = (unsigned)(sr * LDP + sc), voC = (unsigned)(sr * DATT + sc);
  f32x16 o[4];
  float rli[16];
  for (int c = 0; c < 2; ++c) {
    float m_reg = -1e30f, l_reg = 0;
#pragma unroll
    for (int d = 0; d < 4; ++d) o[d] = f32x16{};
    bf16x8 qr[8];
    { const bf16* Qw = Qp + (size_t)(rg * 32 + r32) * DATT + c * 128 + hi * 8;
#pragma unroll
      for (int d0 = 0; d0 < 8; ++d0) qr[d0] = *(const GAS bf16x8*)(Qw + d0 * 16); }
    const bf16* Kh = Kp + c * 128;
    bf16x8 vs0, vs1, vs2, vs3, ks0, ks1;
#define SLOAD(k0) do { const int kk_ = (k0); const bool self_ = kk_ < nself; \
    const bf16* vu_ = self_ ? V0p + (size_t)kk_ * LDP : V1p + (size_t)(kk_ - nself) * DATT; const unsigned vo_ = self_ ? voS : voC, vst_ = self_ ? 32u * LDP : 32u * DATT; \
    vs0 = *(const GAS bf16x8*)(vu_ + vo_); vs1 = *(const GAS bf16x8*)(vu_ + (vo_ + 128u)); vs2 = *(const GAS bf16x8*)(vu_ + (vo_ + vst_)); vs3 = *(const GAS bf16x8*)(vu_ + (vo_ + vst_ + 128u)); \
    const bf16* ku_ = Kh + (size_t)kk_ * DATT; ks0 = *(const GAS bf16x8*)(ku_ + voC); ks1 = *(const GAS bf16x8*)(ku_ + (voC + 32u * DATT)); } while (0)
#define SWRITE(b) do { LAS char* vb_ = V_lds + (b) * SHM_V; LAS char* kb_ = K_lds + (b) * SHM_K; const int kc = sc * 2; \
    *(LAS bf16x8*)(vb_ + vst0) = vs0; *(LAS bf16x8*)(vb_ + SHM_V / 2 + vst0) = vs1; *(LAS bf16x8*)(vb_ + vst1) = vs2; *(LAS bf16x8*)(vb_ + SHM_V / 2 + vst1) = vs3; \
    *(LAS bf16x8*)(kb_ + KSWZ(sr, kc)) = ks0; *(LAS bf16x8*)(kb_ + KSWZ(32 + sr, kc)) = ks1; } while (0)
#define SWAIT() asm volatile("s_waitcnt vmcnt(0)" ::: "memory")
#define RESC(a) do { if (__any((a) < 1.f)) { if (hi == 0) al_l[r32] = (a); asm volatile("s_waitcnt lgkmcnt(0)" ::: "memory"); \
    _Pragma("unroll") for (int d = 0; d < 4; ++d) _Pragma("unroll") for (int r = 0; r < 16; ++r) o[d][r] *= al_l[crow(r, hi)]; } } while (0)
    f32x16 p0, p1; float mn, al; bf16x8 pa0, pa1, pa2, pa3;
    __syncthreads();
    SLOAD(0); SWAIT(); SWRITE(0); __syncthreads();
    for (int j = 0; j < NT; ++j) {
      const int buf = j & 1; const bool more = j + 1 < NT;
      if (more) SLOAD((j + 1) * KVBLK);
      SBAR(); qkt(p0, p1, K_lds + buf * SHM_K, qr, r32, hi);
      partialSM(p0, p1, m_reg, mn, al);
      RESC(al);
      finishSM(p0, p1, al, l_reg, pa0, pa1, pa2, pa3); SBAR();
      pv_d0(o, vb0 + buf * SHM_V, pa0, pa1, pa2, pa3);
      if (more) { SWAIT(); SWRITE(buf ^ 1); }
      __syncthreads();
    }
#undef SLOAD
#undef SWRITE
#undef SWAIT
#undef RESC
    int hi_ = hi, r32_ = r32, wid_ = wid; asm volatile("" : "+v"(hi_), "+v"(r32_), "+s"(wid_));
    LAS float* li2 = (LAS float*)(lds + OFF_WS) + wid_ * 64;
    if (hi_ == 0) li2[r32_] = l_reg; asm volatile("s_waitcnt lgkmcnt(0)" ::: "memory");
#pragma unroll
    for (int r = 0; r < 16; ++r) rli[r] = __builtin_amdgcn_rcpf(li2[crow(r, hi_)]);
    if (c == 0) {
      float* pk = park + (size_t)wid_ * 4096 + (hi_ * 32 + r32_);
#pragma unroll
      for (int d = 0; d < 4; ++d)
#pragma unroll
        for (int r = 0; r < 16; ++r) pk[(d * 16 + r) * 64] = o[d][r] * rli[r];
    }
  }
  int hi_ = hi, r32_ = r32, wid_ = wid; asm volatile("" : "+v"(hi_), "+v"(r32_), "+s"(wid_));
  const int rg_ = wid_ >> 1, e_ = wid_ & 1;
  const float* pk = park + (size_t)wid_ * 4096 + (hi_ * 32 + r32_);
  asm volatile("s_waitcnt vmcnt(0)" ::: "memory");
  float q[16];
#pragma unroll
  for (int r = 0; r < 16; ++r) q[r] = 0.f;
#pragma unroll
  for (int d = 0; d < 4; ++d) {
#pragma unroll
    for (int r = 0; r < 16; ++r) { const float v = pk[(d * 16 + r) * 64] - lam * (o[d][r] * rli[r]); o[d][r] = v; q[r] += v * v; }
    asm volatile("" ::: "memory"); }
#pragma unroll
  for (int r = 0; r < 16; ++r) { float s = q[r]; s += __shfl_xor(s, 1); s += __shfl_xor(s, 2); s += __shfl_xor(s, 4); s += __shfl_xor(s, 8); s += __shfl_xor(s, 16); q[r] = s; }
  if (r32_ == 0) {
#pragma unroll
    for (int r = 0; r < 16; ++r) ssq[(rg_ * 32 + crow(r, hi_)) * 2 + e_] = q[r];
  }
  __syncthreads();
  float g4[4];
#pragma unroll
  for (int d = 0; d < 4; ++d) g4[d] = subln_g[e_ * 128 + d * 32 + r32_] * oscale;
  bf16* ob = Op + (size_t)(rg_ * 32 + 4 * hi_) * LDX + e_ * 128 + r32_;
  const LAS float* sq = ssq + (rg_ * 32 + 4 * hi_) * 2;
#pragma unroll
  for (int r = 0; r < 16; ++r) { const int rr = (r & 3) + 8 * (r >> 2); const float tot = sq[rr * 2] + sq[rr * 2 + 1]; const float rstd = __builtin_amdgcn_rsqf(tot * (1.f / 256.f) + EPS);
    bf16* orow = ob + (size_t)rr * LDX;
#pragma unroll
    for (int d = 0; d < 4; ++d) { const unsigned w = cvtpk(o[d][r] * rstd * g4[d], 0.f); orow[d * 32] = (bf16)(w & 0xffffu); } }
}
#undef KSWZ
#undef SBAR
}

__device__ __forceinline__ void attention_phase(Frame& F) {
    RELAUNDER(F);
    const float d1 = wave_sum(F.lq1[F.lane] * F.lk1[F.lane] + F.lq1[F.lane + 64] * F.lk1[F.lane + 64]);
    const float d2 = wave_sum(F.lq2[F.lane] * F.lk2[F.lane] + F.lq2[F.lane + 64] * F.lk2[F.lane + 64]);
    const float lam_init = 0.2f; const float lam = __expf(d1) - __expf(d2) + lam_init; const float oscale = 1.f - lam_init;
    float* park = F.PARK + (size_t)blockIdx.x * (NWAVES * 4096);
    LAS char* lds = (LAS char*)(F.lds + RING_OFF);
    for (int idx = F.vcu; idx < 768; idx += F.G) {
        const bool lat = idx < 256; const int u = lat ? idx : idx - 256;
        const int b = lat ? (u >> 6) : (u >> 4), h = lat ? ((u >> 3) & 7) : ((u >> 1) & 7), qb = lat ? (u & 7) : (u & 1);
        const int m0 = lat ? M_CTX + b * LAT_SEQ : b * CTX_SEQ; const int k0row = lat ? M_CTX + b * KV_LAT : m0;
        att::attn_unit(F.QB + (size_t)(m0 + qb * 128) * DATT + h * 256, F.KB + (size_t)k0row * DATT + h * 256,
                       F.PROJ + (size_t)m0 * LDP + 2 * DATT + h * 256, lat ? LAT_SEQ : CTX_SEQ, F.CV + (size_t)(b & 3) * PAST * DATT + h * 256, lat ? KV_LAT : CTX_SEQ,
                       F.MIX + (size_t)(m0 + qb * 128) * LDX + h * 256, park, F.subln_g, lam, oscale, lds);
    }
}

struct Args { const float* in[22]; float* out; unsigned char* ws; int ph_lo, ph_hi; };
__global__ void __launch_bounds__(NWAVES * 64, 2) mk_fwd(Args args) {
    extern __shared__ __attribute__((aligned(16))) unsigned char lds[];
    Frame F;
    F.lds = (LAS unsigned char*)lds;
    F.MISC = (volatile LAS unsigned*)(F.lds + MISC_OFF);
    F.tid = threadIdx.x; F.lane = F.tid & 63; F.wave = __builtin_amdgcn_readfirstlane(F.tid >> 6);
    F.G = gridDim.x; { const int bx = blockIdx.x; F.vcu = (F.G % 8 == 0) ? (bx % 8) * (F.G / 8) + bx / 8 : bx; }
    unsigned char* ws = args.ws;
    F.ctl = (gu32*)(ws + WS_CTL);
    F.x_prompt = args.in[0]; F.x_sample = args.in[1]; F.cache_k = args.in[2]; F.cache_v = args.in[3]; F.c = args.in[4]; F.c_ctx = args.in[5];
    F.w_ada = args.in[6]; F.b_ada = args.in[7]; F.norm_attn_g = args.in[8]; F.w_in = args.in[9]; F.q_norm_g = args.in[10]; F.k_norm_g = args.in[11];
    F.lq1 = args.in[12]; F.lk1 = args.in[13]; F.lq2 = args.in[14]; F.lk2 = args.in[15]; F.subln_g = args.in[16]; F.conv_w = args.in[17];
    F.w_out = args.in[18]; F.norm_mlp_g = args.in[19]; F.w_mlp_in = args.in[20]; F.w_mlp_out = args.in[21];
    F.out = args.out;
    F.MOD = (float*)(ws + WS_MOD); F.PARK = (float*)(ws + WS_PARK);
    F.Win_t = (bf16*)(ws + WS_WIN); F.Wout_t = (bf16*)(ws + WS_WOUT); F.W1_t = (bf16*)(ws + WS_W1); F.W2_t = (bf16*)(ws + WS_W2);
    F.XN = (bf16*)(ws + WS_XN); F.CV = (bf16*)(ws + WS_CV); F.PROJ = (bf16*)(ws + WS_PROJ); F.QB = (bf16*)(ws + WS_QB); F.KB = (bf16*)(ws + WS_KB);
    F.MIX = (bf16*)(ws + WS_MIX); F.HB = (bf16*)(ws + WS_H); F.X1B = (bf16*)(ws + WS_X1B);
    for (int u = F.tid; u < (LDS_BYTES - LDSCTL_OFF) / 4; u += NWAVES * 64) ((LAS unsigned*)(F.lds + LDSCTL_OFF))[u] = 0u;
    __syncthreads();
    XcdBarrier bar; bar.bar = (unsigned*)(F.ctl + CW_BAR); bar.x = 0; bar.st = nullptr;
    if (N_LAUNCHES == 1) bar = xcd_barrier_post((unsigned*)(F.ctl + CW_BAR), F.MISC + 8);
#define GRID_BAR(seam) do { if (N_LAUNCHES == 1) { xcd_barrier(bar); } } while (0)
    const int lo = args.ph_lo, hi = args.ph_hi;
#ifndef PH_MASK
#define PH_MASK 0x1ff
#endif
#define IN(k) (((PH_MASK >> (k)) & 1) && lo <= (k) && (k) < hi)
#define BOTH(k) (IN(k) && IN((k) + 1))
#ifndef PROBE_DUP
#define PROBE_DUP 0
#endif
#define DUP(k) ((PROBE_DUP >> (k)) & 1)

    if (IN(0)) { p0_gemv(F); if (DUP(10)) { __syncthreads(); p0_gemv(F); } p0_weights(F); if (DUP(11)) { __syncthreads(); p0_weights(F); } if (BOTH(0)) GRID_BAR(0); }
    if (IN(1)) { norm_mod_phase<0>(F); if (DUP(1)) { __syncthreads(); norm_mod_phase<0>(F); } if (BOTH(1)) GRID_BAR(1); }
    if (IN(2)) {
        pg8::Gemm g{F.XN, F.Win_t, MTOT, NPROJ, DM, LDX, LDX}; pg8::StaticOrder S; S.init(MTOT, NPROJ, F.G, (int)blockIdx.x);
        pg8::EpiBf16<0> E{F.PROJ, LDP};
        pg8::gemm_phase<pg8::EpiBf16<0>, pg8::StaticOrder, PG8_ALIGN, PG8_SP2>(F.lds + RING_OFF, g, S, E);
        if (DUP(2)) { __syncthreads(); pg8::gemm_phase<pg8::EpiBf16<0>, pg8::StaticOrder, PG8_ALIGN, PG8_SP2>(F.lds + RING_OFF, g, S, E); }
        if (DUP(9)) { __syncthreads(); pg8::EpiNull EN; pg8::gemm_phase<pg8::EpiNull, pg8::StaticOrder, PG8_ALIGN, PG8_SP2>(F.lds + RING_OFF, g, S, EN); }
        if (BOTH(2)) GRID_BAR(2);
    }
    if (IN(3)) { post_proj_phase(F); if (DUP(3)) { __syncthreads(); post_proj_phase(F); } if (BOTH(3)) GRID_BAR(3); }
    if (IN(4)) { attention_phase(F); if (DUP(4)) { __syncthreads(); attention_phase(F); } if (BOTH(4)) GRID_BAR(4); }
    if (IN(5)) {
        pg8::Gemm g{F.MIX, F.Wout_t, MTOT, DM, DM, LDX, LDX}; pg8::StaticOrder S; S.init(MTOT, DM, F.G, (int)blockIdx.x);
        pg8::EpiRes1 E{F.x_prompt, F.x_sample, F.X1B, LDX, F.MOD + 2 * DM};
        pg8::gemm_phase<pg8::EpiRes1, pg8::StaticOrder, PG8_ALIGN, PG8_SP2>(F.lds + RING_OFF, g, S, E);
        if (DUP(5)) { __syncthreads(); pg8::gemm_phase<pg8::EpiRes1, pg8::StaticOrder, PG8_ALIGN, PG8_SP2>(F.lds + RING_OFF, g, S, E); }
        if (BOTH(5)) GRID_BAR(5);
    }
    if (IN(6)) { norm_mod_phase<1>(F); if (DUP(6)) { __syncthreads(); norm_mod_phase<1>(F); } if (BOTH(6)) GRID_BAR(6); }
    if (IN(7)) {
        pg8::Gemm g{F.XN, F.W1_t, MTOT, DFF, DM, LDX, LDX}; pg8::StaticOrder S; S.init(MTOT, DFF, F.G, (int)blockIdx.x);
        pg8::EpiBf16<1> E{F.HB, LDH};
        pg8::gemm_phase<pg8::EpiBf16<1>, pg8::StaticOrder, PG8_ALIGN, PG8_SP2>(F.lds + RING_OFF, g, S, E);
        if (DUP(7)) { __syncthreads(); pg8::gemm_phase<pg8::EpiBf16<1>, pg8::StaticOrder, PG8_ALIGN, PG8_SP2>(F.lds + RING_OFF, g, S, E); }
        if (BOTH(7)) GRID_BAR(7);
    }
    if (IN(8)) {
        pg8::Gemm g{F.HB, F.W2_t, MTOT, DM, DFF, LDH, LDH}; pg8::StaticOrder S; S.init(MTOT, DM, F.G, (int)blockIdx.x);
        pg8::EpiRes2 E{F.X1B, LDX, F.out, F.MOD + 5 * DM};
        pg8::gemm_phase<pg8::EpiRes2, pg8::StaticOrder, PG8_ALIGN, PG8_SP2>(F.lds + RING_OFF, g, S, E);
        if (DUP(8)) { __syncthreads(); pg8::gemm_phase<pg8::EpiRes2, pg8::StaticOrder, PG8_ALIGN, PG8_SP2>(F.lds + RING_OFF, g, S, E); }
    }
#undef IN
#undef BOTH
}

extern "C" void kernel_launch(void* const* d_in, const int* in_sizes, int n_in, void* d_out, int out_size, void* d_ws, size_t ws_size, hipStream_t stream) {
    static int grid = 0;
    if (grid == 0) {
        if (n_in != 22 || ws_size < WS_END) { fprintf(stderr, "kernel_launch: expected 22 inputs and >= %zu bytes of workspace; got n_in %d, ws %zu; nothing launched\n", (size_t)WS_END, n_in, ws_size); grid = -1; return; }
        int dev = 0, cus = 0, per_cu = 0;
        if (hipGetDevice(&dev) != hipSuccess || hipDeviceGetAttribute(&cus, hipDeviceAttributeMultiprocessorCount, dev) != hipSuccess) { grid = -1; return; }
        if (hipFuncSetAttribute((const void*)mk_fwd, hipFuncAttributeMaxDynamicSharedMemorySize, LDS_BYTES) != hipSuccess) { fprintf(stderr, "kernel_launch: hipFuncSetAttribute failed\n"); grid = -1; return; }
        if (hipOccupancyMaxActiveBlocksPerMultiprocessor(&per_cu, (const void*)mk_fwd, NWAVES * 64, LDS_BYTES) != hipSuccess || per_cu < 1)
            fprintf(stderr, "kernel_launch: note: occupancy query reports %d workgroups per CU\n", per_cu);
        (void)hipGetLastError();
        grid = cus;
    }
    if (grid < 0) return;
    if (hipMemsetAsync((char*)d_ws + WS_CTL, 0, CTL_ZERO_BYTES, stream) != hipSuccess) { fprintf(stderr, "kernel_launch: memset failed\n"); return; }
    Args a{};
    for (int i = 0; i < 22; ++i) a.in[i] = (const float*)d_in[i];
    a.out = (float*)d_out; a.ws = (unsigned char*)d_ws;
    for (int li = 0; li < N_LAUNCHES; ++li) {
        a.ph_lo = (N_LAUNCHES == 1) ? 0 : li; a.ph_hi = (N_LAUNCHES == 1) ? N_PHASES : li + 1;
        hipLaunchKernelGGL(mk_fwd, dim3(grid), dim3(NWAVES * 64), LDS_BYTES, stream, a);
        const hipError_t le = hipPeekAtLastError();
        if (le != hipSuccess) { fprintf(stderr, "kernel_launch: launch %d failed: %s\n", li, hipGetErrorName(le)); break; }
    }
}
```

```cpp
#include <hip/hip_runtime.h>
#include <cstdio>
#include <cstdint>

#ifndef MK_N_LAUNCHES
#define MK_N_LAUNCHES 1
#endif

namespace pg8 {
#define PG8_LAS __attribute__((address_space(3)))
typedef unsigned short bf16_t;
typedef short bf16x8 __attribute__((ext_vector_type(8)));
typedef float f32x4 __attribute__((ext_vector_type(4)));
typedef unsigned u32x4 __attribute__((ext_vector_type(4)));
constexpr int BM = 256, BK = 64, HALF = 128, HTB = HALF * BK * 2  , STAGE_BYTES = 8 * HTB, NXCD = 8, WGM = 8;

__host__ __device__ __forceinline__ int lds_byte(int r, int c) { const int st = (r >> 4) * 2 + (c >> 5), rr = r & 15, cc = c & 31, ob = rr * 64 + cc * 2; return st * 1024 + (ob ^ (((ob >> 9) & 1) << 5)); }
__host__ __device__ __forceinline__ void stage_rc(int b, int& R, int& C) { const int st = b / 1024, sb = b % 1024, swz = sb ^ (((sb >> 9) & 1) << 5); R = (st >> 1) * 16 + swz / 64; C = (st & 1) * 32 + (swz % 64) / 2; }
__host__ __device__ __forceinline__ int perm32(int rho) { const int n = rho >> 4, i = rho & 15; return 8 * (i >> 2) + 4 * n + (i & 3); }

struct Unit { int pm, pn; };
struct Gemm { const bf16_t* A; const bf16_t* Bt; int M, N, K, lda, ldb; };

struct StaticOrder {
    int nM, nN, nwg, G, c;
    __host__ __device__ void init(int M, int N, int G_, int c_) { nM = M / BM; nN = N / BM; nwg = nM * nN; G = G_; c = c_; }
    int grouped = 0;
    __host__ __device__ bool next(int i, Unit& u) const {
        if (grouped == 2) {
            const int x = c & 7, cu = c >> 3, nG = nM >> 3, strip = i / nG, grp = i % nG; if (strip >= (nN >> 5)) return false;
            u.pm = 8 * grp + (cu & 7); u.pn = 4 * (strip * 8 + x) + (cu >> 3); return true; }
        if (grouped) { const int x = c & 7, cu = c >> 3, bpg = nN >> 2, B = i * 8 + x; if (B >= (nM >> 3) * bpg) return false;
            u.pm = 8 * (B / bpg) + (cu & 7); u.pn = 4 * (B % bpg) + (cu >> 3); return true; }
        const long L = (long)i * G + c; if (L >= nwg) return false;
        int wgid = (int)L; { const int q = nwg / NXCD, r = nwg % NXCD, xcd = wgid % NXCD, off = wgid / NXCD; wgid = (xcd < r ? xcd * (q + 1) : r * (q + 1) + (xcd - r) * q) + off; }
        const int nig = WGM * nN, gid = wgid / nig, fm = gid * WGM, gsz = (nM - fm) < WGM ? (nM - fm) : WGM;
        u.pm = fm + ((wgid % nig) % gsz); u.pn = (wgid % nig) / gsz; return true;
    }
    __device__ __forceinline__ void a_ready(const Unit&) const {}
    __device__ __forceinline__ void done(const Unit&) const {}
};
struct XcdSyncOrder : StaticOrder {
    unsigned* ctr; unsigned nloc; mutable unsigned k;
    __device__ __forceinline__ void a_ready(const Unit&) const {
        if (nloc) {
            if (threadIdx.x == 0) { __hip_atomic_fetch_add(ctr, 1u, __ATOMIC_RELAXED, __HIP_MEMORY_SCOPE_AGENT); const unsigned want = nloc * (k + 1u); unsigned sp = 0;
                while (__hip_atomic_load(ctr, __ATOMIC_RELAXED, __HIP_MEMORY_SCOPE_AGENT) < want && ++sp < 4000u) __builtin_amdgcn_s_sleep(1); }
            ++k;
            asm volatile("" ::: "memory"); __builtin_amdgcn_s_barrier(); asm volatile("" ::: "memory");
        }
    }
};

__device__ __forceinline__ unsigned cvt_pk_bf16(float lo, float hi) { unsigned r; asm volatile("v_cvt_pk_bf16_f32 %0, %1, %2" : "=v"(r) : "v"(lo), "v"(hi)); return r; }

__device__ __forceinline__ unsigned tr_line(int h, unsigned x0, unsigned x1, int srcl) {
    const int X = (h == 0) ? __builtin_amdgcn_update_dpp((int)x0, (int)x1, 0x128, 0xF, 0xC, false)
                           : __builtin_amdgcn_update_dpp((int)x1, (int)x0, 0x128, 0xF, 0x3, false);
    return (unsigned)__builtin_amdgcn_ds_bpermute(srcl, X); }
__device__ __forceinline__ f32x4 tr_line4(int h, const f32x4 x0, const f32x4 x1, int srcl) { f32x4 r;
    r.x = __uint_as_float(tr_line(h, __float_as_uint(x0.x), __float_as_uint(x1.x), srcl)); r.y = __uint_as_float(tr_line(h, __float_as_uint(x0.y), __float_as_uint(x1.y), srcl));
    r.z = __uint_as_float(tr_line(h, __float_as_uint(x0.z), __float_as_uint(x1.z), srcl)); r.w = __uint_as_float(tr_line(h, __float_as_uint(x0.w), __float_as_uint(x1.w), srcl)); return r; }
#define PG8_LINE_MAP int lane_l = fq * 16 + fr; asm volatile("" : "+v"(lane_l));   const int lane = lane_l, r8 = lane >> 3, c8 = lane & 7, srcl = ((lane & 3) * 16 + 8 * ((lane >> 2) & 1) + (lane >> 3)) * 4

template <int ACT  > struct EpiBf16 {
    static constexpr bool PERM = true, AFTER_DRAIN = false;
    bf16_t* O; int ldc;
    __device__ __forceinline__ void operator()(const f32x4 (&acc)[2][2][4][2], const Unit& u, int wr, int wc, int fr, int fq) const {
        PG8_LINE_MAP;
        const int row0 = u.pm * BM + wr * 64 + r8; const int col0 = u.pn * BM + wc * 64 + 8 * c8;
#pragma unroll
        for (int ai = 0; ai < 2; ++ai)
#pragma unroll
            for (int m = 0; m < 4; ++m) { bf16_t* rowp = O + (size_t)(row0 + ai * HALF + m * 16) * ldc + col0;
                u32x4 w[2];
#pragma unroll
                for (int bj = 0; bj < 2; ++bj) { f32x4 v0 = acc[ai][bj][m][0], v1 = acc[ai][bj][m][1];
                    if (ACT == 1) {
#pragma unroll
                        for (int j = 0; j < 4; ++j) { const float a = fmaxf(v0[j], 0.f), b = fmaxf(v1[j], 0.f); v0[j] = a * a; v1[j] = b * b; } }
                    w[bj].x = cvt_pk_bf16(v0[0], v0[1]); w[bj].y = cvt_pk_bf16(v0[2], v0[3]); w[bj].z = cvt_pk_bf16(v1[0], v1[1]); w[bj].w = cvt_pk_bf16(v1[2], v1[3]); }
#pragma unroll
                for (int h = 0; h < 2; ++h) { u32x4 t; t.x = tr_line(h, w[0].x, w[1].x, srcl); t.y = tr_line(h, w[0].y, w[1].y, srcl); t.z = tr_line(h, w[0].z, w[1].z, srcl); t.w = tr_line(h, w[0].w, w[1].w, srcl);
                    *(u32x4*)(rowp + (size_t)(8 * h) * ldc) = t; } }
    }
};
struct EpiNull { static constexpr bool PERM = true, AFTER_DRAIN = false;
    __device__ __forceinline__ void operator()(const f32x4 (&acc)[2][2][4][2], const Unit& u, int wr, int wc, int fr, int fq) const { _Pragma("unroll") for (int a = 0; a < 2; ++a) _Pragma("unroll") for (int b = 0; b < 2; ++b) _Pragma("unroll") for (int m = 0; m < 4; ++m) _Pragma("unroll") for (int n = 0; n < 2; ++n) asm volatile("" :: "v"(acc[a][b][m][n])); } };
__device__ __forceinline__ f32x4 lane_tr(const f32x4 v, int srcl) { f32x4 r;
    r.x = __int_as_float(__builtin_amdgcn_ds_bpermute(srcl, __float_as_int(v.x))); r.y = __int_as_float(__builtin_amdgcn_ds_bpermute(srcl, __float_as_int(v.y)));
    r.z = __int_as_float(__builtin_amdgcn_ds_bpermute(srcl, __float_as_int(v.z))); r.w = __int_as_float(__builtin_amdgcn_ds_bpermute(srcl, __float_as_int(v.w))); return r; }
struct EpiRes1 {
    static constexpr bool PERM = true, AFTER_DRAIN = false;
    const float* base_ctx; const float* base_lat; bf16_t* O; int ldo; const float* gate;
    __device__ __forceinline__ void operator()(const f32x4 (&acc)[2][2][4][2], const Unit& u, int wr, int wc, int fr, int fq) const {
        PG8_LINE_MAP;
        const int mt = u.pm * BM; const bool lat = mt >= 8192; const int b = lat ? 1 + ((mt - 8192) >> 10) : 0;
        const float* bp = lat ? base_lat + (size_t)(mt - 8192) * 4096 : base_ctx + (size_t)mt * 4096;
        const int rl0 = wr * 64 + r8, col0 = u.pn * BM + wc * 64 + 8 * c8;
        bf16_t* op = O + (size_t)mt * ldo;
        const f32x4 g0 = *(const f32x4*)(gate + (size_t)b * 24576 + col0), g1 = *(const f32x4*)(gate + (size_t)b * 24576 + col0 + 4);
#pragma unroll
        for (int ai = 0; ai < 2; ++ai)
#pragma unroll
            for (int m = 0; m < 4; ++m) {
                f32x4 B0[2], B1[2];
#pragma unroll
                for (int h = 0; h < 2; ++h) { const size_t off = (size_t)(rl0 + ai * HALF + m * 16 + 8 * h) * 4096 + col0;
                    B0[h] = __builtin_nontemporal_load((const f32x4*)(bp + off)); B1[h] = __builtin_nontemporal_load((const f32x4*)(bp + off + 4)); }
#pragma unroll
                for (int h = 0; h < 2; ++h) { const int row = rl0 + ai * HALF + m * 16 + 8 * h;
                    const f32x4 a0 = tr_line4(h, acc[ai][0][m][0], acc[ai][1][m][0], srcl), a1 = tr_line4(h, acc[ai][0][m][1], acc[ai][1][m][1], srcl);
                    const f32x4 v0 = B0[h] + g0 * a0, v1 = B1[h] + g1 * a1;
                    u32x4 w; w.x = cvt_pk_bf16(v0[0], v0[1]); w.y = cvt_pk_bf16(v0[2], v0[3]); w.z = cvt_pk_bf16(v1[0], v1[1]); w.w = cvt_pk_bf16(v1[2], v1[3]);
                    *(u32x4*)(op + (size_t)row * ldo + col0) = w; }
                asm volatile("" ::: "memory"); }
    }
};
struct EpiRes2 {
    static constexpr bool PERM = true, AFTER_DRAIN = false;
    const bf16_t* X; int ldx; float* out; const float* gate;
    __device__ __forceinline__ void operator()(const f32x4 (&acc)[2][2][4][2], const Unit& u, int wr, int wc, int fr, int fq) const {
        PG8_LINE_MAP;
        const int mt = u.pm * BM; const bool lat = mt >= 8192; const int b = lat ? 1 + ((mt - 8192) >> 10) : 0;
        const int rl0 = wr * 64 + r8, col0 = u.pn * BM + wc * 64 + 8 * c8;
        const bf16_t* xp = X + (size_t)mt * ldx; float* op = out + (size_t)mt * 4096;
        const f32x4 g0 = *(const f32x4*)(gate + (size_t)b * 24576 + col0), g1 = *(const f32x4*)(gate + (size_t)b * 24576 + col0 + 4);
#pragma unroll
        for (int ai = 0; ai < 2; ++ai)
#pragma unroll
            for (int m = 0; m < 4; ++m) {
                u32x4 XB[2];
#pragma unroll
                for (int h = 0; h < 2; ++h) XB[h] = __builtin_nontemporal_load((const u32x4*)(xp + (size_t)(rl0 + ai * HALF + m * 16 + 8 * h) * ldx + col0));
#pragma unroll
                for (int h = 0; h < 2; ++h) { const size_t off = (size_t)(rl0 + ai * HALF + m * 16 + 8 * h) * 4096 + col0; const u32x4 xb = XB[h];
                    const f32x4 a0 = tr_line4(h, acc[ai][0][m][0], acc[ai][1][m][0], srcl), a1 = tr_line4(h, acc[ai][0][m][1], acc[ai][1][m][1], srcl);
                    const f32x4 b0 = {__uint_as_float(xb.x << 16), __uint_as_float(xb.x & 0xffff0000u), __uint_as_float(xb.y << 16), __uint_as_float(xb.y & 0xffff0000u)};
                    const f32x4 b1 = {__uint_as_float(xb.z << 16), __uint_as_float(xb.z & 0xffff0000u), __uint_as_float(xb.w << 16), __uint_as_float(xb.w & 0xffff0000u)};
                    __builtin_nontemporal_store(b0 + g0 * a0, (f32x4*)(op + off)); __builtin_nontemporal_store(b1 + g1 * a1, (f32x4*)(op + off + 4)); }
                asm volatile("" ::: "memory"); }
    }
};
#undef PG8_LINE_MAP

template <class Epi, class Sched, bool ALIGN_EPI = false, bool SP2 = false>
__device__ __forceinline__ void gemm_phase(PG8_LAS unsigned char* lds, const Gemm g, const Sched& S, const Epi& E) {
    int tid_l = threadIdx.x; asm volatile("" : "+v"(tid_l));
    const int tid = tid_l, wid = __builtin_amdgcn_readfirstlane(tid >> 6), lane = tid & 63, wr = wid >> 2, wc = wid & 3, fr = lane & 15, fq = lane >> 4;
    const int K = g.K, nt = K / BK;
    unsigned voffA[2], voffB[2];
#pragma unroll
    for (int i = 0; i < 2; ++i) { int R, C; stage_rc(tid * 16 + i * 8192, R, C); const int bb = tid * 16 + i * 8192;
        voffA[i] = (unsigned)(R * g.lda + C) * 2u; voffB[i] = (unsigned)((bb >> 11) * g.ldb + ((bb & 2047) >> 4)) * 16u; }
    const size_t kstepA = (size_t)(BK * 2), kstepB = (size_t)(BK / 8) * g.ldb * 16;
    const size_t hstepA = (size_t)HALF * g.lda * 2, hstepB = (size_t)HALF * 16;
    const size_t tstepA = 2 * hstepA, tstepB = 2 * hstepB;
    const unsigned ldsw = (unsigned)wid * 1024u;
    const int aoff = lds_byte(wr * 64 + fr, fq * 8), boff = fq * 2048 + (wc * 32 + fr) * 16;
#define PG8_SA(b, h) (((b) * 2 + (h)) * HTB)
#define PG8_SB(b, h) ((4 + (b) * 2 + (h)) * HTB)
#define PG8_STAGE(bufoff, gbase, voff) do { _Pragma("unroll") for (int _i = 0; _i < 2; ++_i) \
        __builtin_amdgcn_global_load_lds((const unsigned*)((const char*)(gbase) + (voff)[_i]), (PG8_LAS unsigned*)(lds + (bufoff) + ldsw + _i * 8192), 16, 0, 0); } while (0)
#define PG8_LDA(dst, b, h) do { _Pragma("unroll") for (int m = 0; m < 4; ++m) _Pragma("unroll") for (int k = 0; k < 2; ++k) dst[m][k] = *(const PG8_LAS bf16x8*)(lds + PG8_SA(b, h) + aoff + m * 2048 + k * 1024); } while (0)
#define PG8_LDB(dst, b, h) do { _Pragma("unroll") for (int n = 0; n < 2; ++n) _Pragma("unroll") for (int k = 0; k < 2; ++k) dst[n][k] = *(const PG8_LAS bf16x8*)(lds + PG8_SB(b, h) + boff + n * 256 + k * 8192); } while (0)
#define PG8_MMA(ai, bj, At, Bt) do { __builtin_amdgcn_s_setprio(1); _Pragma("unroll") for (int m = 0; m < 4; ++m) _Pragma("unroll") for (int n = 0; n < 2; ++n) _Pragma("unroll") for (int k = 0; k < 2; ++k) \
        acc[ai][bj][m][n] = __builtin_amdgcn_mfma_f32_16x16x32_bf16(Bt[n][k], At[m][k], acc[ai][bj][m][n], 0, 0, 0); __builtin_amdgcn_s_setprio(0); } while (0)
#define PG8_WAIT_V(n) asm volatile("s_waitcnt vmcnt(" #n ")" ::: "memory")
#define PG8_WAIT_L(n) asm volatile("s_waitcnt lgkmcnt(" #n ")" ::: "memory")
#define PG8_BAR __builtin_amdgcn_s_barrier()
#define PG8_SCHED __builtin_amdgcn_sched_barrier(0)
    static_assert(Epi::PERM, "the weight copies are stored with perm32 applied to their column order: every epilogue must use the PERM column map");
    Unit cur, nxt; int ui = 0;
    if (!S.next(0, cur)) return;
    f32x4 acc[2][2][4][2];
#pragma unroll
    for (int a = 0; a < 2; ++a)
#pragma unroll
        for (int b = 0; b < 2; ++b)
#pragma unroll
            for (int m = 0; m < 4; ++m)
#pragma unroll
                for (int n = 0; n < 2; ++n) acc[a][b][m][n] = (f32x4){0.f, 0.f, 0.f, 0.f};
    bf16x8 At[4][2], B0[2][2], B1[2][2];
    const char* cA = (const char*)g.A + (size_t)cur.pm * tstepA; const char* cB = (const char*)g.Bt + (size_t)cur.pn * tstepB;
    S.a_ready(cur);
    if constexpr (SP2) {
        PG8_STAGE(PG8_SB(0, 0), cB, voffB); PG8_STAGE(PG8_SB(0, 1), cB + hstepB, voffB); PG8_STAGE(PG8_SA(0, 0), cA, voffA); PG8_STAGE(PG8_SA(0, 1), cA + hstepA, voffA);
        if (wr == 1) PG8_BAR;
        PG8_WAIT_V(2); PG8_BAR;
        PG8_STAGE(PG8_SB(1, 0), cB + kstepB, voffB); PG8_STAGE(PG8_SA(1, 0), cA + kstepA, voffA); PG8_STAGE(PG8_SB(1, 1), cB + hstepB + kstepB, voffB);
        PG8_WAIT_V(6); PG8_BAR;
    } else {
        PG8_STAGE(PG8_SB(0, 0), cB, voffB); PG8_STAGE(PG8_SA(0, 0), cA, voffA); PG8_STAGE(PG8_SB(0, 1), cB + hstepB, voffB); PG8_STAGE(PG8_SA(0, 1), cA + hstepA, voffA);
        if (wr == 1) PG8_BAR;
        PG8_WAIT_V(4); PG8_BAR;
        PG8_STAGE(PG8_SB(1, 0), cB + kstepB, voffB); PG8_STAGE(PG8_SA(1, 0), cA + kstepA, voffA); PG8_STAGE(PG8_SB(1, 1), cB + hstepB + kstepB, voffB);
        PG8_WAIT_V(6); PG8_BAR;
    }
    for (;;) {
        const bool has_next = S.next(ui + 1, nxt);
        const char* nA = has_next ? (const char*)g.A + (size_t)nxt.pm * tstepA : cA; const char* nB = has_next ? (const char*)g.Bt + (size_t)nxt.pn * tstepB : cB;
        for (int t = 0; t < nt; t += 2) {
            const bool last = (t == nt - 2);
            const char* a1 = cA + (size_t)(t + 1) * kstepA;
            const char* a2 = last ? nA : cA + (size_t)(t + 2) * kstepA; const char* b2 = last ? nB : cB + (size_t)(t + 2) * kstepB;
            const char* a3 = a2 + kstepA; const char* b3 = b2 + kstepB;
            if (last && has_next) S.a_ready(nxt);
            if constexpr (SP2) {
            PG8_LDB(B0, 0, 0); PG8_LDB(B1, 0, 1); PG8_SCHED; PG8_LDA(At, 0, 0); PG8_STAGE(PG8_SA(1, 1), a1 + hstepA, voffA);
            PG8_WAIT_V(8); PG8_WAIT_L(0); PG8_BAR; PG8_MMA(0, 0, At, B0); PG8_MMA(0, 1, At, B1); PG8_BAR; PG8_SCHED;
            PG8_LDA(At, 0, 1); PG8_STAGE(PG8_SB(0, 0), b2, voffB); PG8_STAGE(PG8_SB(0, 1), b2 + hstepB, voffB); PG8_STAGE(PG8_SA(0, 0), a2, voffA);
            PG8_WAIT_V(8); PG8_WAIT_L(0); PG8_BAR; PG8_MMA(1, 0, At, B0); PG8_MMA(1, 1, At, B1); PG8_BAR; PG8_SCHED;
            PG8_LDB(B0, 1, 0); PG8_LDB(B1, 1, 1); PG8_SCHED; PG8_LDA(At, 1, 0); PG8_STAGE(PG8_SA(0, 1), a2 + hstepA, voffA);
            PG8_WAIT_V(8); PG8_WAIT_L(0); PG8_BAR; PG8_MMA(0, 0, At, B0); PG8_MMA(0, 1, At, B1); PG8_BAR; PG8_SCHED;
            PG8_LDA(At, 1, 1); PG8_STAGE(PG8_SB(1, 0), b3, voffB); PG8_STAGE(PG8_SB(1, 1), b3 + hstepB, voffB); PG8_STAGE(PG8_SA(1, 0), a3, voffA);
            PG8_WAIT_V(8); PG8_WAIT_L(0); PG8_BAR; PG8_MMA(1, 0, At, B0); PG8_MMA(1, 1, At, B1); PG8_BAR; PG8_SCHED;
            } else {
            PG8_LDB(B0, 0, 0); PG8_SCHED; PG8_LDA(At, 0, 0); PG8_STAGE(PG8_SA(1, 1), a1 + hstepA, voffA);
            PG8_WAIT_L(8); PG8_BAR; PG8_WAIT_L(0); PG8_MMA(0, 0, At, B0); PG8_BAR; PG8_SCHED;
            PG8_LDB(B1, 0, 1); PG8_STAGE(PG8_SB(0, 0), b2, voffB);
            PG8_BAR; PG8_WAIT_L(0); PG8_MMA(0, 1, At, B1); PG8_BAR;
            PG8_LDA(At, 0, 1); PG8_STAGE(PG8_SA(0, 0), a2, voffA);
            PG8_BAR; PG8_WAIT_L(0); PG8_MMA(1, 0, At, B0); PG8_BAR; PG8_SCHED;
            PG8_STAGE(PG8_SB(0, 1), b2 + hstepB, voffB);
            PG8_WAIT_V(6); PG8_BAR; PG8_MMA(1, 1, At, B1); PG8_BAR;
            PG8_LDB(B0, 1, 0); PG8_SCHED; PG8_LDA(At, 1, 0); PG8_STAGE(PG8_SA(0, 1), a2 + hstepA, voffA);
            PG8_WAIT_L(8); PG8_BAR; PG8_WAIT_L(0); PG8_MMA(0, 0, At, B0); PG8_BAR; PG8_SCHED;
            PG8_LDB(B1, 1, 1); PG8_STAGE(PG8_SB(1, 0), b3, voffB);
            PG8_BAR; PG8_WAIT_L(0); PG8_MMA(0, 1, At, B1); PG8_BAR;
            PG8_LDA(At, 1, 1); PG8_STAGE(PG8_SA(1, 0), a3, voffA);
            PG8_BAR; PG8_WAIT_L(0); PG8_MMA(1, 0, At, B0); PG8_BAR; PG8_SCHED;
            PG8_STAGE(PG8_SB(1, 1), b3 + hstepB, voffB);
            PG8_WAIT_V(6); PG8_BAR; PG8_MMA(1, 1, At, B1); PG8_BAR;
            }
        }
        if constexpr (ALIGN_EPI) { if (wr == 0) PG8_BAR; }
        if constexpr (!Epi::AFTER_DRAIN) { E(acc, cur, wr, wc, fr, fq); S.done(cur); }
        if (!has_next) break;
#pragma unroll
        for (int a = 0; a < 2; ++a)
#pragma unroll
            for (int b = 0; b < 2; ++b)
#pragma unroll
                for (int m = 0; m < 4; ++m)
#pragma unroll
                    for (int n = 0; n < 2; ++n) acc[a][b][m][n] = (f32x4){0.f, 0.f, 0.f, 0.f};
        cur = nxt; cA = nA; cB = nB; ++ui;
        if constexpr (ALIGN_EPI) { if (wr == 1) PG8_BAR; }
    }
    PG8_WAIT_V(0);
    if constexpr (!ALIGN_EPI) { if (wr == 0) PG8_BAR; }
    PG8_BAR;
#undef PG8_SA
#undef PG8_SB
#undef PG8_STAGE
#undef PG8_LDA
#undef PG8_LDB
#undef PG8_MMA
#undef PG8_WAIT_V
#undef PG8_WAIT_L
#undef PG8_BAR
#undef PG8_SCHED
}
}

#ifndef PG8_SP2
#define PG8_SP2 true
#endif
#ifndef PG8_ALIGN
#define PG8_ALIGN true
#endif

constexpr int NWAVES = 8;
constexpr int DM = 4096, M_CTX = 8192, M_LAT = 4096, MTOT = M_CTX + M_LAT, NPROJ = 12288, DFF = 16384, DATT = 2048, NMODW = 6 * DM;
constexpr int LAT_SEQ = 1024, CTX_SEQ = 256, PAST = 256, NHEAD = 8, KV_LAT = LAT_SEQ + PAST;
constexpr int KB_ROWS = M_CTX + 4 * KV_LAT;
constexpr int LDX = DM + 64, LDH = DFF + 64, LDP = NPROJ + 64;
constexpr int OPAD = 272;
constexpr float EPS = 1e-6f;
constexpr int N_PHASES = 9;
constexpr int N_LAUNCHES = MK_N_LAUNCHES;

constexpr size_t MiB = 1u << 20;
constexpr size_t WS_CTL = 0, CTL_ZERO_BYTES = 64 * 1024;
constexpr size_t WS_MOD = 1 * MiB;
constexpr size_t WS_WIN = 2 * MiB;
constexpr size_t WS_WOUT = 102 * MiB;
constexpr size_t WS_W1 = 138 * MiB;
constexpr size_t WS_W2 = 270 * MiB;
constexpr size_t WS_XN = 408 * MiB;
constexpr size_t WS_CV = 506 * MiB;
constexpr size_t WS_PARK = 510 * MiB;
constexpr size_t WS_R = 542 * MiB;
constexpr size_t WS_PROJ = WS_R;
constexpr size_t WS_QB = WS_R + 290 * MiB;
constexpr size_t WS_KB = WS_R + 338 * MiB;
constexpr size_t WS_MIX = WS_R + 390 * MiB;
constexpr size_t WS_H = WS_R;
constexpr size_t WS_X1B = WS_R + 488 * MiB;
constexpr size_t WS_END = WS_X1B + 98 * MiB;
static_assert((size_t)MTOT * LDX * 2 <= 98 * MiB && (size_t)(DM / 8) * (NPROJ + OPAD) * 16 <= 100 * MiB && (size_t)(DM / 8) * (DM + OPAD) * 16 <= 36 * MiB && (size_t)(DM / 8) * (DFF + OPAD) * 16 <= 132 * MiB && (size_t)(DFF / 8) * (DM + OPAD) * 16 <= 138 * MiB && (size_t)MTOT * LDP * 2 <= 290 * MiB, "ws map 1");
static_assert((size_t)KB_ROWS * DATT * 2 <= 52 * MiB && (size_t)MTOT * LDH * 2 <= 386 * MiB && WS_H + 386 * MiB <= WS_MIX, "ws map 2");
constexpr int CW_TMO = 0, CW_CODE = 1;
constexpr int CW_BAR = 4096;
constexpr int CW_XS = 8192;

constexpr int RING_OFF = 0, RING_BYTES = 131072;
constexpr int LDSCTL_OFF = RING_BYTES, MISC_OFF = LDSCTL_OFF + 320;
constexpr int LDS_BYTES = 147456;
static_assert(MISC_OFF + 128 <= LDS_BYTES, "LDS map");

#define GAS __attribute__((address_space(1)))
#define LAS __attribute__((address_space(3)))
typedef unsigned short bf16;
typedef unsigned v4u __attribute__((ext_vector_type(4)));
typedef unsigned v2u __attribute__((ext_vector_type(2)));
typedef float f32x4 __attribute__((ext_vector_type(4)));
typedef short bf16x8 __attribute__((ext_vector_type(8)));
typedef GAS unsigned gu32;
#define RLX_AGENT __ATOMIC_RELAXED, __HIP_MEMORY_SCOPE_AGENT
#define LDS_WAIT() asm volatile("s_waitcnt lgkmcnt(0)" ::: "memory")
#define VM_WAIT() asm volatile("s_waitcnt vmcnt(0)" ::: "memory")
__device__ __forceinline__ unsigned pk2(float lo, float hi) { return pg8::cvt_pk_bf16(lo, hi); }
__device__ __forceinline__ float bflo(unsigned w) { return __uint_as_float(w << 16); }
__device__ __forceinline__ float bfhi(unsigned w) { return __uint_as_float(w & 0xffff0000u); }

#define XB_TMO      128
#define XB_XCNT(j)  (256  + 64 * (j))
#define XB_XSUB(j)  (1280 + 64 * (j))
#define XB_XGEN(j)  (2304 + 64 * (j))
#define XB_TOP      3328
#define XB_TOPGEN   3392
#define XCD_BAR_WORDS 3456
#define XB_SPIN_CAP (1u << 18)

__device__ __forceinline__ unsigned xb_ld(unsigned* p)              { return __hip_atomic_load(p, __ATOMIC_RELAXED, __HIP_MEMORY_SCOPE_AGENT); }
__device__ __forceinline__ unsigned xb_add(unsigned* p, unsigned v) { return __hip_atomic_fetch_add(p, v, __ATOMIC_RELAXED, __HIP_MEMORY_SCOPE_AGENT); }
__device__ __forceinline__ unsigned xb_xcc_id() { return (unsigned)__builtin_amdgcn_s_getreg((3 << 11) | 20) & 0xFu; }
#define XB_SPIN(cond, bar) do { unsigned _sp = 0; while (cond) { __builtin_amdgcn_s_sleep(1); \
    if ((++_sp & 255u) == 0u) { if (xb_ld(&(bar)[XB_TMO])) break; if (_sp > XB_SPIN_CAP) { atomicAdd(&(bar)[XB_TMO], 1u); break; } } } } while (0)

struct XcdBarrier {
    unsigned* bar; unsigned x;
    volatile LAS unsigned* st;
};
__device__ __forceinline__ XcdBarrier xcd_barrier_post(unsigned* bar, volatile LAS unsigned* st) {
    XcdBarrier b; b.bar = bar; b.x = xb_xcc_id(); b.st = st;
    if (threadIdx.x == 0) (void)xb_add(&bar[XB_XCNT(b.x)], 1u);
    return b;
}
__device__ __forceinline__ void xcd_barrier_complete(unsigned* bar, unsigned x, unsigned& nloc, unsigned& nx) {
    const unsigned G = gridDim.x * gridDim.y * gridDim.z;
    unsigned sum, cnt, mine, sp = 0u;
    for (;;) {
        sum = 0u; cnt = 0u; mine = 0u;
#pragma unroll
        for (unsigned j = 0; j < 16; ++j) { const unsigned c = xb_ld(&bar[XB_XCNT(j)]); sum += c; cnt += (c > 0u) ? 1u : 0u; mine = (j == x) ? c : mine; }
        if (sum == G) break;
        __builtin_amdgcn_s_sleep(1);
        if ((++sp & 255u) == 0u) { if (xb_ld(&bar[XB_TMO])) break; if (sp > XB_SPIN_CAP) { atomicAdd(&bar[XB_TMO], 1u); break; } }
    }
    nloc = mine > 0u ? mine : 1u; nx = cnt > 0u ? cnt : 1u;
}
__device__ __forceinline__ void xcd_barrier(const XcdBarrier& b) {
    asm volatile("s_waitcnt vmcnt(0)" ::: "memory");
    __syncthreads();
    if (threadIdx.x == 0) {
        unsigned* bar = b.bar;
        __builtin_amdgcn_s_waitcnt(0);
        unsigned nloc = b.st[0], nx = b.st[1];
        if (nloc == 0u) { xcd_barrier_complete(bar, b.x, nloc, nx); b.st[0] = nloc; b.st[1] = nx; }
        const unsigned old = xb_add(&bar[XB_XSUB(b.x)], 1u);
        const unsigned gen = old / nloc;
        if (old + 1u == (gen + 1u) * nloc) {
            __builtin_amdgcn_fence(__ATOMIC_RELEASE, "agent");
            asm volatile("s_waitcnt vmcnt(0)" ::: "memory");
            const unsigned og = xb_add(&bar[XB_TOP], 1u);
            const unsigned tg = og / nx;
            if (og + 1u == (tg + 1u) * nx) xb_add(&bar[XB_TOPGEN], 1u);
            else XB_SPIN(xb_ld(&bar[XB_TOPGEN]) == tg, bar);
            __builtin_amdgcn_fence(__ATOMIC_ACQUIRE, "agent");
            xb_add(&bar[XB_XGEN(b.x)], 1u);
            asm volatile("s_waitcnt vmcnt(0)" ::: "memory");
        } else {
            XB_SPIN(xb_ld(&bar[XB_XGEN(b.x)]) == gen, bar);
            __builtin_amdgcn_fence(__ATOMIC_ACQUIRE, "agent");
            asm volatile("s_waitcnt vmcnt(0)" ::: "memory");
        }
    }
    __syncthreads();
}

struct Frame {
    LAS unsigned char* lds;
    volatile LAS unsigned* MISC;
    gu32* ctl;
    int tid, lane, wave;
    int vcu, G;
    const float *x_prompt, *x_sample, *cache_k, *cache_v, *c, *c_ctx, *w_ada, *b_ada, *norm_attn_g, *w_in, *q_norm_g, *k_norm_g;
    const float *lq1, *lk1, *lq2, *lk2, *subln_g, *conv_w, *w_out, *norm_mlp_g, *w_mlp_in, *w_mlp_out;
    float* out;
    float* MOD; float* PARK;
    bf16 *Win_t, *Wout_t, *W1_t, *W2_t, *XN, *CV, *PROJ, *QB, *KB, *MIX, *HB, *X1B;
};

#define RELAUNDER(F) do { int t_ = threadIdx.x; asm volatile("" : "+v"(t_)); F.tid = t_; F.lane = t_ & 63; F.wave = __builtin_amdgcn_readfirstlane(t_ >> 6); } while (0)
__device__ __forceinline__ float wave_sum(float v) {
#pragma unroll
    for (int o = 1; o < 64; o <<= 1) v += __shfl_xor(v, o);
    return v;
}

__device__ __forceinline__ void p0_transpose_item(const float* W, int K, int N, bf16* WT, LAS float* scr, int item, int lane) {
    const int nblk = N / 32, kb = item / nblk, nb = item % nblk, k0 = 64 * kb, n0 = 32 * nb;
#pragma unroll 8
    for (int i = 0; i < 32; ++i) { const int kk = 2 * i + (lane >> 5); scr[kk * 33 + (lane & 31)] = W[(size_t)(k0 + kk) * N + n0 + (lane & 31)]; }
    LDS_WAIT(); asm volatile("" ::: "memory");
    const int c = lane & 7;
#pragma unroll
    for (int j = 0; j < 4; ++j) { const int n = (lane >> 3) + 8 * j; const LAS float* s = scr + (8 * c) * 33 + n;
        v4u o; o.x = pk2(s[0 * 33], s[1 * 33]); o.y = pk2(s[2 * 33], s[3 * 33]); o.z = pk2(s[4 * 33], s[5 * 33]); o.w = pk2(s[6 * 33], s[7 * 33]);
        *(GAS v4u*)(WT + (size_t)(n0 + n) * K + k0 + 8 * c) = o; }
    LDS_WAIT(); asm volatile("" ::: "memory");
}
__device__ __forceinline__ void cvt_row2048(const float* src, bf16* dst, int lane) {
#pragma unroll
    for (int j = 0; j < 4; ++j) { const int col = 8 * (lane + 64 * j);
        const f32x4 a = *(const GAS f32x4*)(src + col), b = *(const GAS f32x4*)(src + col + 4);
        v4u o; o.x = pk2(a.x, a.y); o.y = pk2(a.z, a.w); o.z = pk2(b.x, b.y); o.w = pk2(b.z, b.w);
        *(GAS v4u*)(dst + col) = o; }
}
__device__ __forceinline__ float silu_f(float v) { return v / (1.f + __expf(-v)); }

__device__ __forceinline__ void p0_gemv(Frame& F) {
    RELAUNDER(F);
    LAS float* sl = (LAS float*)(F.lds);
    LAS float* red = (LAS float*)(F.lds + 81920);
    for (int i = F.tid; i < 5 * DM; i += NWAVES * 64) { const int b = i / DM, k = i % DM; const float v = (b == 0) ? F.c_ctx[k] : F.c[(b - 1) * DM + k]; sl[i] = silu_f(v); }
    __syncthreads();
    for (int jt = blockIdx.x; jt < NMODW / 96; jt += F.G) {
        const int jl = F.lane % 24, rg = F.lane / 24; const bool act = F.lane < 48;
        const float* wp = F.w_ada + (size_t)(2 * F.wave + (act ? rg : 0)) * NMODW + 96 * jt + 4 * jl;
        f32x4 acc[5];
#pragma unroll
        for (int b = 0; b < 5; ++b) acc[b] = (f32x4){0.f, 0.f, 0.f, 0.f};
        for (int it = 0; it < 256; it += 16) {
            f32x4 w[16];
#pragma unroll
            for (int u = 0; u < 16; ++u) w[u] = __builtin_nontemporal_load((const GAS f32x4*)(wp + (size_t)(it + u) * 16 * NMODW));
            __builtin_amdgcn_sched_barrier(0);
#pragma unroll
            for (int u = 0; u < 16; ++u) { const int k = 2 * F.wave + (act ? rg : 0) + 16 * (it + u);
#pragma unroll
                for (int b = 0; b < 5; ++b) { const float s = sl[b * DM + k]; acc[b] += w[u] * s; } }
        }
        if (act) {
#pragma unroll
            for (int b = 0; b < 5; ++b)
#pragma unroll
                for (int e = 0; e < 4; ++e) red[(F.wave * 48 + F.lane) * 20 + b * 4 + e] = acc[b][e];
        }
        __syncthreads();
        RELAUNDER(F);
        if (F.tid < 480) { const int b = F.tid / 96, jj = F.tid % 96, jl2 = jj >> 2, e = jj & 3; float s = 0.f;
#pragma unroll
            for (int w = 0; w < 8; ++w) s += red[(w * 48 + jl2) * 20 + b * 4 + e] + red[(w * 48 + 24 + jl2) * 20 + b * 4 + e];
            F.MOD[(size_t)b * NMODW + 96 * jt + jj] = s + F.b_ada[96 * jt + jj]; }
        __syncthreads();
    }
    __syncthreads();
}
template <int PART> __device__ __forceinline__ void p0_weights(Frame& F) {
    RELAUNDER(F);
    const int gw = F.vcu * NWAVES + F.wave, NGW = F.G * NWAVES;
    constexpr int I_IN = (DM / 8) * (NPROJ / 256), I_O = (DM / 8) * (DM / 256), I_1 = (DM / 8) * (DFF / 256), I_2 = (DFF / 8) * (DM / 256);
    constexpr int NITEMS = I_IN + I_O + I_1 + I_2;
#define P0_DECODE(it_, src_, N_, dst_) do { int r_ = (it_); const float* W_; bf16* T_; \
        if (r_ < I_IN) { W_ = F.w_in; T_ = F.Win_t; N_ = NPROJ; } else { r_ -= I_IN; \
        if (r_ < I_O) { W_ = F.w_out; T_ = F.Wout_t; N_ = DM; } else { r_ -= I_O; \
        if (r_ < I_1) { W_ = F.w_mlp_in; T_ = F.W1_t; N_ = DFF; } else { r_ -= I_1; W_ = F.w_mlp_out; T_ = F.W2_t; N_ = DM; } } } \
        const int nblk_ = N_ / 256, ko_ = r_ / nblk_, nb_ = r_ % nblk_; src_ = W_ + (size_t)(8 * ko_) * N_ + 256 * nb_ + 4 * F.lane; dst_ = T_ + ((size_t)ko_ * (N_ + OPAD) + 256 * nb_ + 32 * (4 * ((F.lane >> 3) & 1) + (F.lane >> 4)) + 16 * (F.lane & 1) + 4 * ((F.lane & 7) >> 1)) * 8; } while (0)
#define P0_PACK_STORE(r_, dst_) do { _Pragma("unroll") for (int e_ = 0; e_ < 4; ++e_) { v4u o_; o_.x = pk2(r_[0][e_], r_[1][e_]); o_.y = pk2(r_[2][e_], r_[3][e_]); o_.z = pk2(r_[4][e_], r_[5][e_]); o_.w = pk2(r_[6][e_], r_[7][e_]); \
        *(GAS v4u*)((dst_) + 8 * e_) = o_; } } while (0)
    constexpr int IT_LO = (PART == 1) ? I_IN : (PART == 2) ? I_IN + I_O : 0, IT_HI = (PART == 0) ? I_IN : (PART == 1) ? I_IN + I_O : NITEMS;
    for (int it = IT_LO + gw; it < IT_HI; it += 2 * NGW) {
        const float* s0; const float* s1; bf16* d0; bf16* d1; int N0, N1; const bool two = it + NGW < IT_HI;
        const int ia = (PART == 2) ? IT_LO + IT_HI - 1 - it : it, ib = two ? ((PART == 2) ? ia - NGW : it + NGW) : ia;
        P0_DECODE(ia, s0, N0, d0); P0_DECODE(ib, s1, N1, d1);
        f32x4 ra[8], rb[8];
#pragma unroll
        for (int k = 0; k < 8; ++k) ra[k] = __builtin_nontemporal_load((const GAS f32x4*)(s0 + (size_t)k * N0));
#pragma unroll
        for (int k = 0; k < 8; ++k) rb[k] = __builtin_nontemporal_load((const GAS f32x4*)(s1 + (size_t)k * N1));
        __builtin_amdgcn_sched_barrier(0);
        P0_PACK_STORE(ra, d0);
        if (two) P0_PACK_STORE(rb, d1);
    }
#undef P0_DECODE
#undef P0_PACK_STORE
    if (PART == 0)
    for (int r = gw; r < 2 * 4 * PAST; r += NGW) {
        if (r < 4 * PAST) { const int b = r / PAST, j = r % PAST; cvt_row2048(F.cache_k + (size_t)r * DATT, F.KB + (size_t)(M_CTX + b * KV_LAT + LAT_SEQ + j) * DATT, F.lane); }
        else { const int rr = r - 4 * PAST; cvt_row2048(F.cache_v + (size_t)rr * DATT, F.CV + (size_t)rr * DATT, F.lane); }
    }
}

__device__ __forceinline__ void unpack8(const v4u w, float (&f)[8]) { f[0] = bflo(w.x); f[1] = bfhi(w.x); f[2] = bflo(w.y); f[3] = bfhi(w.y); f[4] = bflo(w.z); f[5] = bfhi(w.z); f[6] = bflo(w.w); f[7] = bfhi(w.w); }
__device__ __forceinline__ v4u pack8(const float (&f)[8]) { v4u o; o.x = pk2(f[0], f[1]); o.y = pk2(f[2], f[3]); o.z = pk2(f[4], f[5]); o.w = pk2(f[6], f[7]); return o; }
template <int WHICH> __device__ __forceinline__ void norm_mod_phase(Frame& F) {
    RELAUNDER(F);
    LAS float* gs = (LAS float*)(F.lds);
    LAS float* sh = (LAS float*)(F.lds + 16384);
    const float* g = WHICH ? F.norm_mlp_g : F.norm_attn_g;
    const int NR = MTOT / 8;
    const int r_lo = (int)(((long)blockIdx.x * NR) / F.G), r_hi = (int)(((long)(blockIdx.x + 1) * NR) / F.G);
    int cur_b = -1;
    for (int r8 = r_lo; r8 < r_hi; ++r8) {
        const int m0 = r8 * 8; const int b = m0 < M_CTX ? 0 : 1 + ((m0 - M_CTX) >> 10);
        if (b != cur_b) {
            __syncthreads();
            const float* scp = F.MOD + (size_t)b * NMODW + (WHICH ? 4 : 1) * DM; const float* shp = F.MOD + (size_t)b * NMODW + (WHICH ? 3 : 0) * DM;
            for (int i = F.tid; i < DM; i += NWAVES * 64) { gs[i] = g[i] * (1.f + scp[i]); sh[i] = shp[i]; }
            __syncthreads(); cur_b = b;
        }
        const int m = m0 + F.wave;
        if (WHICH == 0) {
            const float* xrow = m < M_CTX ? F.x_prompt + (size_t)m * DM : F.x_sample + (size_t)(m - M_CTX) * DM;
            const GAS f32x4* xr = (const GAS f32x4*)xrow + F.lane;
            f32x4 v[16]; float s = 0.f;
#pragma unroll
            for (int j = 0; j < 16; ++j) { v[j] = __builtin_nontemporal_load(xr + 64 * j); }
#pragma unroll
            for (int j = 0; j < 16; ++j) { s += (v[j].x * v[j].x + v[j].y * v[j].y) + (v[j].z * v[j].z + v[j].w * v[j].w); }
            const float rstd = 1.f / sqrtf(wave_sum(s) * (1.f / DM) + EPS);
            GAS v2u* o8 = (GAS v2u*)(F.XN + (size_t)m * LDX) + F.lane;
#pragma unroll
            for (int j = 0; j < 16; ++j) { const f32x4 gg = *(const LAS f32x4*)(gs + 4 * (F.lane + 64 * j)), ss = *(const LAS f32x4*)(sh + 4 * (F.lane + 64 * j));
                const f32x4 y = v[j] * rstd * gg + ss; v2u w; w.x = pk2(y.x, y.y); w.y = pk2(y.z, y.w); o8[64 * j] = w; }
        } else {
            const GAS v4u* xr = (const GAS v4u*)(F.X1B + (size_t)m * LDX) + F.lane;
            v4u xv[8]; float s = 0.f;
#pragma unroll
            for (int j = 0; j < 8; ++j) xv[j] = __builtin_nontemporal_load(xr + 64 * j);
            float f[8][8];
#pragma unroll
            for (int j = 0; j < 8; ++j) { unpack8(xv[j], f[j]);
#pragma unroll
                for (int e = 0; e < 8; ++e) s += f[j][e] * f[j][e]; }
            const float rstd = 1.f / sqrtf(wave_sum(s) * (1.f / DM) + EPS);
            GAS v4u* o16 = (GAS v4u*)(F.XN + (size_t)m * LDX) + F.lane;
#pragma unroll
            for (int j = 0; j < 8; ++j) { const int col = 8 * (F.lane + 64 * j);
                const f32x4 g0 = *(const LAS f32x4*)(gs + col), g1 = *(const LAS f32x4*)(gs + col + 4), s0 = *(const LAS f32x4*)(sh + col), s1 = *(const LAS f32x4*)(sh + col + 4);
                float y[8];
#pragma unroll
                for (int e = 0; e < 4; ++e) { y[e] = f[j][e] * rstd * g0[e] + s0[e]; y[4 + e] = f[j][4 + e] * rstd * g1[e] + s1[e]; }
                o16[64 * j] = pack8(y); }
        }
    }
}


__device__ __forceinline__ void post_proj_phase(Frame& F) {
    RELAUNDER(F);
    float* new_k = F.out + (size_t)MTOT * DM; float* new_v = new_k + (size_t)M_CTX * DATT;
    const int l8 = F.lane & 7, ax = l8 >> 2, i0 = (l8 & 3) * 8;
    float inv[8], gq1[8], gq2[8], gk1[8], gk2[8];
#pragma unroll
    for (int j = 0; j < 8; ++j) { inv[j] = exp2f(-(float)(2 * (i0 + j)) * (13.287712379549449f / 64.f));
        gq1[j] = F.q_norm_g[ax * 64 + i0 + j]; gq2[j] = F.q_norm_g[ax * 64 + 32 + i0 + j]; gk1[j] = F.k_norm_g[ax * 64 + i0 + j]; gk2[j] = F.k_norm_g[ax * 64 + 32 + i0 + j]; }
    const int NR = MTOT / 8;
    const int r_lo = (int)(((long)blockIdx.x * NR) / F.G), r_hi = (int)(((long)(blockIdx.x + 1) * NR) / F.G);
    for (int r8 = r_lo; r8 < r_hi; ++r8) {
        const int m = r8 * 8 + F.wave; const bool lat = m >= M_CTX;
        const int t = lat ? ((m - M_CTX) & (LAT_SEQ - 1)) : (m & (CTX_SEQ - 1)); const int L = lat ? LAT_SEQ : CTX_SEQ;
        const int krow = lat ? (M_CTX + ((m - M_CTX) >> 10) * KV_LAT + t) : m;
        const bf16* prow = F.PROJ + (size_t)m * LDP;
        v4u A[2][2][2]; v2u V8[8];
#pragma unroll
        for (int part = 0; part < 2; ++part)
#pragma unroll
            for (int pass = 0; pass < 2; ++pass) { const int cb = (pass * 8 + (F.lane >> 3)) * 128 + ax * 64 + i0;
                A[part][pass][0] = __builtin_nontemporal_load((const GAS v4u*)(prow + part * DATT + cb)); A[part][pass][1] = __builtin_nontemporal_load((const GAS v4u*)(prow + part * DATT + cb + 32)); }
        if (!lat) {
#pragma unroll
            for (int j = 0; j < 8; ++j) V8[j] = *(const GAS v2u*)(prow + 2 * DATT + 4 * (F.lane + 64 * j));
        }
        __builtin_amdgcn_sched_barrier(0);
#pragma unroll
        for (int part = 0; part < 2; ++part) {
#pragma unroll
            for (int pass = 0; pass < 2; ++pass) {
                const int gidx = pass * 8 + (F.lane >> 3); const int cb = gidx * 128 + ax * 64 + i0;
                float x1[8], x2[8];
                unpack8(A[part][pass][0], x1); unpack8(A[part][pass][1], x2);
                float ss = 0.f;
#pragma unroll
                for (int j = 0; j < 8; ++j) ss += x1[j] * x1[j] + x2[j] * x2[j];
                ss += __shfl_xor(ss, 1); ss += __shfl_xor(ss, 2); ss += __shfl_xor(ss, 4);
                const float rstd = 1.f / sqrtf(ss * (1.f / 128.f) + EPS);
#pragma unroll
                for (int j = 0; j < 8; ++j) { x1[j] = x1[j] * rstd * (part ? gk1[j] : gq1[j]); x2[j] = x2[j] * rstd * (part ? gk2[j] : gq2[j]); }
                if (part == 1 && !lat) {
                    float* nk = new_k + (size_t)m * DATT + cb;
                    __builtin_nontemporal_store((f32x4){x1[0], x1[1], x1[2], x1[3]}, (GAS f32x4*)(nk)); __builtin_nontemporal_store((f32x4){x1[4], x1[5], x1[6], x1[7]}, (GAS f32x4*)(nk + 4));
                    __builtin_nontemporal_store((f32x4){x2[0], x2[1], x2[2], x2[3]}, (GAS f32x4*)(nk + 32)); __builtin_nontemporal_store((f32x4){x2[4], x2[5], x2[6], x2[7]}, (GAS f32x4*)(nk + 36));
                }
                if (lat) {
                    const float pos = (float)(ax == 0 ? (t >> 6) : (t & 63));
#pragma unroll
                    for (int j = 0; j < 8; ++j) { const float ang = pos * inv[j]; const float cs = __cosf(ang), sn = __sinf(ang);
                        const float a = x1[j], b = x2[j]; x1[j] = a * cs - b * sn; x2[j] = a * sn + b * cs; }
                }
                bf16* dst = part ? (F.KB + (size_t)krow * DATT + cb) : (F.QB + (size_t)m * DATT + cb);
                *(GAS v4u*)(dst) = pack8(x1); *(GAS v4u*)(dst + 32) = pack8(x2);
            }
        }
        if (!lat) {
#pragma unroll
            for (int j = 0; j < 8; ++j) { const int col = 4 * (F.lane + 64 * j);
                __builtin_nontemporal_store((f32x4){bflo(V8[j].x), bfhi(V8[j].x), bflo(V8[j].y), bfhi(V8[j].y)}, (GAS f32x4*)(new_v + (size_t)m * DATT + col)); }
        }
        const bool hm = t > 0, hp = t < L - 1;
        const bf16* pm_ = hm ? prow - LDP : prow; const bf16* pp_ = hp ? prow + LDP : prow;
        const float fm = hm ? 1.f : 0.f, fp = hp ? 1.f : 0.f;
#pragma unroll
        for (int pb = 0; pb < 2; ++pb) {
            v4u C[2][7]; f32x4 W[2][6];
#pragma unroll
            for (int q = 0; q < 2; ++q) { const int ch = 8 * (F.lane + 64 * (2 * pb + q));
                C[q][0] = __builtin_nontemporal_load((const GAS v4u*)(prow + 3 * DATT + ch)); C[q][1] = *(const GAS v4u*)(prow + 4 * DATT + ch); C[q][2] = *(const GAS v4u*)(prow + 5 * DATT + ch);
                C[q][3] = *(const GAS v4u*)(pm_ + 4 * DATT + ch); C[q][4] = *(const GAS v4u*)(pm_ + 5 * DATT + ch);
                C[q][5] = *(const GAS v4u*)(pp_ + 4 * DATT + ch); C[q][6] = *(const GAS v4u*)(pp_ + 5 * DATT + ch);
#pragma unroll
                for (int k = 0; k < 3; ++k) { W[q][2 * k] = *(const GAS f32x4*)(F.conv_w + k * DATT + ch); W[q][2 * k + 1] = *(const GAS f32x4*)(F.conv_w + k * DATT + ch + 4); } }
            __builtin_amdgcn_sched_barrier(0);
#pragma unroll
            for (int q = 0; q < 2; ++q) { const int ch = 8 * (F.lane + 64 * (2 * pb + q));
                float bg[8], c0[8], u0[8], cm[8], um[8], cp[8], up[8];
                unpack8(C[q][0], bg); unpack8(C[q][1], c0); unpack8(C[q][2], u0); unpack8(C[q][3], cm); unpack8(C[q][4], um); unpack8(C[q][5], cp); unpack8(C[q][6], up);
                float y[8];
#pragma unroll
                for (int j = 0; j < 8; ++j) { const float w0 = W[q][j >> 2][j & 3], w1 = W[q][2 + (j >> 2)][j & 3], w2 = W[q][4 + (j >> 2)][j & 3];
                    y[j] = bg[j] * (w0 * (cm[j] * um[j]) * fm + w1 * (c0[j] * u0[j]) + w2 * (cp[j] * up[j]) * fp); }
                *(GAS v4u*)(F.MIX + (size_t)m * LDX + DATT + ch) = pack8(y); }
        }
    }
}

namespace att {
using s16x4  = __attribute__((ext_vector_type(4))) short;
using f32x16 = __attribute__((ext_vector_type(16))) float;
constexpr int KVBLK = 64;
constexpr float SCALE = 0.088388347648318440f;
constexpr float THR = 8.f;
constexpr int SHM_K = KVBLK * 128 * 2, SHM_V = KVBLK * 256 * 2;
constexpr int OFF_V = 0, OFF_K = 2 * SHM_V, OFF_WS = OFF_K + 2 * SHM_K, OFF_SSQ = OFF_WS + NWAVES * 256, ATT_LDS = OFF_SSQ + 128 * 2 * 4;
static_assert(ATT_LDS <= RING_BYTES, "attention LDS");
#define KSWZ(row, colB) ((row) * 256 + ((colB) ^ (((row) & 7) << 4)))
#define SBAR() __builtin_amdgcn_sched_barrier(0)
__device__ __forceinline__ int crow(int r, int hi) { return (r & 3) + 8 * (r >> 2) + 4 * hi; }
__device__ __forceinline__ unsigned cvtpk(float lo, float hi) { unsigned r; asm volatile("v_cvt_pk_bf16_f32 %0, %1, %2" : "=v"(r) : "v"(lo), "v"(hi)); return r; }

__device__ __forceinline__ void partialSM(f32x16& p0, f32x16& p1, float& m_reg, float& mn, float& alpha) {
  constexpr float C = SCALE * 1.4426950408889634f;
  float pmax = p0[0];
#pragma unroll
  for (int r = 1; r < 16; ++r) pmax = fmaxf(pmax, p0[r]);
#pragma unroll
  for (int r = 0; r < 16; ++r) pmax = fmaxf(pmax, p1[r]);
  { auto rr = __builtin_amdgcn_permlane32_swap(__float_as_uint(pmax), __float_as_uint(pmax), false, false);
    pmax = fmaxf(__uint_as_float(rr[0]), __uint_as_float(rr[1])); }
  if (__builtin_expect(__all(pmax - m_reg <= THR / SCALE), 1)) { mn = m_reg; alpha = 1.f; }
  else { mn = fmaxf(m_reg, pmax); alpha = __builtin_amdgcn_exp2f((m_reg - mn) * C); m_reg = mn; }
  float mnC = -mn * C;
#pragma unroll
  for (int r = 0; r < 16; ++r) p0[r] = fmaf(p0[r], C, mnC);
#pragma unroll
  for (int r = 0; r < 16; ++r) p1[r] = fmaf(p1[r], C, mnC);
#pragma unroll
  for (int r = 0; r < 16; ++r) p0[r] = __builtin_amdgcn_exp2f(p0[r]);
}
__device__ __forceinline__ void finishSM(f32x16& p0, f32x16& p1, float alpha, float& l_reg, bf16x8& pa0, bf16x8& pa1, bf16x8& pa2, bf16x8& pa3) {
#pragma unroll
  for (int r = 0; r < 16; ++r) p1[r] = __builtin_amdgcn_exp2f(p1[r]);
  float ps = 0;
#pragma unroll
  for (int r = 0; r < 16; ++r) ps += p0[r];
#pragma unroll
  for (int r = 0; r < 16; ++r) ps += p1[r];
  { auto rr = __builtin_amdgcn_permlane32_swap(__float_as_uint(ps), __float_as_uint(ps), false, false);
    ps = __uint_as_float(rr[0]) + __uint_as_float(rr[1]); }
  l_reg = l_reg * alpha + ps;
#define PK4(P, BASE, OUT) do { unsigned a0 = cvtpk(P[BASE + 0], P[BASE + 1]), a1 = cvtpk(P[BASE + 2], P[BASE + 3]);   \
    unsigned b0 = cvtpk(P[BASE + 4], P[BASE + 5]), b1 = cvtpk(P[BASE + 6], P[BASE + 7]);                              \
    auto r0 = __builtin_amdgcn_permlane32_swap(a0, b0, false, false); auto r1 = __builtin_amdgcn_permlane32_swap(a1, b1, false, false); \
    v4u w = {r0[0], r1[0], r0[1], r1[1]}; OUT = *reinterpret_cast<bf16x8*>(&w); } while (0)
  PK4(p0, 0, pa0); PK4(p0, 8, pa1); PK4(p1, 0, pa2); PK4(p1, 8, pa3);
#undef PK4
}
__device__ __forceinline__ void qkt(f32x16& p0, f32x16& p1, const LAS char* Ks, const bf16x8* qr, int r32, int hi) {
  p0 = f32x16{}; p1 = f32x16{};
#pragma unroll
  for (int d0 = 0; d0 < 8; ++d0) { int cb = (d0 * 16 + hi * 8) * 2;
    bf16x8 b0 = *reinterpret_cast<const LAS bf16x8*>(Ks + KSWZ(r32, cb));
    bf16x8 b1 = *reinterpret_cast<const LAS bf16x8*>(Ks + KSWZ(32 + r32, cb));
    p0 = __builtin_amdgcn_mfma_f32_32x32x16_bf16(b0, qr[d0], p0, 0, 0, 0);
    p1 = __builtin_amdgcn_mfma_f32_32x32x16_bf16(b1, qr[d0], p1, 0, 0, 0); }
}
__device__ __forceinline__ int v_st(int k, int c) { const int kk = (k & ~0xC) | ((k & 4) << 1) | ((k & 8) >> 1); return ((kk >> 3) * 4 + (c >> 5)) * 512 + ((kk & 7) * 32 + (c & 31)) * 2; }
__device__ __forceinline__ int v_rd_base(int lane) { return ((lane & 3) << 3) | (((lane >> 2) & 3) << 6) | (((lane >> 4) & 1) << 5) | (((lane >> 5) & 1) << 8); }
constexpr int v_rd_off(int d0, int ks, int half) { return d0 * 512 + ks * 4096 + half * 2048; }
template <int OFF> __device__ __forceinline__ s16x4 tr_read(int vb) {
  s16x4 r; asm volatile("ds_read_b64_tr_b16 %0, %1 offset:%2" : "=&v"(r) : "v"(vb), "i"(OFF) : "memory"); return r;
}
template <int D0> __device__ __forceinline__ void pv_one(f32x16& od, int vb, bf16x8 pa0, bf16x8 pa1, bf16x8 pa2, bf16x8 pa3) {
  const s16x4 l0 = tr_read<v_rd_off(D0, 0, 0)>(vb), h0 = tr_read<v_rd_off(D0, 0, 1)>(vb), l1 = tr_read<v_rd_off(D0, 1, 0)>(vb), h1 = tr_read<v_rd_off(D0, 1, 1)>(vb);
  const s16x4 l2 = tr_read<v_rd_off(D0, 2, 0)>(vb), h2 = tr_read<v_rd_off(D0, 2, 1)>(vb), l3 = tr_read<v_rd_off(D0, 3, 0)>(vb), h3 = tr_read<v_rd_off(D0, 3, 1)>(vb);
  asm volatile("s_waitcnt lgkmcnt(0)" ::: "memory"); SBAR();
#define PK(L, H) (bf16x8){L[0], L[1], L[2], L[3], H[0], H[1], H[2], H[3]}
  od = __builtin_amdgcn_mfma_f32_32x32x16_bf16(pa0, PK(l0, h0), od, 0, 0, 0);
  od = __builtin_amdgcn_mfma_f32_32x32x16_bf16(pa1, PK(l1, h1), od, 0, 0, 0);
  od = __builtin_amdgcn_mfma_f32_32x32x16_bf16(pa2, PK(l2, h2), od, 0, 0, 0);
  od = __builtin_amdgcn_mfma_f32_32x32x16_bf16(pa3, PK(l3, h3), od, 0, 0, 0);
#undef PK
}
__device__ __forceinline__ void pv_d0(f32x16* o, int vb, bf16x8 pa0, bf16x8 pa1, bf16x8 pa2, bf16x8 pa3) {
  pv_one<0>(o[0], vb, pa0, pa1, pa2, pa3); pv_one<1>(o[1], vb, pa0, pa1, pa2, pa3); pv_one<2>(o[2], vb, pa0, pa1, pa2, pa3); pv_one<3>(o[3], vb, pa0, pa1, pa2, pa3);
}

__device__ __forceinline__ void attn_unit(const bf16* Qp, const bf16* Kp, const bf16* V0p, int nself, const bf16* V1p, int nkeys, bf16* Op,
                                          float* park, const float* subln_g, float lam, float oscale, LAS char* lds) {
  int tid_l = threadIdx.x; asm volatile("" : "+v"(tid_l));
  const int tid = tid_l, wid = __builtin_amdgcn_readfirstlane(tid >> 6), lane = tid & 63, r32 = lane & 31, hi = lane >> 5, rg = wid >> 1, e = wid & 1;
  LAS char* V_lds = lds + OFF_V; LAS char* K_lds = lds + OFF_K;
  LAS float* wsf = (LAS float*)(lds + OFF_WS) + wid * 64; LAS float* li_l = wsf; LAS float* al_l = wsf + 32;
  LAS float* ssq = (LAS float*)(lds + OFF_SSQ);
  const int sr = tid >> 4, sc = (tid & 15) * 8, vst0 = v_st(sr, sc), vst1 = v_st(32 + sr, sc);
  const int vb0 = (int)(unsigned)(uintptr_t)(V_lds + e * (SHM_V / 2)) + v_rd_base(lane);
  const int NT = nkeys / KVBLK;
  const unsigned voS = (unsigned)(sr * LDP + sc), voC = (unsigned)(sr * DATT + sc);
  f32x16 o[4];
  float rli[16];
  for (int c = 0; c < 2; ++c) {
    float m_reg = -1e30f, l_reg = 0;
#pragma unroll
    for (int d = 0; d < 4; ++d) o[d] = f32x16{};
    bf16x8 qr[8];
    { const bf16* Qw = Qp + (size_t)(rg * 32 + r32) * DATT + c * 128 + hi * 8;
#pragma unroll
      for (int d0 = 0; d0 < 8; ++d0) qr[d0] = *(const GAS bf16x8*)(Qw + d0 * 16); }
    const bf16* Kh = Kp + c * 128;
    bf16x8 vs0, vs1, vs2, vs3, ks0, ks1;
#define SLOAD(k0) do { const int kk_ = (k0); const bool self_ = kk_ < nself; \
    const bf16* vu_ = self_ ? V0p + (size_t)kk_ * LDP : V1p + (size_t)(kk_ - nself) * DATT; const unsigned vo_ = self_ ? voS : voC, vst_ = self_ ? 32u * LDP : 32u * DATT; \
    vs0 = *(const GAS bf16x8*)(vu_ + vo_); vs1 = *(const GAS bf16x8*)(vu_ + (vo_ + 128u)); vs2 = *(const GAS bf16x8*)(vu_ + (vo_ + vst_)); vs3 = *(const GAS bf16x8*)(vu_ + (vo_ + vst_ + 128u)); \
    const bf16* ku_ = Kh + (size_t)kk_ * DATT; ks0 = *(const GAS bf16x8*)(ku_ + voC); ks1 = *(const GAS bf16x8*)(ku_ + (voC + 32u * DATT)); } while (0)
#define SWRITE(b) do { LAS char* vb_ = V_lds + (b) * SHM_V; LAS char* kb_ = K_lds + (b) * SHM_K; const int kc = sc * 2; \
    *(LAS bf16x8*)(vb_ + vst0) = vs0; *(LAS bf16x8*)(vb_ + SHM_V / 2 + vst0) = vs1; *(LAS bf16x8*)(vb_ + vst1) = vs2; *(LAS bf16x8*)(vb_ + SHM_V / 2 + vst1) = vs3; \
    *(LAS bf16x8*)(kb_ + KSWZ(sr, kc)) = ks0; *(LAS bf16x8*)(kb_ + KSWZ(32 + sr, kc)) = ks1; } while (0)
#define SWAIT() asm volatile("s_waitcnt vmcnt(0)" ::: "memory")
#define RESC(a) do { if (__any((a) < 1.f)) { if (hi == 0) al_l[r32] = (a); asm volatile("s_waitcnt lgkmcnt(0)" ::: "memory"); \
    _Pragma("unroll") for (int d = 0; d < 4; ++d) _Pragma("unroll") for (int r = 0; r < 16; ++r) o[d][r] *= al_l[crow(r, hi)]; } } while (0)
    f32x16 p0, p1; float mn, al; bf16x8 pa0, pa1, pa2, pa3;
    __syncthreads();
    SLOAD(0); SWAIT(); SWRITE(0); __syncthreads();
    for (int j = 0; j < NT; ++j) {
      const int buf = j & 1; const bool more = j + 1 < NT;
      if (more) SLOAD((j + 1) * KVBLK);
      SBAR(); qkt(p0, p1, K_lds + buf * SHM_K, qr, r32, hi);
      partialSM(p0, p1, m_reg, mn, al);
      RESC(al);
      finishSM(p0, p1, al, l_reg, pa0, pa1, pa2, pa3); SBAR();
      pv_d0(o, vb0 + buf * SHM_V, pa0, pa1, pa2, pa3);
      if (more) { SWAIT(); SWRITE(buf ^ 1); }
      __syncthreads();
    }
#undef SLOAD
#undef SWRITE
#undef SWAIT
#undef RESC
    int hi_ = hi, r32_ = r32, wid_ = wid; asm volatile("" : "+v"(hi_), "+v"(r32_), "+s"(wid_));
    LAS float* li2 = (LAS float*)(lds + OFF_WS) + wid_ * 64;
    if (hi_ == 0) li2[r32_] = l_reg; asm volatile("s_waitcnt lgkmcnt(0)" ::: "memory");
#pragma unroll
    for (int r = 0; r < 16; ++r) rli[r] = __builtin_amdgcn_rcpf(li2[crow(r, hi_)]);
    if (c == 0) {
      float* pk = park + (size_t)wid_ * 4096 + (hi_ * 32 + r32_);
#pragma unroll
      for (int d = 0; d < 4; ++d)
#pragma unroll
        for (int r = 0; r < 16; ++r) pk[(d * 16 + r) * 64] = o[d][r] * rli[r];
    }
  }
  int hi_ = hi, r32_ = r32, wid_ = wid; asm volatile("" : "+v"(hi_), "+v"(r32_), "+s"(wid_));
  const int rg_ = wid_ >> 1, e_ = wid_ & 1;
  const float* pk = park + (size_t)wid_ * 4096 + (hi_ * 32 + r32_);
  asm volatile("s_waitcnt vmcnt(0)" ::: "memory");
  float q[16];
#pragma unroll
  for (int r = 0; r < 16; ++r) q[r] = 0.f;
#pragma unroll
  for (int d = 0; d < 4; ++d) {
#pragma unroll
    for (int r = 0; r < 16; ++r) { const float v = pk[(d * 16 + r) * 64] - lam * (o[d][r] * rli[r]); o[d][r] = v; q[r] += v * v; }
    asm volatile("" ::: "memory"); }
#pragma unroll
  for (int r = 0; r < 16; ++r) { float s = q[r]; s += __shfl_xor(s, 1); s += __shfl_xor(s, 2); s += __shfl_xor(s, 4); s += __shfl_xor(s, 8); s += __shfl_xor(s, 16); q[r] = s; }
  if (r32_ == 0) {
#pragma unroll
    for (int r = 0; r < 16; ++r) ssq[(rg_ * 32 + crow(r, hi_)) * 2 + e_] = q[r];
  }
  __syncthreads();
  float g4[4];
#pragma unroll
  for (int d = 0; d < 4; ++d) g4[d] = subln_g[e_ * 128 + d * 32 + r32_] * oscale;
  bf16* ob = Op + (size_t)(rg_ * 32 + 4 * hi_) * LDX + e_ * 128 + r32_;
  const LAS float* sq = ssq + (rg_ * 32 + 4 * hi_) * 2;
#pragma unroll
  for (int r = 0; r < 16; ++r) { const int rr = (r & 3) + 8 * (r >> 2); const float tot = sq[rr * 2] + sq[rr * 2 + 1]; const float rstd = __builtin_amdgcn_rsqf(tot * (1.f / 256.f) + EPS);
    bf16* orow = ob + (size_t)rr * LDX;
#pragma unroll
    for (int d = 0; d < 4; ++d) { const unsigned w = cvtpk(o[d][r] * rstd * g4[d], 0.f); orow[d * 32] = (bf16)(w & 0xffffu); } }
}
#undef KSWZ
#undef SBAR
}

__device__ __forceinline__ void attention_phase(Frame& F) {
    RELAUNDER(F);
    const float d1 = wave_sum(F.lq1[F.lane] * F.lk1[F.lane] + F.lq1[F.lane + 64] * F.lk1[F.lane + 64]);
    const float d2 = wave_sum(F.lq2[F.lane] * F.lk2[F.lane] + F.lq2[F.lane + 64] * F.lk2[F.lane + 64]);
    const float lam_init = 0.2f; const float lam = __expf(d1) - __expf(d2) + lam_init; const float oscale = 1.f - lam_init;
    float* park = F.PARK + (size_t)blockIdx.x * (NWAVES * 4096);
    LAS char* lds = (LAS char*)(F.lds + RING_OFF);
    for (int idx = F.vcu; idx < 768; idx += F.G) {
        const bool lat = idx < 256; const int u = lat ? idx : idx - 256;
        const int b = lat ? (u >> 6) : (u >> 4), h = lat ? ((u >> 3) & 7) : ((u >> 1) & 7), qb = lat ? (u & 7) : (u & 1);
        const int m0 = lat ? M_CTX + b * LAT_SEQ : b * CTX_SEQ; const int k0row = lat ? M_CTX + b * KV_LAT : m0;
        att::attn_unit(F.QB + (size_t)(m0 + qb * 128) * DATT + h * 256, F.KB + (size_t)k0row * DATT + h * 256,
                       F.PROJ + (size_t)m0 * LDP + 2 * DATT + h * 256, lat ? LAT_SEQ : CTX_SEQ, F.CV + (size_t)(b & 3) * PAST * DATT + h * 256, lat ? KV_LAT : CTX_SEQ,
                       F.MIX + (size_t)(m0 + qb * 128) * LDX + h * 256, park, F.subln_g, lam, oscale, lds);
    }
}

struct Args { const float* in[22]; float* out; unsigned char* ws; int ph_lo, ph_hi; };
__global__ void __launch_bounds__(NWAVES * 64, 2) mk_fwd(Args args) {
    extern __shared__ __attribute__((aligned(16))) unsigned char lds[];
    Frame F;
    F.lds = (LAS unsigned char*)lds;
    F.MISC = (volatile LAS unsigned*)(F.lds + MISC_OFF);
    F.tid = threadIdx.x; F.lane = F.tid & 63; F.wave = __builtin_amdgcn_readfirstlane(F.tid >> 6);
    F.G = gridDim.x; { const int bx = blockIdx.x; F.vcu = (F.G % 8 == 0) ? (bx % 8) * (F.G / 8) + bx / 8 : bx; }
    unsigned char* ws = args.ws;
    F.ctl = (gu32*)(ws + WS_CTL);
    F.x_prompt = args.in[0]; F.x_sample = args.in[1]; F.cache_k = args.in[2]; F.cache_v = args.in[3]; F.c = args.in[4]; F.c_ctx = args.in[5];
    F.w_ada = args.in[6]; F.b_ada = args.in[7]; F.norm_attn_g = args.in[8]; F.w_in = args.in[9]; F.q_norm_g = args.in[10]; F.k_norm_g = args.in[11];
    F.lq1 = args.in[12]; F.lk1 = args.in[13]; F.lq2 = args.in[14]; F.lk2 = args.in[15]; F.subln_g = args.in[16]; F.conv_w = args.in[17];
    F.w_out = args.in[18]; F.norm_mlp_g = args.in[19]; F.w_mlp_in = args.in[20]; F.w_mlp_out = args.in[21];
    F.out = args.out;
    F.MOD = (float*)(ws + WS_MOD); F.PARK = (float*)(ws + WS_PARK);
    F.Win_t = (bf16*)(ws + WS_WIN); F.Wout_t = (bf16*)(ws + WS_WOUT); F.W1_t = (bf16*)(ws + WS_W1); F.W2_t = (bf16*)(ws + WS_W2);
    F.XN = (bf16*)(ws + WS_XN); F.CV = (bf16*)(ws + WS_CV); F.PROJ = (bf16*)(ws + WS_PROJ); F.QB = (bf16*)(ws + WS_QB); F.KB = (bf16*)(ws + WS_KB);
    F.MIX = (bf16*)(ws + WS_MIX); F.HB = (bf16*)(ws + WS_H); F.X1B = (bf16*)(ws + WS_X1B);
    for (int u = F.tid; u < (LDS_BYTES - LDSCTL_OFF) / 4; u += NWAVES * 64) ((LAS unsigned*)(F.lds + LDSCTL_OFF))[u] = 0u;
    __syncthreads();
    XcdBarrier bar; bar.bar = (unsigned*)(F.ctl + CW_BAR); bar.x = 0; bar.st = nullptr;
    if (N_LAUNCHES == 1) bar = xcd_barrier_post((unsigned*)(F.ctl + CW_BAR), F.MISC + 8);
#define GRID_BAR(seam) do { if (N_LAUNCHES == 1) { xcd_barrier(bar); } } while (0)
    const int lo = args.ph_lo, hi = args.ph_hi;
#ifndef PH_MASK
#define PH_MASK 0x1ff
#endif
#define IN(k) (((PH_MASK >> (k)) & 1) && lo <= (k) && (k) < hi)
#define BOTH(k) (IN(k) && IN((k) + 1))
#define XS_SETUP(S_, gi_) do { (S_).ctr = (unsigned*)(F.ctl + CW_XS) + 64 * (16 * (gi_) + (int)bar.x); (S_).k = 0u; (S_).nloc = (N_LAUNCHES == 1 && lo == 0 && (S_).nwg % F.G == 0) ? F.MISC[8] : 0u; } while (0)
#ifndef PROBE_DUP
#define PROBE_DUP 0
#ifndef PROBE_GROUPED
#define PROBE_GROUPED 1
#endif
#endif
#define DUP(k) ((PROBE_DUP >> (k)) & 1)

    if (IN(0)) { p0_gemv(F); if (DUP(10)) { __syncthreads(); p0_gemv(F); } if (BOTH(0)) GRID_BAR(0); }
    if (IN(1)) { p0_weights<0>(F); norm_mod_phase<0>(F); if (DUP(1)) { __syncthreads(); norm_mod_phase<0>(F); } if (BOTH(1)) GRID_BAR(1); }
    if (IN(2)) {
        pg8::Gemm g{F.XN, F.Win_t, MTOT, NPROJ, DM, LDX, NPROJ + OPAD}; pg8::XcdSyncOrder S; S.init(MTOT, NPROJ, F.G, (int)blockIdx.x); S.grouped = (F.G == 256 && PROBE_GROUPED) ? 1 : 0; XS_SETUP(S, 0);
        pg8::EpiBf16<0> E{F.PROJ, LDP};
        pg8::gemm_phase<pg8::EpiBf16<0>, pg8::XcdSyncOrder, PG8_ALIGN, PG8_SP2>(F.lds + RING_OFF, g, S, E);
        if (DUP(2)) { __syncthreads(); pg8::gemm_phase<pg8::EpiBf16<0>, pg8::XcdSyncOrder, PG8_ALIGN, PG8_SP2>(F.lds + RING_OFF, g, S, E); }
        if (DUP(9)) { __syncthreads(); pg8::EpiNull EN; pg8::gemm_phase<pg8::EpiNull, pg8::XcdSyncOrder, PG8_ALIGN, PG8_SP2>(F.lds + RING_OFF, g, S, EN); }
        if (BOTH(2)) GRID_BAR(2);
    }
    if (IN(3)) { post_proj_phase(F); if (DUP(3)) { __syncthreads(); post_proj_phase(F); } if (BOTH(3)) GRID_BAR(3); }
    if (IN(4)) { attention_phase(F); p0_weights<1>(F); if (DUP(4)) { __syncthreads(); attention_phase(F); } if (BOTH(4)) GRID_BAR(4); }
    if (IN(5)) {
        pg8::Gemm g{F.MIX, F.Wout_t, MTOT, DM, DM, LDX, DM + OPAD}; pg8::XcdSyncOrder S; S.init(MTOT, DM, F.G, (int)blockIdx.x); S.grouped = (F.G == 256 && PROBE_GROUPED) ? 1 : 0; XS_SETUP(S, 1);
        pg8::EpiRes1 E{F.x_prompt, F.x_sample, F.X1B, LDX, F.MOD + 2 * DM};
        pg8::gemm_phase<pg8::EpiRes1, pg8::XcdSyncOrder, PG8_ALIGN, PG8_SP2>(F.lds + RING_OFF, g, S, E);
        if (DUP(5)) { __syncthreads(); pg8::gemm_phase<pg8::EpiRes1, pg8::XcdSyncOrder, PG8_ALIGN, PG8_SP2>(F.lds + RING_OFF, g, S, E); }
        if (BOTH(5)) GRID_BAR(5);
    }
    if (IN(6)) { p0_weights<2>(F); norm_mod_phase<1>(F); if (DUP(6)) { __syncthreads(); norm_mod_phase<1>(F); } if (BOTH(6)) GRID_BAR(6); }
    if (IN(7)) {
#if defined(PROBE_IDLE_US)
        { const unsigned long long t0 = __builtin_amdgcn_s_memrealtime(); while (__builtin_amdgcn_s_memrealtime() - t0 < 100ull * PROBE_IDLE_US) __builtin_amdgcn_s_sleep(32); }
#endif
        pg8::Gemm g{F.XN, F.W1_t, MTOT, DFF, DM, LDX, DFF + OPAD}; pg8::XcdSyncOrder S; S.init(MTOT, DFF, F.G, (int)blockIdx.x); S.grouped = (F.G == 256 && PROBE_GROUPED) ? 2 : 0; XS_SETUP(S, 2);
        pg8::EpiBf16<1> E{F.HB, LDH};
        pg8::gemm_phase<pg8::EpiBf16<1>, pg8::XcdSyncOrder, PG8_ALIGN, PG8_SP2>(F.lds + RING_OFF, g, S, E);
        if (DUP(7)) { __syncthreads(); pg8::gemm_phase<pg8::EpiBf16<1>, pg8::XcdSyncOrder, PG8_ALIGN, PG8_SP2>(F.lds + RING_OFF, g, S, E); }
        if (BOTH(7)) GRID_BAR(7);
    }
    if (IN(8)) {
        pg8::Gemm g{F.HB, F.W2_t, MTOT, DM, DFF, LDH, DM + OPAD}; pg8::XcdSyncOrder S; S.init(MTOT, DM, F.G, (int)blockIdx.x); S.grouped = (F.G == 256 && PROBE_GROUPED) ? 1 : 0; XS_SETUP(S, 3);
        pg8::EpiRes2 E{F.X1B, LDX, F.out, F.MOD + 5 * DM};
        pg8::gemm_phase<pg8::EpiRes2, pg8::XcdSyncOrder, PG8_ALIGN, PG8_SP2>(F.lds + RING_OFF, g, S, E);
        if (DUP(8)) { __syncthreads(); pg8::gemm_phase<pg8::EpiRes2, pg8::XcdSyncOrder, PG8_ALIGN, PG8_SP2>(F.lds + RING_OFF, g, S, E); }
    }
#undef IN
#undef BOTH
}

extern "C" void kernel_launch(void* const* d_in, const int* in_sizes, int n_in, void* d_out, int out_size, void* d_ws, size_t ws_size, hipStream_t stream) {
    static int grid = 0;
    if (grid == 0) {
        if (n_in != 22 || ws_size < WS_END) { fprintf(stderr, "kernel_launch: expected 22 inputs and >= %zu bytes of workspace; got n_in %d, ws %zu; nothing launched\n", (size_t)WS_END, n_in, ws_size); grid = -1; return; }
        int dev = 0, cus = 0, per_cu = 0;
        if (hipGetDevice(&dev) != hipSuccess || hipDeviceGetAttribute(&cus, hipDeviceAttributeMultiprocessorCount, dev) != hipSuccess) { grid = -1; return; }
        if (hipFuncSetAttribute((const void*)mk_fwd, hipFuncAttributeMaxDynamicSharedMemorySize, LDS_BYTES) != hipSuccess) { fprintf(stderr, "kernel_launch: hipFuncSetAttribute failed\n"); grid = -1; return; }
        if (hipOccupancyMaxActiveBlocksPerMultiprocessor(&per_cu, (const void*)mk_fwd, NWAVES * 64, LDS_BYTES) != hipSuccess || per_cu < 1)
            fprintf(stderr, "kernel_launch: note: occupancy query reports %d workgroups per CU\n", per_cu);
        (void)hipGetLastError();
        grid = cus;
    }
    if (grid < 0) return;
    if (hipMemsetAsync((char*)d_ws + WS_CTL, 0, CTL_ZERO_BYTES, stream) != hipSuccess) { fprintf(stderr, "kernel_launch: memset failed\n"); return; }
    Args a{};
    for (int i = 0; i < 22; ++i) a.in[i] = (const float*)d_in[i];
    a.out = (float*)d_out; a.ws = (unsigned char*)d_ws;
    for (int li = 0; li < N_LAUNCHES; ++li) {
        a.ph_lo = (N_LAUNCHES == 1) ? 0 : li; a.ph_hi = (N_LAUNCHES == 1) ? N_PHASES : li + 1;
        hipLaunchKernelGGL(mk_fwd, dim3(grid), dim3(NWAVES * 64), LDS_BYTES, stream, a);
        const hipError_t le = hipPeekAtLastError();
        if (le != hipSuccess) { fprintf(stderr, "kernel_launch: launch %d failed: %s\n", li, hipGetErrorName(le)); break; }
    }
}
```

```cpp
#include <hip/hip_runtime.h>
#include <cstdio>
#include <cstdint>

#ifndef MK_N_LAUNCHES
#define MK_N_LAUNCHES 1
#endif

namespace pg8 {
#define PG8_LAS __attribute__((address_space(3)))
typedef unsigned short bf16_t;
typedef short bf16x8 __attribute__((ext_vector_type(8)));
typedef float f32x4 __attribute__((ext_vector_type(4)));
typedef unsigned u32x4 __attribute__((ext_vector_type(4)));
constexpr int BM = 256, BK = 64, HALF = 128, HTB = HALF * BK * 2  , STAGE_BYTES = 8 * HTB, NXCD = 8, WGM = 8;

__host__ __device__ __forceinline__ int lds_byte(int r, int c) { const int st = (r >> 4) * 2 + (c >> 5), rr = r & 15, cc = c & 31, ob = rr * 64 + cc * 2; return st * 1024 + (ob ^ (((ob >> 9) & 1) << 5)); }
__host__ __device__ __forceinline__ void stage_rc(int b, int& R, int& C) { const int st = b / 1024, sb = b % 1024, swz = sb ^ (((sb >> 9) & 1) << 5); R = (st >> 1) * 16 + swz / 64; C = (st & 1) * 32 + (swz % 64) / 2; }
__host__ __device__ __forceinline__ int perm32(int rho) { const int n = rho >> 4, i = rho & 15; return 8 * (i >> 2) + 4 * n + (i & 3); }

struct Unit { int pm, pn; };
struct Gemm { const bf16_t* A; const bf16_t* Bt; int M, N, K, lda, ldb; };

struct StaticOrder {
    int nM, nN, nwg, G, c;
    __host__ __device__ void init(int M, int N, int G_, int c_) { nM = M / BM; nN = N / BM; nwg = nM * nN; G = G_; c = c_; }
    int grouped = 0;
    __host__ __device__ bool next(int i, Unit& u) const {
        if (grouped == 2) {
            const int x = c & 7, cu = c >> 3, nG = nM >> 3, strip = i / nG, grp = i % nG; if (strip >= (nN >> 5)) return false;
            u.pm = 8 * grp + (cu & 7); u.pn = 4 * (strip * 8 + x) + (cu >> 3); return true; }
        if (grouped) { const int x = c & 7, cu = c >> 3, bpg = nN >> 2, B = i * 8 + x; if (B >= (nM >> 3) * bpg) return false;
            u.pm = 8 * (B / bpg) + (cu & 7); u.pn = 4 * (B % bpg) + (cu >> 3); return true; }
        const long L = (long)i * G + c; if (L >= nwg) return false;
        int wgid = (int)L; { const int q = nwg / NXCD, r = nwg % NXCD, xcd = wgid % NXCD, off = wgid / NXCD; wgid = (xcd < r ? xcd * (q + 1) : r * (q + 1) + (xcd - r) * q) + off; }
        const int nig = WGM * nN, gid = wgid / nig, fm = gid * WGM, gsz = (nM - fm) < WGM ? (nM - fm) : WGM;
        u.pm = fm + ((wgid % nig) % gsz); u.pn = (wgid % nig) / gsz; return true;
    }
    __device__ __forceinline__ void a_ready(const Unit&) const {}
    __device__ __forceinline__ void done(const Unit&) const {}
};
struct XcdSyncOrder : StaticOrder {
    unsigned* ctr; unsigned nloc; mutable unsigned k;
    __device__ __forceinline__ void a_ready(const Unit&) const {
        if (nloc) {
            if (threadIdx.x == 0) { __hip_atomic_fetch_add(ctr, 1u, __ATOMIC_RELAXED, __HIP_MEMORY_SCOPE_AGENT); const unsigned want = nloc * (k + 1u); unsigned sp = 0;
                while (__hip_atomic_load(ctr, __ATOMIC_RELAXED, __HIP_MEMORY_SCOPE_AGENT) < want && ++sp < 4000u) __builtin_amdgcn_s_sleep(1); }
            ++k;
            asm volatile("" ::: "memory"); __builtin_amdgcn_s_barrier(); asm volatile("" ::: "memory");
        }
    }
};

__device__ __forceinline__ unsigned cvt_pk_bf16(float lo, float hi) { unsigned r; asm volatile("v_cvt_pk_bf16_f32 %0, %1, %2" : "=v"(r) : "v"(lo), "v"(hi)); return r; }

template <int ACT  > struct EpiBf16 {
    static constexpr bool PERM = true, AFTER_DRAIN = false;
    bf16_t* O; int ldc;
    __device__ __forceinline__ void operator()(const f32x4 (&acc)[2][2][4][2], const Unit& u, int wr, int wc, int fr, int fq) const {
        const int lane = fq * 16 + fr, fr2 = lane >> 2, fq2 = lane & 3, srcl = ((lane & 3) * 16 + (lane >> 2)) * 4;
        const int row0 = u.pm * BM + wr * 64 + fr2; const int col0 = u.pn * BM + wc * 32 + 8 * fq2;
#pragma unroll
        for (int ai = 0; ai < 2; ++ai)
#pragma unroll
            for (int m = 0; m < 4; ++m) { bf16_t* rowp = O + (size_t)(row0 + ai * HALF + m * 16) * ldc + col0;
#pragma unroll
                for (int bj = 0; bj < 2; ++bj) { f32x4 v0 = acc[ai][bj][m][0], v1 = acc[ai][bj][m][1];
                    if (ACT == 1) {
#pragma unroll
                        for (int j = 0; j < 4; ++j) { const float a = fmaxf(v0[j], 0.f), b = fmaxf(v1[j], 0.f); v0[j] = a * a; v1[j] = b * b; } }
                    u32x4 w; w.x = cvt_pk_bf16(v0[0], v0[1]); w.y = cvt_pk_bf16(v0[2], v0[3]); w.z = cvt_pk_bf16(v1[0], v1[1]); w.w = cvt_pk_bf16(v1[2], v1[3]);
                    u32x4 t; t.x = (unsigned)__builtin_amdgcn_ds_bpermute(srcl, (int)w.x); t.y = (unsigned)__builtin_amdgcn_ds_bpermute(srcl, (int)w.y);
                    t.z = (unsigned)__builtin_amdgcn_ds_bpermute(srcl, (int)w.z); t.w = (unsigned)__builtin_amdgcn_ds_bpermute(srcl, (int)w.w);
                    *(u32x4*)(rowp + bj * HALF) = t; } }
    }
};
struct EpiNull { static constexpr bool PERM = true, AFTER_DRAIN = false;
    __device__ __forceinline__ void operator()(const f32x4 (&acc)[2][2][4][2], const Unit& u, int wr, int wc, int fr, int fq) const { _Pragma("unroll") for (int a = 0; a < 2; ++a) _Pragma("unroll") for (int b = 0; b < 2; ++b) _Pragma("unroll") for (int m = 0; m < 4; ++m) _Pragma("unroll") for (int n = 0; n < 2; ++n) asm volatile("" :: "v"(acc[a][b][m][n])); } };
__device__ __forceinline__ f32x4 lane_tr(const f32x4 v, int srcl) { f32x4 r;
    r.x = __int_as_float(__builtin_amdgcn_ds_bpermute(srcl, __float_as_int(v.x))); r.y = __int_as_float(__builtin_amdgcn_ds_bpermute(srcl, __float_as_int(v.y)));
    r.z = __int_as_float(__builtin_amdgcn_ds_bpermute(srcl, __float_as_int(v.z))); r.w = __int_as_float(__builtin_amdgcn_ds_bpermute(srcl, __float_as_int(v.w))); return r; }
struct EpiRes1 {
    static constexpr bool PERM = true, AFTER_DRAIN = false;
    const float* base_ctx; const float* base_lat; bf16_t* O; int ldo; const float* gate;
    __device__ __forceinline__ void operator()(const f32x4 (&acc)[2][2][4][2], const Unit& u, int wr, int wc, int fr, int fq) const {
        int lane_l = fq * 16 + fr; asm volatile("" : "+v"(lane_l));
        const int lane = lane_l, fr2 = lane >> 2, fq2 = lane & 3, srcl = ((lane & 3) * 16 + (lane >> 2)) * 4;
        const int mt = u.pm * BM; const bool lat = mt >= 8192; const int b = lat ? 1 + ((mt - 8192) >> 10) : 0;
        const float* bp = lat ? base_lat + (size_t)(mt - 8192) * 4096 : base_ctx + (size_t)mt * 4096;
        const int rl0 = wr * 64 + fr2, col0 = u.pn * BM + wc * 32 + 8 * fq2;
        bf16_t* op = O + (size_t)mt * ldo;
        f32x4 gv[2][2];
#pragma unroll
        for (int bj = 0; bj < 2; ++bj)
#pragma unroll
            for (int n = 0; n < 2; ++n) gv[bj][n] = *(const f32x4*)(gate + (size_t)b * 24576 + col0 + bj * HALF + n * 4);
#pragma unroll
        for (int ai = 0; ai < 2; ++ai) {
            f32x4 B0[4][2], B1[4][2];
#pragma unroll
            for (int m = 0; m < 4; ++m)
#pragma unroll
                for (int bj = 0; bj < 2; ++bj) { const size_t off = (size_t)(rl0 + ai * HALF + m * 16) * 4096 + col0 + bj * HALF;
                    B0[m][bj] = __builtin_nontemporal_load((const f32x4*)(bp + off)); B1[m][bj] = __builtin_nontemporal_load((const f32x4*)(bp + off + 4)); }
            __builtin_amdgcn_sched_barrier(0);
#pragma unroll
            for (int m = 0; m < 4; ++m) { const int row = rl0 + ai * HALF + m * 16;
#pragma unroll
                for (int bj = 0; bj < 2; ++bj) {
                    const f32x4 a0 = lane_tr(acc[ai][bj][m][0], srcl), a1 = lane_tr(acc[ai][bj][m][1], srcl);
                    const f32x4 v0 = B0[m][bj] + gv[bj][0] * a0, v1 = B1[m][bj] + gv[bj][1] * a1;
                    u32x4 w; w.x = cvt_pk_bf16(v0[0], v0[1]); w.y = cvt_pk_bf16(v0[2], v0[3]); w.z = cvt_pk_bf16(v1[0], v1[1]); w.w = cvt_pk_bf16(v1[2], v1[3]);
                    *(u32x4*)(op + (size_t)row * ldo + col0 + bj * HALF) = w; } }
            asm volatile("" ::: "memory"); }
    }
};
struct EpiRes2 {
    static constexpr bool PERM = true, AFTER_DRAIN = false;
    const bf16_t* X; int ldx; float* out; const float* gate;
    __device__ __forceinline__ void operator()(const f32x4 (&acc)[2][2][4][2], const Unit& u, int wr, int wc, int fr, int fq) const {
        int lane_l = fq * 16 + fr; asm volatile("" : "+v"(lane_l));
        const int lane = lane_l, fr2 = lane >> 2, fq2 = lane & 3, srcl = ((lane & 3) * 16 + (lane >> 2)) * 4;
        const int mt = u.pm * BM; const bool lat = mt >= 8192; const int b = lat ? 1 + ((mt - 8192) >> 10) : 0;
        const int rl0 = wr * 64 + fr2, col0 = u.pn * BM + wc * 32 + 8 * fq2;
        const bf16_t* xp = X + (size_t)mt * ldx; float* op = out + (size_t)mt * 4096;
        f32x4 gv[2][2];
#pragma unroll
        for (int bj = 0; bj < 2; ++bj)
#pragma unroll
            for (int n = 0; n < 2; ++n) gv[bj][n] = *(const f32x4*)(gate + (size_t)b * 24576 + col0 + bj * HALF + n * 4);
#pragma unroll
        for (int ai = 0; ai < 2; ++ai) {
            u32x4 XB[4][2];
#pragma unroll
            for (int m = 0; m < 4; ++m)
#pragma unroll
                for (int bj = 0; bj < 2; ++bj) XB[m][bj] = __builtin_nontemporal_load((const u32x4*)(xp + (size_t)(rl0 + ai * HALF + m * 16) * ldx + col0 + bj * HALF));
            __builtin_amdgcn_sched_barrier(0);
#pragma unroll
            for (int m = 0; m < 4; ++m) { const size_t off = (size_t)(rl0 + ai * HALF + m * 16) * 4096 + col0;
#pragma unroll
                for (int bj = 0; bj < 2; ++bj) { const u32x4 xb = XB[m][bj];
                    const f32x4 a0 = lane_tr(acc[ai][bj][m][0], srcl), a1 = lane_tr(acc[ai][bj][m][1], srcl);
                    const f32x4 b0 = {__uint_as_float(xb.x << 16), __uint_as_float(xb.x & 0xffff0000u), __uint_as_float(xb.y << 16), __uint_as_float(xb.y & 0xffff0000u)};
                    const f32x4 b1 = {__uint_as_float(xb.z << 16), __uint_as_float(xb.z & 0xffff0000u), __uint_as_float(xb.w << 16), __uint_as_float(xb.w & 0xffff0000u)};
                    __builtin_nontemporal_store(b0 + gv[bj][0] * a0, (f32x4*)(op + off + bj * HALF)); __builtin_nontemporal_store(b1 + gv[bj][1] * a1, (f32x4*)(op + off + bj * HALF + 4)); } }
            asm volatile("" ::: "memory"); }
    }
};

template <class Epi, class Sched, bool ALIGN_EPI = false, bool SP2 = false>
__device__ __forceinline__ void gemm_phase(PG8_LAS unsigned char* lds, const Gemm g, const Sched& S, const Epi& E) {
    int tid_l = threadIdx.x; asm volatile("" : "+v"(tid_l));
    const int tid = tid_l, wid = __builtin_amdgcn_readfirstlane(tid >> 6), lane = tid & 63, wr = wid >> 2, wc = wid & 3, fr = lane & 15, fq = lane >> 4;
    const int K = g.K, nt = K / BK;
    unsigned voffA[2], voffB[2];
#pragma unroll
    for (int i = 0; i < 2; ++i) { int R, C; stage_rc(tid * 16 + i * 8192, R, C); const int bb = tid * 16 + i * 8192;
        voffA[i] = (unsigned)(R * g.lda + C) * 2u; voffB[i] = (unsigned)((bb >> 11) * g.ldb + ((bb & 2047) >> 4)) * 16u; }
    const size_t kstepA = (size_t)(BK * 2), kstepB = (size_t)(BK / 8) * g.ldb * 16;
    const size_t hstepA = (size_t)HALF * g.lda * 2, hstepB = (size_t)HALF * 16;
    const size_t tstepA = 2 * hstepA, tstepB = 2 * hstepB;
    const unsigned ldsw = (unsigned)wid * 1024u;
    const int aoff = lds_byte(wr * 64 + fr, fq * 8), boff = fq * 2048 + (wc * 32 + fr) * 16;
#define PG8_SA(b, h) (((b) * 2 + (h)) * HTB)
#define PG8_SB(b, h) ((4 + (b) * 2 + (h)) * HTB)
#define PG8_STAGE(bufoff, gbase, voff) do { _Pragma("unroll") for (int _i = 0; _i < 2; ++_i) \
        __builtin_amdgcn_global_load_lds((const unsigned*)((const char*)(gbase) + (voff)[_i]), (PG8_LAS unsigned*)(lds + (bufoff) + ldsw + _i * 8192), 16, 0, 0); } while (0)
#define PG8_LDA(dst, b, h) do { _Pragma("unroll") for (int m = 0; m < 4; ++m) _Pragma("unroll") for (int k = 0; k < 2; ++k) dst[m][k] = *(const PG8_LAS bf16x8*)(lds + PG8_SA(b, h) + aoff + m * 2048 + k * 1024); } while (0)
#define PG8_LDB(dst, b, h) do { _Pragma("unroll") for (int n = 0; n < 2; ++n) _Pragma("unroll") for (int k = 0; k < 2; ++k) dst[n][k] = *(const PG8_LAS bf16x8*)(lds + PG8_SB(b, h) + boff + n * 256 + k * 8192); } while (0)
#define PG8_MMA(ai, bj, At, Bt) do { __builtin_amdgcn_s_setprio(1); _Pragma("unroll") for (int m = 0; m < 4; ++m) _Pragma("unroll") for (int n = 0; n < 2; ++n) _Pragma("unroll") for (int k = 0; k < 2; ++k) \
        acc[ai][bj][m][n] = __builtin_amdgcn_mfma_f32_16x16x32_bf16(Bt[n][k], At[m][k], acc[ai][bj][m][n], 0, 0, 0); __builtin_amdgcn_s_setprio(0); } while (0)
#define PG8_WAIT_V(n) asm volatile("s_waitcnt vmcnt(" #n ")" ::: "memory")
#define PG8_WAIT_L(n) asm volatile("s_waitcnt lgkmcnt(" #n ")" ::: "memory")
#define PG8_BAR __builtin_amdgcn_s_barrier()
#define PG8_SCHED __builtin_amdgcn_sched_barrier(0)
    static_assert(Epi::PERM, "the weight copies are stored with perm32 applied to their column order: every epilogue must use the PERM column map");
    Unit cur, nxt; int ui = 0;
    if (!S.next(0, cur)) return;
    f32x4 acc[2][2][4][2];
#pragma unroll
    for (int a = 0; a < 2; ++a)
#pragma unroll
        for (int b = 0; b < 2; ++b)
#pragma unroll
            for (int m = 0; m < 4; ++m)
#pragma unroll
                for (int n = 0; n < 2; ++n) acc[a][b][m][n] = (f32x4){0.f, 0.f, 0.f, 0.f};
    bf16x8 At[4][2], B0[2][2], B1[2][2];
    const char* cA = (const char*)g.A + (size_t)cur.pm * tstepA; const char* cB = (const char*)g.Bt + (size_t)cur.pn * tstepB;
    S.a_ready(cur);
    if constexpr (SP2) {
        PG8_STAGE(PG8_SB(0, 0), cB, voffB); PG8_STAGE(PG8_SB(0, 1), cB + hstepB, voffB); PG8_STAGE(PG8_SA(0, 0), cA, voffA); PG8_STAGE(PG8_SA(0, 1), cA + hstepA, voffA);
        if (wr == 1) PG8_BAR;
        PG8_WAIT_V(2); PG8_BAR;
        PG8_STAGE(PG8_SB(1, 0), cB + kstepB, voffB); PG8_STAGE(PG8_SA(1, 0), cA + kstepA, voffA); PG8_STAGE(PG8_SB(1, 1), cB + hstepB + kstepB, voffB);
        PG8_WAIT_V(6); PG8_BAR;
    } else {
        PG8_STAGE(PG8_SB(0, 0), cB, voffB); PG8_STAGE(PG8_SA(0, 0), cA, voffA); PG8_STAGE(PG8_SB(0, 1), cB + hstepB, voffB); PG8_STAGE(PG8_SA(0, 1), cA + hstepA, voffA);
        if (wr == 1) PG8_BAR;
        PG8_WAIT_V(4); PG8_BAR;
        PG8_STAGE(PG8_SB(1, 0), cB + kstepB, voffB); PG8_STAGE(PG8_SA(1, 0), cA + kstepA, voffA); PG8_STAGE(PG8_SB(1, 1), cB + hstepB + kstepB, voffB);
        PG8_WAIT_V(6); PG8_BAR;
    }
    for (;;) {
        const bool has_next = S.next(ui + 1, nxt);
        const char* nA = has_next ? (const char*)g.A + (size_t)nxt.pm * tstepA : cA; const char* nB = has_next ? (const char*)g.Bt + (size_t)nxt.pn * tstepB : cB;
        for (int t = 0; t < nt; t += 2) {
            const bool last = (t == nt - 2);
            const char* a1 = cA + (size_t)(t + 1) * kstepA;
            const char* a2 = last ? nA : cA + (size_t)(t + 2) * kstepA; const char* b2 = last ? nB : cB + (size_t)(t + 2) * kstepB;
            const char* a3 = a2 + kstepA; const char* b3 = b2 + kstepB;
            if (last && has_next) S.a_ready(nxt);
            if constexpr (SP2) {
            PG8_LDB(B0, 0, 0); PG8_LDB(B1, 0, 1); PG8_SCHED; PG8_LDA(At, 0, 0); PG8_STAGE(PG8_SA(1, 1), a1 + hstepA, voffA);
            PG8_WAIT_V(8); PG8_WAIT_L(0); PG8_BAR; PG8_MMA(0, 0, At, B0); PG8_MMA(0, 1, At, B1); PG8_BAR; PG8_SCHED;
            PG8_LDA(At, 0, 1); PG8_STAGE(PG8_SB(0, 0), b2, voffB); PG8_STAGE(PG8_SB(0, 1), b2 + hstepB, voffB); PG8_STAGE(PG8_SA(0, 0), a2, voffA);
            PG8_WAIT_V(8); PG8_WAIT_L(0); PG8_BAR; PG8_MMA(1, 0, At, B0); PG8_MMA(1, 1, At, B1); PG8_BAR; PG8_SCHED;
            PG8_LDB(B0, 1, 0); PG8_LDB(B1, 1, 1); PG8_SCHED; PG8_LDA(At, 1, 0); PG8_STAGE(PG8_SA(0, 1), a2 + hstepA, voffA);
            PG8_WAIT_V(8); PG8_WAIT_L(0); PG8_BAR; PG8_MMA(0, 0, At, B0); PG8_MMA(0, 1, At, B1); PG8_BAR; PG8_SCHED;
            PG8_LDA(At, 1, 1); PG8_STAGE(PG8_SB(1, 0), b3, voffB); PG8_STAGE(PG8_SB(1, 1), b3 + hstepB, voffB); PG8_STAGE(PG8_SA(1, 0), a3, voffA);
            PG8_WAIT_V(8); PG8_WAIT_L(0); PG8_BAR; PG8_MMA(1, 0, At, B0); PG8_MMA(1, 1, At, B1); PG8_BAR; PG8_SCHED;
            } else {
            PG8_LDB(B0, 0, 0); PG8_SCHED; PG8_LDA(At, 0, 0); PG8_STAGE(PG8_SA(1, 1), a1 + hstepA, voffA);
            PG8_WAIT_L(8); PG8_BAR; PG8_WAIT_L(0); PG8_MMA(0, 0, At, B0); PG8_BAR; PG8_SCHED;
            PG8_LDB(B1, 0, 1); PG8_STAGE(PG8_SB(0, 0), b2, voffB);
            PG8_BAR; PG8_WAIT_L(0); PG8_MMA(0, 1, At, B1); PG8_BAR;
            PG8_LDA(At, 0, 1); PG8_STAGE(PG8_SA(0, 0), a2, voffA);
            PG8_BAR; PG8_WAIT_L(0); PG8_MMA(1, 0, At, B0); PG8_BAR; PG8_SCHED;
            PG8_STAGE(PG8_SB(0, 1), b2 + hstepB, voffB);
            PG8_WAIT_V(6); PG8_BAR; PG8_MMA(1, 1, At, B1); PG8_BAR;
            PG8_LDB(B0, 1, 0); PG8_SCHED; PG8_LDA(At, 1, 0); PG8_STAGE(PG8_SA(0, 1), a2 + hstepA, voffA);
            PG8_WAIT_L(8); PG8_BAR; PG8_WAIT_L(0); PG8_MMA(0, 0, At, B0); PG8_BAR; PG8_SCHED;
            PG8_LDB(B1, 1, 1); PG8_STAGE(PG8_SB(1, 0), b3, voffB);
            PG8_BAR; PG8_WAIT_L(0); PG8_MMA(0, 1, At, B1); PG8_BAR;
            PG8_LDA(At, 1, 1); PG8_STAGE(PG8_SA(1, 0), a3, voffA);
            PG8_BAR; PG8_WAIT_L(0); PG8_MMA(1, 0, At, B0); PG8_BAR; PG8_SCHED;
            PG8_STAGE(PG8_SB(1, 1), b3 + hstepB, voffB);
            PG8_WAIT_V(6); PG8_BAR; PG8_MMA(1, 1, At, B1); PG8_BAR;
            }
        }
        if constexpr (ALIGN_EPI) { if (wr == 0) PG8_BAR; }
        if constexpr (!Epi::AFTER_DRAIN) { E(acc, cur, wr, wc, fr, fq); S.done(cur); }
        if (!has_next) break;
#pragma unroll
        for (int a = 0; a < 2; ++a)
#pragma unroll
            for (int b = 0; b < 2; ++b)
#pragma unroll
                for (int m = 0; m < 4; ++m)
#pragma unroll
                    for (int n = 0; n < 2; ++n) acc[a][b][m][n] = (f32x4){0.f, 0.f, 0.f, 0.f};
        cur = nxt; cA = nA; cB = nB; ++ui;
        if constexpr (ALIGN_EPI) { if (wr == 1) PG8_BAR; }
    }
    PG8_WAIT_V(0);
    if constexpr (!ALIGN_EPI) { if (wr == 0) PG8_BAR; }
    PG8_BAR;
#undef PG8_SA
#undef PG8_SB
#undef PG8_STAGE
#undef PG8_LDA
#undef PG8_LDB
#undef PG8_MMA
#undef PG8_WAIT_V
#undef PG8_WAIT_L
#undef PG8_BAR
#undef PG8_SCHED
}
}

#ifndef PG8_SP2
#define PG8_SP2 true
#endif
#ifndef PG8_ALIGN
#define PG8_ALIGN true
#endif

constexpr int NWAVES = 8;
constexpr int DM = 4096, M_CTX = 8192, M_LAT = 4096, MTOT = M_CTX + M_LAT, NPROJ = 12288, DFF = 16384, DATT = 2048, NMODW = 6 * DM;
constexpr int LAT_SEQ = 1024, CTX_SEQ = 256, PAST = 256, NHEAD = 8, KV_LAT = LAT_SEQ + PAST;
constexpr int KB_ROWS = M_CTX + 4 * KV_LAT;
constexpr int LDX = DM + 64, LDH = DFF + 64, LDP = NPROJ + 64;
constexpr int OPAD = 272;
constexpr float EPS = 1e-6f;
constexpr int N_PHASES = 9;
constexpr int N_LAUNCHES = MK_N_LAUNCHES;

constexpr size_t MiB = 1u << 20;
constexpr size_t WS_CTL = 0, CTL_ZERO_BYTES = 64 * 1024;
constexpr size_t WS_MOD = 1 * MiB;
constexpr size_t WS_WIN = 2 * MiB;
constexpr size_t WS_WOUT = 102 * MiB;
constexpr size_t WS_W1 = 138 * MiB;
constexpr size_t WS_W2 = 270 * MiB;
constexpr size_t WS_XN = 408 * MiB;
constexpr size_t WS_CV = 506 * MiB;
constexpr size_t WS_PARK = 510 * MiB;
constexpr size_t WS_R = 542 * MiB;
constexpr size_t WS_PROJ = WS_R;
constexpr size_t WS_QB = WS_R + 290 * MiB;
constexpr size_t WS_KB = WS_R + 338 * MiB;
constexpr size_t WS_MIX = WS_R + 390 * MiB;
constexpr size_t WS_H = WS_R;
constexpr size_t WS_X1B = WS_R + 488 * MiB;
constexpr size_t WS_END = WS_X1B + 98 * MiB;
static_assert((size_t)MTOT * LDX * 2 <= 98 * MiB && (size_t)(DM / 8) * (NPROJ + OPAD) * 16 <= 100 * MiB && (size_t)(DM / 8) * (DM + OPAD) * 16 <= 36 * MiB && (size_t)(DM / 8) * (DFF + OPAD) * 16 <= 132 * MiB && (size_t)(DFF / 8) * (DM + OPAD) * 16 <= 138 * MiB && (size_t)MTOT * LDP * 2 <= 290 * MiB, "ws map 1");
static_assert((size_t)KB_ROWS * DATT * 2 <= 52 * MiB && (size_t)MTOT * LDH * 2 <= 386 * MiB && WS_H + 386 * MiB <= WS_MIX, "ws map 2");
constexpr int CW_TMO = 0, CW_CODE = 1;
constexpr int CW_BAR = 4096;
constexpr int CW_XS = 8192;

constexpr int RING_OFF = 0, RING_BYTES = 131072;
constexpr int LDSCTL_OFF = RING_BYTES, MISC_OFF = LDSCTL_OFF + 320;
constexpr int LDS_BYTES = 147456;
static_assert(MISC_OFF + 128 <= LDS_BYTES, "LDS map");

#define GAS __attribute__((address_space(1)))
#define LAS __attribute__((address_space(3)))
typedef unsigned short bf16;
typedef unsigned v4u __attribute__((ext_vector_type(4)));
typedef unsigned v2u __attribute__((ext_vector_type(2)));
typedef float f32x4 __attribute__((ext_vector_type(4)));
typedef short bf16x8 __attribute__((ext_vector_type(8)));
typedef GAS unsigned gu32;
#define RLX_AGENT __ATOMIC_RELAXED, __HIP_MEMORY_SCOPE_AGENT
#define LDS_WAIT() asm volatile("s_waitcnt lgkmcnt(0)" ::: "memory")
#define VM_WAIT() asm volatile("s_waitcnt vmcnt(0)" ::: "memory")
__device__ __forceinline__ unsigned pk2(float lo, float hi) { return pg8::cvt_pk_bf16(lo, hi); }
__device__ __forceinline__ float bflo(unsigned w) { return __uint_as_float(w << 16); }
__device__ __forceinline__ float bfhi(unsigned w) { return __uint_as_float(w & 0xffff0000u); }

#define XB_TMO      128
#define XB_XCNT(j)  (256  + 64 * (j))
#define XB_XSUB(j)  (1280 + 64 * (j))
#define XB_XGEN(j)  (2304 + 64 * (j))
#define XB_TOP      3328
#define XB_TOPGEN   3392
#define XCD_BAR_WORDS 3456
#define XB_SPIN_CAP (1u << 18)

__device__ __forceinline__ unsigned xb_ld(unsigned* p)              { return __hip_atomic_load(p, __ATOMIC_RELAXED, __HIP_MEMORY_SCOPE_AGENT); }
__device__ __forceinline__ unsigned xb_add(unsigned* p, unsigned v) { return __hip_atomic_fetch_add(p, v, __ATOMIC_RELAXED, __HIP_MEMORY_SCOPE_AGENT); }
__device__ __forceinline__ unsigned xb_xcc_id() { return (unsigned)__builtin_amdgcn_s_getreg((3 << 11) | 20) & 0xFu; }
#define XB_SPIN(cond, bar) do { unsigned _sp = 0; while (cond) { __builtin_amdgcn_s_sleep(1); \
    if ((++_sp & 255u) == 0u) { if (xb_ld(&(bar)[XB_TMO])) break; if (_sp > XB_SPIN_CAP) { atomicAdd(&(bar)[XB_TMO], 1u); break; } } } } while (0)

struct XcdBarrier {
    unsigned* bar; unsigned x;
    volatile LAS unsigned* st;
};
__device__ __forceinline__ XcdBarrier xcd_barrier_post(unsigned* bar, volatile LAS unsigned* st) {
    XcdBarrier b; b.bar = bar; b.x = xb_xcc_id(); b.st = st;
    if (threadIdx.x == 0) (void)xb_add(&bar[XB_XCNT(b.x)], 1u);
    return b;
}
__device__ __forceinline__ void xcd_barrier_complete(unsigned* bar, unsigned x, unsigned& nloc, unsigned& nx) {
    const unsigned G = gridDim.x * gridDim.y * gridDim.z;
    unsigned sum, cnt, mine, sp = 0u;
    for (;;) {
        sum = 0u; cnt = 0u; mine = 0u;
#pragma unroll
        for (unsigned j = 0; j < 16; ++j) { const unsigned c = xb_ld(&bar[XB_XCNT(j)]); sum += c; cnt += (c > 0u) ? 1u : 0u; mine = (j == x) ? c : mine; }
        if (sum == G) break;
        __builtin_amdgcn_s_sleep(1);
        if ((++sp & 255u) == 0u) { if (xb_ld(&bar[XB_TMO])) break; if (sp > XB_SPIN_CAP) { atomicAdd(&bar[XB_TMO], 1u); break; } }
    }
    nloc = mine > 0u ? mine : 1u; nx = cnt > 0u ? cnt : 1u;
}
__device__ __forceinline__ void xcd_barrier(const XcdBarrier& b) {
    asm volatile("s_waitcnt vmcnt(0)" ::: "memory");
    __syncthreads();
    if (threadIdx.x == 0) {
        unsigned* bar = b.bar;
        __builtin_amdgcn_s_waitcnt(0);
        unsigned nloc = b.st[0], nx = b.st[1];
        if (nloc == 0u) { xcd_barrier_complete(bar, b.x, nloc, nx); b.st[0] = nloc; b.st[1] = nx; }
        const unsigned old = xb_add(&bar[XB_XSUB(b.x)], 1u);
        const unsigned gen = old / nloc;
        if (old + 1u == (gen + 1u) * nloc) {
            __builtin_amdgcn_fence(__ATOMIC_RELEASE, "agent");
            asm volatile("s_waitcnt vmcnt(0)" ::: "memory");
            const unsigned og = xb_add(&bar[XB_TOP], 1u);
            const unsigned tg = og / nx;
            if (og + 1u == (tg + 1u) * nx) xb_add(&bar[XB_TOPGEN], 1u);
            else XB_SPIN(xb_ld(&bar[XB_TOPGEN]) == tg, bar);
            __builtin_amdgcn_fence(__ATOMIC_ACQUIRE, "agent");
            xb_add(&bar[XB_XGEN(b.x)], 1u);
            asm volatile("s_waitcnt vmcnt(0)" ::: "memory");
        } else {
            XB_SPIN(xb_ld(&bar[XB_XGEN(b.x)]) == gen, bar);
            __builtin_amdgcn_fence(__ATOMIC_ACQUIRE, "agent");
            asm volatile("s_waitcnt vmcnt(0)" ::: "memory");
        }
    }
    __syncthreads();
}

struct Frame {
    LAS unsigned char* lds;
    volatile LAS unsigned* MISC;
    gu32* ctl;
    int tid, lane, wave;
    int vcu, G;
    const float *x_prompt, *x_sample, *cache_k, *cache_v, *c, *c_ctx, *w_ada, *b_ada, *norm_attn_g, *w_in, *q_norm_g, *k_norm_g;
    const float *lq1, *lk1, *lq2, *lk2, *subln_g, *conv_w, *w_out, *norm_mlp_g, *w_mlp_in, *w_mlp_out;
    float* out;
    float* MOD; float* PARK;
    bf16 *Win_t, *Wout_t, *W1_t, *W2_t, *XN, *CV, *PROJ, *QB, *KB, *MIX, *HB, *X1B;
};

#define RELAUNDER(F) do { int t_ = threadIdx.x; asm volatile("" : "+v"(t_)); F.tid = t_; F.lane = t_ & 63; F.wave = __builtin_amdgcn_readfirstlane(t_ >> 6); } while (0)
__device__ __forceinline__ float wave_sum(float v) {
#pragma unroll
    for (int o = 1; o < 64; o <<= 1) v += __shfl_xor(v, o);
    return v;
}

__device__ __forceinline__ void p0_transpose_item(const float* W, int K, int N, bf16* WT, LAS float* scr, int item, int lane) {
    const int nblk = N / 32, kb = item / nblk, nb = item % nblk, k0 = 64 * kb, n0 = 32 * nb;
#pragma unroll 8
    for (int i = 0; i < 32; ++i) { const int kk = 2 * i + (lane >> 5); scr[kk * 33 + (lane & 31)] = W[(size_t)(k0 + kk) * N + n0 + (lane & 31)]; }
    LDS_WAIT(); asm volatile("" ::: "memory");
    const int c = lane & 7;
#pragma unroll
    for (int j = 0; j < 4; ++j) { const int n = (lane >> 3) + 8 * j; const LAS float* s = scr + (8 * c) * 33 + n;
        v4u o; o.x = pk2(s[0 * 33], s[1 * 33]); o.y = pk2(s[2 * 33], s[3 * 33]); o.z = pk2(s[4 * 33], s[5 * 33]); o.w = pk2(s[6 * 33], s[7 * 33]);
        *(GAS v4u*)(WT + (size_t)(n0 + n) * K + k0 + 8 * c) = o; }
    LDS_WAIT(); asm volatile("" ::: "memory");
}
__device__ __forceinline__ void cvt_row2048(const float* src, bf16* dst, int lane) {
#pragma unroll
    for (int j = 0; j < 4; ++j) { const int col = 8 * (lane + 64 * j);
        const f32x4 a = *(const GAS f32x4*)(src + col), b = *(const GAS f32x4*)(src + col + 4);
        v4u o; o.x = pk2(a.x, a.y); o.y = pk2(a.z, a.w); o.z = pk2(b.x, b.y); o.w = pk2(b.z, b.w);
        *(GAS v4u*)(dst + col) = o; }
}
__device__ __forceinline__ float silu_f(float v) { return v / (1.f + __expf(-v)); }

__device__ __forceinline__ void p0_gemv(Frame& F) {
    RELAUNDER(F);
    LAS float* sl = (LAS float*)(F.lds);
    LAS float* red = (LAS float*)(F.lds + 81920);
    for (int i = F.tid; i < 5 * DM; i += NWAVES * 64) { const int b = i / DM, k = i % DM; const float v = (b == 0) ? F.c_ctx[k] : F.c[(b - 1) * DM + k]; sl[i] = silu_f(v); }
    __syncthreads();
    for (int jt = blockIdx.x; jt < NMODW / 96; jt += F.G) {
        const int jl = F.lane % 24, rg = F.lane / 24; const bool act = F.lane < 48;
        const float* wp = F.w_ada + (size_t)(2 * F.wave + (act ? rg : 0)) * NMODW + 96 * jt + 4 * jl;
        f32x4 acc[5];
#pragma unroll
        for (int b = 0; b < 5; ++b) acc[b] = (f32x4){0.f, 0.f, 0.f, 0.f};
        for (int it = 0; it < 256; it += 16) {
            f32x4 w[16];
#pragma unroll
            for (int u = 0; u < 16; ++u) w[u] = __builtin_nontemporal_load((const GAS f32x4*)(wp + (size_t)(it + u) * 16 * NMODW));
            __builtin_amdgcn_sched_barrier(0);
#pragma unroll
            for (int u = 0; u < 16; ++u) { const int k = 2 * F.wave + (act ? rg : 0) + 16 * (it + u);
#pragma unroll
                for (int b = 0; b < 5; ++b) { const float s = sl[b * DM + k]; acc[b] += w[u] * s; } }
        }
        if (act) {
#pragma unroll
            for (int b = 0; b < 5; ++b)
#pragma unroll
                for (int e = 0; e < 4; ++e) red[(F.wave * 48 + F.lane) * 20 + b * 4 + e] = acc[b][e];
        }
        __syncthreads();
        RELAUNDER(F);
        if (F.tid < 480) { const int b = F.tid / 96, jj = F.tid % 96, jl2 = jj >> 2, e = jj & 3; float s = 0.f;
#pragma unroll
            for (int w = 0; w < 8; ++w) s += red[(w * 48 + jl2) * 20 + b * 4 + e] + red[(w * 48 + 24 + jl2) * 20 + b * 4 + e];
            F.MOD[(size_t)b * NMODW + 96 * jt + jj] = s + F.b_ada[96 * jt + jj]; }
        __syncthreads();
    }
    __syncthreads();
}
template <int PART> __device__ __forceinline__ void p0_weights(Frame& F) {
    RELAUNDER(F);
    const int gw = F.vcu * NWAVES + F.wave, NGW = F.G * NWAVES;
    constexpr int I_IN = (DM / 8) * (NPROJ / 256), I_O = (DM / 8) * (DM / 256), I_1 = (DM / 8) * (DFF / 256), I_2 = (DFF / 8) * (DM / 256);
    constexpr int NITEMS = I_IN + I_O + I_1 + I_2;
#define P0_DECODE(it_, src_, N_, dst_) do { int r_ = (it_); const float* W_; bf16* T_; \
        if (r_ < I_IN) { W_ = F.w_in; T_ = F.Win_t; N_ = NPROJ; } else { r_ -= I_IN; \
        if (r_ < I_O) { W_ = F.w_out; T_ = F.Wout_t; N_ = DM; } else { r_ -= I_O; \
        if (r_ < I_1) { W_ = F.w_mlp_in; T_ = F.W1_t; N_ = DFF; } else { r_ -= I_1; W_ = F.w_mlp_out; T_ = F.W2_t; N_ = DM; } } } \
        const int nblk_ = N_ / 256, ko_ = r_ / nblk_, nb_ = r_ % nblk_; src_ = W_ + (size_t)(8 * ko_) * N_ + 256 * nb_ + 4 * F.lane; dst_ = T_ + ((size_t)ko_ * (N_ + OPAD) + 256 * nb_ + ((4 * F.lane) & ~31) + 16 * (F.lane & 1) + 4 * ((F.lane & 7) >> 1)) * 8; } while (0)
#define P0_PACK_STORE(r_, dst_) do { _Pragma("unroll") for (int e_ = 0; e_ < 4; ++e_) { v4u o_; o_.x = pk2(r_[0][e_], r_[1][e_]); o_.y = pk2(r_[2][e_], r_[3][e_]); o_.z = pk2(r_[4][e_], r_[5][e_]); o_.w = pk2(r_[6][e_], r_[7][e_]); \
        *(GAS v4u*)((dst_) + 8 * e_) = o_; } } while (0)
    constexpr int IT_LO = (PART == 1) ? I_IN : (PART == 2) ? I_IN + I_O : 0, IT_HI = (PART == 0) ? I_IN : (PART == 1) ? I_IN + I_O : NITEMS;
    for (int it = IT_LO + gw; it < IT_HI; it += 2 * NGW) {
        const float* s0; const float* s1; bf16* d0; bf16* d1; int N0, N1; const bool two = it + NGW < IT_HI;
        const int ia = (PART == 2) ? IT_LO + IT_HI - 1 - it : it, ib = two ? ((PART == 2) ? ia - NGW : it + NGW) : ia;
        P0_DECODE(ia, s0, N0, d0); P0_DECODE(ib, s1, N1, d1);
        f32x4 ra[8], rb[8];
#pragma unroll
        for (int k = 0; k < 8; ++k) ra[k] = __builtin_nontemporal_load((const GAS f32x4*)(s0 + (size_t)k * N0));
#pragma unroll
        for (int k = 0; k < 8; ++k) rb[k] = __builtin_nontemporal_load((const GAS f32x4*)(s1 + (size_t)k * N1));
        __builtin_amdgcn_sched_barrier(0);
        P0_PACK_STORE(ra, d0);
        if (two) P0_PACK_STORE(rb, d1);
    }
#undef P0_DECODE
#undef P0_PACK_STORE
    if (PART == 0)
    for (int r = gw; r < 2 * 4 * PAST; r += NGW) {
        if (r < 4 * PAST) { const int b = r / PAST, j = r % PAST; cvt_row2048(F.cache_k + (size_t)r * DATT, F.KB + (size_t)(M_CTX + b * KV_LAT + LAT_SEQ + j) * DATT, F.lane); }
        else { const int rr = r - 4 * PAST; cvt_row2048(F.cache_v + (size_t)rr * DATT, F.CV + (size_t)rr * DATT, F.lane); }
    }
}

__device__ __forceinline__ void unpack8(const v4u w, float (&f)[8]) { f[0] = bflo(w.x); f[1] = bfhi(w.x); f[2] = bflo(w.y); f[3] = bfhi(w.y); f[4] = bflo(w.z); f[5] = bfhi(w.z); f[6] = bflo(w.w); f[7] = bfhi(w.w); }
__device__ __forceinline__ v4u pack8(const float (&f)[8]) { v4u o; o.x = pk2(f[0], f[1]); o.y = pk2(f[2], f[3]); o.z = pk2(f[4], f[5]); o.w = pk2(f[6], f[7]); return o; }
template <int WHICH> __device__ __forceinline__ void norm_mod_phase(Frame& F) {
    RELAUNDER(F);
    LAS float* gs = (LAS float*)(F.lds);
    LAS float* sh = (LAS float*)(F.lds + 16384);
    const float* g = WHICH ? F.norm_mlp_g : F.norm_attn_g;
    const int NR = MTOT / 8;
    const int r_lo = (int)(((long)blockIdx.x * NR) / F.G), r_hi = (int)(((long)(blockIdx.x + 1) * NR) / F.G);
    int cur_b = -1;
    for (int r8 = r_lo; r8 < r_hi; ++r8) {
        const int m0 = r8 * 8; const int b = m0 < M_CTX ? 0 : 1 + ((m0 - M_CTX) >> 10);
        if (b != cur_b) {
            __syncthreads();
            const float* scp = F.MOD + (size_t)b * NMODW + (WHICH ? 4 : 1) * DM; const float* shp = F.MOD + (size_t)b * NMODW + (WHICH ? 3 : 0) * DM;
            for (int i = F.tid; i < DM; i += NWAVES * 64) { gs[i] = g[i] * (1.f + scp[i]); sh[i] = shp[i]; }
            __syncthreads(); cur_b = b;
        }
        const int m = m0 + F.wave;
        if (WHICH == 0) {
            const float* xrow = m < M_CTX ? F.x_prompt + (size_t)m * DM : F.x_sample + (size_t)(m - M_CTX) * DM;
            const GAS f32x4* xr = (const GAS f32x4*)xrow + F.lane;
            f32x4 v[16]; float s = 0.f;
#pragma unroll
            for (int j = 0; j < 16; ++j) { v[j] = __builtin_nontemporal_load(xr + 64 * j); }
#pragma unroll
            for (int j = 0; j < 16; ++j) { s += (v[j].x * v[j].x + v[j].y * v[j].y) + (v[j].z * v[j].z + v[j].w * v[j].w); }
            const float rstd = 1.f / sqrtf(wave_sum(s) * (1.f / DM) + EPS);
            GAS v2u* o8 = (GAS v2u*)(F.XN + (size_t)m * LDX) + F.lane;
#pragma unroll
            for (int j = 0; j < 16; ++j) { const f32x4 gg = *(const LAS f32x4*)(gs + 4 * (F.lane + 64 * j)), ss = *(const LAS f32x4*)(sh + 4 * (F.lane + 64 * j));
                const f32x4 y = v[j] * rstd * gg + ss; v2u w; w.x = pk2(y.x, y.y); w.y = pk2(y.z, y.w); o8[64 * j] = w; }
        } else {
            const GAS v4u* xr = (const GAS v4u*)(F.X1B + (size_t)m * LDX) + F.lane;
            v4u xv[8]; float s = 0.f;
#pragma unroll
            for (int j = 0; j < 8; ++j) xv[j] = __builtin_nontemporal_load(xr + 64 * j);
            float f[8][8];
#pragma unroll
            for (int j = 0; j < 8; ++j) { unpack8(xv[j], f[j]);
#pragma unroll
                for (int e = 0; e < 8; ++e) s += f[j][e] * f[j][e]; }
            const float rstd = 1.f / sqrtf(wave_sum(s) * (1.f / DM) + EPS);
            GAS v4u* o16 = (GAS v4u*)(F.XN + (size_t)m * LDX) + F.lane;
#pragma unroll
            for (int j = 0; j < 8; ++j) { const int col = 8 * (F.lane + 64 * j);
                const f32x4 g0 = *(const LAS f32x4*)(gs + col), g1 = *(const LAS f32x4*)(gs + col + 4), s0 = *(const LAS f32x4*)(sh + col), s1 = *(const LAS f32x4*)(sh + col + 4);
                float y[8];
#pragma unroll
                for (int e = 0; e < 4; ++e) { y[e] = f[j][e] * rstd * g0[e] + s0[e]; y[4 + e] = f[j][4 + e] * rstd * g1[e] + s1[e]; }
                o16[64 * j] = pack8(y); }
        }
    }
}


__device__ __forceinline__ void post_proj_phase(Frame& F) {
    RELAUNDER(F);
    float* new_k = F.out + (size_t)MTOT * DM; float* new_v = new_k + (size_t)M_CTX * DATT;
    const int l8 = F.lane & 7, ax = l8 >> 2, i0 = (l8 & 3) * 8;
    float inv[8], gq1[8], gq2[8], gk1[8], gk2[8];
#pragma unroll
    for (int j = 0; j < 8; ++j) { inv[j] = exp2f(-(float)(2 * (i0 + j)) * (13.287712379549449f / 64.f));
        gq1[j] = F.q_norm_g[ax * 64 + i0 + j]; gq2[j] = F.q_norm_g[ax * 64 + 32 + i0 + j]; gk1[j] = F.k_norm_g[ax * 64 + i0 + j]; gk2[j] = F.k_norm_g[ax * 64 + 32 + i0 + j]; }
    const int NR = MTOT / 8;
    const int r_lo = (int)(((long)blockIdx.x * NR) / F.G), r_hi = (int)(((long)(blockIdx.x + 1) * NR) / F.G);
    for (int r8 = r_lo; r8 < r_hi; ++r8) {
        const int m = r8 * 8 + F.wave; const bool lat = m >= M_CTX;
        const int t = lat ? ((m - M_CTX) & (LAT_SEQ - 1)) : (m & (CTX_SEQ - 1)); const int L = lat ? LAT_SEQ : CTX_SEQ;
        const int krow = lat ? (M_CTX + ((m - M_CTX) >> 10) * KV_LAT + t) : m;
        const bf16* prow = F.PROJ + (size_t)m * LDP;
        v4u A[2][2][2]; v2u V8[8];
#pragma unroll
        for (int part = 0; part < 2; ++part)
#pragma unroll
            for (int pass = 0; pass < 2; ++pass) { const int cb = (pass * 8 + (F.lane >> 3)) * 128 + ax * 64 + i0;
                A[part][pass][0] = __builtin_nontemporal_load((const GAS v4u*)(prow + part * DATT + cb)); A[part][pass][1] = __builtin_nontemporal_load((const GAS v4u*)(prow + part * DATT + cb + 32)); }
        if (!lat) {
#pragma unroll
            for (int j = 0; j < 8; ++j) V8[j] = *(const GAS v2u*)(prow + 2 * DATT + 4 * (F.lane + 64 * j));
        }
        __builtin_amdgcn_sched_barrier(0);
#pragma unroll
        for (int part = 0; part < 2; ++part) {
#pragma unroll
            for (int pass = 0; pass < 2; ++pass) {
                const int gidx = pass * 8 + (F.lane >> 3); const int cb = gidx * 128 + ax * 64 + i0;
                float x1[8], x2[8];
                unpack8(A[part][pass][0], x1); unpack8(A[part][pass][1], x2);
                float ss = 0.f;
#pragma unroll
                for (int j = 0; j < 8; ++j) ss += x1[j] * x1[j] + x2[j] * x2[j];
                ss += __shfl_xor(ss, 1); ss += __shfl_xor(ss, 2); ss += __shfl_xor(ss, 4);
                const float rstd = 1.f / sqrtf(ss * (1.f / 128.f) + EPS);
#pragma unroll
                for (int j = 0; j < 8; ++j) { x1[j] = x1[j] * rstd * (part ? gk1[j] : gq1[j]); x2[j] = x2[j] * rstd * (part ? gk2[j] : gq2[j]); }
                if (part == 1 && !lat) {
                    float* nk = new_k + (size_t)m * DATT + cb;
                    __builtin_nontemporal_store((f32x4){x1[0], x1[1], x1[2], x1[3]}, (GAS f32x4*)(nk)); __builtin_nontemporal_store((f32x4){x1[4], x1[5], x1[6], x1[7]}, (GAS f32x4*)(nk + 4));
                    __builtin_nontemporal_store((f32x4){x2[0], x2[1], x2[2], x2[3]}, (GAS f32x4*)(nk + 32)); __builtin_nontemporal_store((f32x4){x2[4], x2[5], x2[6], x2[7]}, (GAS f32x4*)(nk + 36));
                }
                if (lat) {
                    const float pos = (float)(ax == 0 ? (t >> 6) : (t & 63));
#pragma unroll
                    for (int j = 0; j < 8; ++j) { const float ang = pos * inv[j]; const float cs = __cosf(ang), sn = __sinf(ang);
                        const float a = x1[j], b = x2[j]; x1[j] = a * cs - b * sn; x2[j] = a * sn + b * cs; }
                }
                bf16* dst = part ? (F.KB + (size_t)krow * DATT + cb) : (F.QB + (size_t)m * DATT + cb);
                *(GAS v4u*)(dst) = pack8(x1); *(GAS v4u*)(dst + 32) = pack8(x2);
            }
        }
        if (!lat) {
#pragma unroll
            for (int j = 0; j < 8; ++j) { const int col = 4 * (F.lane + 64 * j);
                __builtin_nontemporal_store((f32x4){bflo(V8[j].x), bfhi(V8[j].x), bflo(V8[j].y), bfhi(V8[j].y)}, (GAS f32x4*)(new_v + (size_t)m * DATT + col)); }
        }
        const bool hm = t > 0, hp = t < L - 1;
        const bf16* pm_ = hm ? prow - LDP : prow; const bf16* pp_ = hp ? prow + LDP : prow;
        const float fm = hm ? 1.f : 0.f, fp = hp ? 1.f : 0.f;
#pragma unroll
        for (int pb = 0; pb < 2; ++pb) {
            v4u C[2][7]; f32x4 W[2][6];
#pragma unroll
            for (int q = 0; q < 2; ++q) { const int ch = 8 * (F.lane + 64 * (2 * pb + q));
                C[q][0] = __builtin_nontemporal_load((const GAS v4u*)(prow + 3 * DATT + ch)); C[q][1] = *(const GAS v4u*)(prow + 4 * DATT + ch); C[q][2] = *(const GAS v4u*)(prow + 5 * DATT + ch);
                C[q][3] = *(const GAS v4u*)(pm_ + 4 * DATT + ch); C[q][4] = *(const GAS v4u*)(pm_ + 5 * DATT + ch);
                C[q][5] = *(const GAS v4u*)(pp_ + 4 * DATT + ch); C[q][6] = *(const GAS v4u*)(pp_ + 5 * DATT + ch);
#pragma unroll
                for (int k = 0; k < 3; ++k) { W[q][2 * k] = *(const GAS f32x4*)(F.conv_w + k * DATT + ch); W[q][2 * k + 1] = *(const GAS f32x4*)(F.conv_w + k * DATT + ch + 4); } }
            __builtin_amdgcn_sched_barrier(0);
#pragma unroll
            for (int q = 0; q < 2; ++q) { const int ch = 8 * (F.lane + 64 * (2 * pb + q));
                float bg[8], c0[8], u0[8], cm[8], um[8], cp[8], up[8];
                unpack8(C[q][0], bg); unpack8(C[q][1], c0); unpack8(C[q][2], u0); unpack8(C[q][3], cm); unpack8(C[q][4], um); unpack8(C[q][5], cp); unpack8(C[q][6], up);
                float y[8];
#pragma unroll
                for (int j = 0; j < 8; ++j) { const float w0 = W[q][j >> 2][j & 3], w1 = W[q][2 + (j >> 2)][j & 3], w2 = W[q][4 + (j >> 2)][j & 3];
                    y[j] = bg[j] * (w0 * (cm[j] * um[j]) * fm + w1 * (c0[j] * u0[j]) + w2 * (cp[j] * up[j]) * fp); }
                *(GAS v4u*)(F.MIX + (size_t)m * LDX + DATT + ch) = pack8(y); }
        }
    }
}

namespace att {
using s16x4  = __attribute__((ext_vector_type(4))) short;
using f32x16 = __attribute__((ext_vector_type(16))) float;
constexpr int KVBLK = 64;
constexpr float SCALE = 0.088388347648318440f;
constexpr float THR = 8.f;
constexpr int SHM_K = KVBLK * 128 * 2, SHM_V = KVBLK * 256 * 2;
constexpr int OFF_V = 0, OFF_K = 2 * SHM_V, OFF_WS = OFF_K + 2 * SHM_K, OFF_SSQ = OFF_WS + NWAVES * 256, ATT_LDS = OFF_SSQ + 128 * 2 * 4;
static_assert(ATT_LDS <= RING_BYTES, "attention LDS");
#define KSWZ(row, colB) ((row) * 256 + ((colB) ^ (((row) & 7) << 4)))
#define SBAR() __builtin_amdgcn_sched_barrier(0)
__device__ __forceinline__ int crow(int r, int hi) { return (r & 3) + 8 * (r >> 2) + 4 * hi; }
__device__ __forceinline__ unsigned cvtpk(float lo, float hi) { unsigned r; asm volatile("v_cvt_pk_bf16_f32 %0, %1, %2" : "=v"(r) : "v"(lo), "v"(hi)); return r; }

__device__ __forceinline__ void partialSM(f32x16& p0, f32x16& p1, float& m_reg, float& mn, float& alpha) {
  constexpr float C = SCALE * 1.4426950408889634f;
  float pmax = p0[0];
#pragma unroll
  for (int r = 1; r < 16; ++r) pmax = fmaxf(pmax, p0[r]);
#pragma unroll
  for (int r = 0; r < 16; ++r) pmax = fmaxf(pmax, p1[r]);
  { auto rr = __builtin_amdgcn_permlane32_swap(__float_as_uint(pmax), __float_as_uint(pmax), false, false);
    pmax = fmaxf(__uint_as_float(rr[0]), __uint_as_float(rr[1])); }
  if (__builtin_expect(__all(pmax - m_reg <= THR / SCALE), 1)) { mn = m_reg; alpha = 1.f; }
  else { mn = fmaxf(m_reg, pmax); alpha = __builtin_amdgcn_exp2f((m_reg - mn) * C); m_reg = mn; }
  float mnC = -mn * C;
#pragma unroll
  for (int r = 0; r < 16; ++r) p0[r] = fmaf(p0[r], C, mnC);
#pragma unroll
  for (int r = 0; r < 16; ++r) p1[r] = fmaf(p1[r], C, mnC);
#pragma unroll
  for (int r = 0; r < 16; ++r) p0[r] = __builtin_amdgcn_exp2f(p0[r]);
}
__device__ __forceinline__ void finishSM(f32x16& p0, f32x16& p1, float alpha, float& l_reg, bf16x8& pa0, bf16x8& pa1, bf16x8& pa2, bf16x8& pa3) {
#pragma unroll
  for (int r = 0; r < 16; ++r) p1[r] = __builtin_amdgcn_exp2f(p1[r]);
  float ps = 0;
#pragma unroll
  for (int r = 0; r < 16; ++r) ps += p0[r];
#pragma unroll
  for (int r = 0; r < 16; ++r) ps += p1[r];
  { auto rr = __builtin_amdgcn_permlane32_swap(__float_as_uint(ps), __float_as_uint(ps), false, false);
    ps = __uint_as_float(rr[0]) + __uint_as_float(rr[1]); }
  l_reg = l_reg * alpha + ps;
#define PK4(P, BASE, OUT) do { unsigned a0 = cvtpk(P[BASE + 0], P[BASE + 1]), a1 = cvtpk(P[BASE + 2], P[BASE + 3]);   \
    unsigned b0 = cvtpk(P[BASE + 4], P[BASE + 5]), b1 = cvtpk(P[BASE + 6], P[BASE + 7]);                              \
    auto r0 = __builtin_amdgcn_permlane32_swap(a0, b0, false, false); auto r1 = __builtin_amdgcn_permlane32_swap(a1, b1, false, false); \
    v4u w = {r0[0], r1[0], r0[1], r1[1]}; OUT = *reinterpret_cast<bf16x8*>(&w); } while (0)
  PK4(p0, 0, pa0); PK4(p0, 8, pa1); PK4(p1, 0, pa2); PK4(p1, 8, pa3);
#undef PK4
}
__device__ __forceinline__ void qkt(f32x16& p0, f32x16& p1, const LAS char* Ks, const bf16x8* qr, int r32, int hi) {
  p0 = f32x16{}; p1 = f32x16{};
#pragma unroll
  for (int d0 = 0; d0 < 8; ++d0) { int cb = (d0 * 16 + hi * 8) * 2;
    bf16x8 b0 = *reinterpret_cast<const LAS bf16x8*>(Ks + KSWZ(r32, cb));
    bf16x8 b1 = *reinterpret_cast<const LAS bf16x8*>(Ks + KSWZ(32 + r32, cb));
    p0 = __builtin_amdgcn_mfma_f32_32x32x16_bf16(b0, qr[d0], p0, 0, 0, 0);
    p1 = __builtin_amdgcn_mfma_f32_32x32x16_bf16(b1, qr[d0], p1, 0, 0, 0); }
}
__device__ __forceinline__ int v_st(int k, int c) { const int kk = (k & ~0xC) | ((k & 4) << 1) | ((k & 8) >> 1); return ((kk >> 3) * 4 + (c >> 5)) * 512 + ((kk & 7) * 32 + (c & 31)) * 2; }
__device__ __forceinline__ int v_rd_base(int lane) { return ((lane & 3) << 3) | (((lane >> 2) & 3) << 6) | (((lane >> 4) & 1) << 5) | (((lane >> 5) & 1) << 8); }
constexpr int v_rd_off(int d0, int ks, int half) { return d0 * 512 + ks * 4096 + half * 2048; }
template <int OFF> __device__ __forceinline__ s16x4 tr_read(int vb) {
  s16x4 r; asm volatile("ds_read_b64_tr_b16 %0, %1 offset:%2" : "=&v"(r) : "v"(vb), "i"(OFF) : "memory"); return r;
}
template <int D0> __device__ __forceinline__ void pv_one(f32x16& od, int vb, bf16x8 pa0, bf16x8 pa1, bf16x8 pa2, bf16x8 pa3) {
  const s16x4 l0 = tr_read<v_rd_off(D0, 0, 0)>(vb), h0 = tr_read<v_rd_off(D0, 0, 1)>(vb), l1 = tr_read<v_rd_off(D0, 1, 0)>(vb), h1 = tr_read<v_rd_off(D0, 1, 1)>(vb);
  const s16x4 l2 = tr_read<v_rd_off(D0, 2, 0)>(vb), h2 = tr_read<v_rd_off(D0, 2, 1)>(vb), l3 = tr_read<v_rd_off(D0, 3, 0)>(vb), h3 = tr_read<v_rd_off(D0, 3, 1)>(vb);
  asm volatile("s_waitcnt lgkmcnt(0)" ::: "memory"); SBAR();
#define PK(L, H) (bf16x8){L[0], L[1], L[2], L[3], H[0], H[1], H[2], H[3]}
  od = __builtin_amdgcn_mfma_f32_32x32x16_bf16(pa0, PK(l0, h0), od, 0, 0, 0);
  od = __builtin_amdgcn_mfma_f32_32x32x16_bf16(pa1, PK(l1, h1), od, 0, 0, 0);
  od = __builtin_amdgcn_mfma_f32_32x32x16_bf16(pa2, PK(l2, h2), od, 0, 0, 0);
  od = __builtin_amdgcn_mfma_f32_32x32x16_bf16(pa3, PK(l3, h3), od, 0, 0, 0);
#undef PK
}
__device__ __forceinline__ void pv_d0(f32x16* o, int vb, bf16x8 pa0, bf16x8 pa1, bf16x8 pa2, bf16x8 pa3) {
  pv_one<0>(o[0], vb, pa0, pa1, pa2, pa3); pv_one<1>(o[1], vb, pa0, pa1, pa2, pa3); pv_one<2>(o[2], vb, pa0, pa1, pa2, pa3); pv_one<3>(o[3], vb, pa0, pa1, pa2, pa3);
}

__device__ __forceinline__ void attn_unit(const bf16* Qp, const bf16* Kp, const bf16* V0p, int nself, const bf16* V1p, int nkeys, bf16* Op,
                                          float* park, const float* subln_g, float lam, float oscale, LAS char* lds) {
  int tid_l = threadIdx.x; asm volatile("" : "+v"(tid_l));
  const int tid = tid_l, wid = __builtin_amdgcn_readfirstlane(tid >> 6), lane = tid & 63, r32 = lane & 31, hi = lane >> 5, rg = wid >> 1, e = wid & 1;
  LAS char* V_lds = lds + OFF_V; LAS char* K_lds = lds + OFF_K;
  LAS float* wsf = (LAS float*)(lds + OFF_WS) + wid * 64; LAS float* li_l = wsf; LAS float* al_l = wsf + 32;
  LAS float* ssq = (LAS float*)(lds + OFF_SSQ);
  const int sr = tid >> 4, sc = (tid & 15) * 8, vst0 = v_st(sr, sc), vst1 = v_st(32 + sr, sc);
  const int vb0 = (int)(unsigned)(uintptr_t)(V_lds + e * (SHM_V / 2)) + v_rd_base(lane);
  const int NT = nkeys / KVBLK;
  const unsigned voS = (unsigned)(sr * LDP + sc), voC = (unsigned)(sr * DATT + sc);
  f32x16 o[4];
  float rli[16];
  for (int c = 0; c < 2; ++c) {
    float m_reg = -1e30f, l_reg = 0;
#pragma unroll
    for (int d = 0; d < 4; ++d) o[d] = f32x16{};
    bf16x8 qr[8];
    { const bf16* Qw = Qp + (size_t)(rg * 32 + r32) * DATT + c * 128 + hi * 8;
#pragma unroll
      for (int d0 = 0; d0 < 8; ++d0) qr[d0] = *(const GAS bf16x8*)(Qw + d0 * 16); }
    const bf16* Kh = Kp + c * 128;
    bf16x8 vs0, vs1, vs2, vs3, ks0, ks1;
#define SLOAD(k0) do { const int kk_ = (k0); const bool self_ = kk_ < nself; \
    const bf16* vu_ = self_ ? V0p + (size_t)kk_ * LDP : V1p + (size_t)(kk_ - nself) * DATT; const unsigned vo_ = self_ ? voS : voC, vst_ = self_ ? 32u * LDP : 32u * DATT; \
    vs0 = *(const GAS bf16x8*)(vu_ + vo_); vs1 = *(const GAS bf16x8*)(vu_ + (vo_ + 128u)); vs2 = *(const GAS bf16x8*)(vu_ + (vo_ + vst_)); vs3 = *(const GAS bf16x8*)(vu_ + (vo_ + vst_ + 128u)); \
    const bf16* ku_ = Kh + (size_t)kk_ * DATT; ks0 = *(const GAS bf16x8*)(ku_ + voC); ks1 = *(const GAS bf16x8*)(ku_ + (voC + 32u * DATT)); } while (0)
#define SWRITE(b) do { LAS char* vb_ = V_lds + (b) * SHM_V; LAS char* kb_ = K_lds + (b) * SHM_K; const int kc = sc * 2; \
    *(LAS bf16x8*)(vb_ + vst0) = vs0; *(LAS bf16x8*)(vb_ + SHM_V / 2 + vst0) = vs1; *(LAS bf16x8*)(vb_ + vst1) = vs2; *(LAS bf16x8*)(vb_ + SHM_V / 2 + vst1) = vs3; \
    *(LAS bf16x8*)(kb_ + KSWZ(sr, kc)) = ks0; *(LAS bf16x8*)(kb_ + KSWZ(32 + sr, kc)) = ks1; } while (0)
#define SWAIT() asm volatile("s_waitcnt vmcnt(0)" ::: "memory")
#define RESC(a) do { if (__any((a) < 1.f)) { if (hi == 0) al_l[r32] = (a); asm volatile("s_waitcnt lgkmcnt(0)" ::: "memory"); \
    _Pragma("unroll") for (int d = 0; d < 4; ++d) _Pragma("unroll") for (int r = 0; r < 16; ++r) o[d][r] *= al_l[crow(r, hi)]; } } while (0)
    f32x16 p0, p1; float mn, al; bf16x8 pa0, pa1, pa2, pa3;
    __syncthreads();
    SLOAD(0); SWAIT(); SWRITE(0); __syncthreads();
    for (int j = 0; j < NT; ++j) {
      const int buf = j & 1; const bool more = j + 1 < NT;
      if (more) SLOAD((j + 1) * KVBLK);
      SBAR(); qkt(p0, p1, K_lds + buf * SHM_K, qr, r32, hi);
      partialSM(p0, p1, m_reg, mn, al);
      RESC(al);
      finishSM(p0, p1, al, l_reg, pa0, pa1, pa2, pa3); SBAR();
      pv_d0(o, vb0 + buf * SHM_V, pa0, pa1, pa2, pa3);
      if (more) { SWAIT(); SWRITE(buf ^ 1); }
      __syncthreads();
    }
#undef SLOAD
#undef SWRITE
#undef SWAIT
#undef RESC
    int hi_ = hi, r32_ = r32, wid_ = wid; asm volatile("" : "+v"(hi_), "+v"(r32_), "+s"(wid_));
    LAS float* li2 = (LAS float*)(lds + OFF_WS) + wid_ * 64;
    if (hi_ == 0) li2[r32_] = l_reg; asm volatile("s_waitcnt lgkmcnt(0)" ::: "memory");
#pragma unroll
    for (int r = 0; r < 16; ++r) rli[r] = __builtin_amdgcn_rcpf(li2[crow(r, hi_)]);
    if (c == 0) {
      float* pk = park + (size_t)wid_ * 4096 + (hi_ * 32 + r32_);
#pragma unroll
      for (int d = 0; d < 4; ++d)
#pragma unroll
        for (int r = 0; r < 16; ++r) pk[(d * 16 + r) * 64] = o[d][r] * rli[r];
    }
  }
  int hi_ = hi, r32_ = r32, wid_ = wid; asm volatile("" : "+v"(hi_), "+v"(r32_), "+s"(wid_));
  const int rg_ = wid_ >> 1, e_ = wid_ & 1;
  const float* pk = park + (size_t)wid_ * 4096 + (hi_ * 32 + r32_);
  asm volatile("s_waitcnt vmcnt(0)" ::: "memory");
  float q[16];
#pragma unroll
  for (int r = 0; r < 16; ++r) q[r] = 0.f;
#pragma unroll
  for (int d = 0; d < 4; ++d) {
#pragma unroll
    for (int r = 0; r < 16; ++r) { const float v = pk[(d * 16 + r) * 64] - lam * (o[d][r] * rli[r]); o[d][r] = v; q[r] += v * v; }
    asm volatile("" ::: "memory"); }
#pragma unroll
  for (int r = 0; r < 16; ++r) { float s = q[r]; s += __shfl_xor(s, 1); s += __shfl_xor(s, 2); s += __shfl_xor(s, 4); s += __shfl_xor(s, 8); s += __shfl_xor(s, 16); q[r] = s; }
  if (r32_ == 0) {
#pragma unroll
    for (int r = 0; r < 16; ++r) ssq[(rg_ * 32 + crow(r, hi_)) * 2 + e_] = q[r];
  }
  __syncthreads();
  float g4[4];
#pragma unroll
  for (int d = 0; d < 4; ++d) g4[d] = subln_g[e_ * 128 + d * 32 + r32_] * oscale;
  bf16* ob = Op + (size_t)(rg_ * 32 + 4 * hi_) * LDX + e_ * 128 + r32_;
  const LAS float* sq = ssq + (rg_ * 32 + 4 * hi_) * 2;
#pragma unroll
  for (int r = 0; r < 16; ++r) { const int rr = (r & 3) + 8 * (r >> 2); const float tot = sq[rr * 2] + sq[rr * 2 + 1]; const float rstd = __builtin_amdgcn_rsqf(tot * (1.f / 256.f) + EPS);
    bf16* orow = ob + (size_t)rr * LDX;
#pragma unroll
    for (int d = 0; d < 4; ++d) { const unsigned w = cvtpk(o[d][r] * rstd * g4[d], 0.f); orow[d * 32] = (bf16)(w & 0xffffu); } }
}
#undef KSWZ
#undef SBAR
}

__device__ __forceinline__ void attention_phase(Frame& F) {
    RELAUNDER(F);
    const float d1 = wave_sum(F.lq1[F.lane] * F.lk1[F.lane] + F.lq1[F.lane + 64] * F.lk1[F.lane + 64]);
    const float d2 = wave_sum(F.lq2[F.lane] * F.lk2[F.lane] + F.lq2[F.lane + 64] * F.lk2[F.lane + 64]);
    const float lam_init = 0.2f; const float lam = __expf(d1) - __expf(d2) + lam_init; const float oscale = 1.f - lam_init;
    float* park = F.PARK + (size_t)blockIdx.x * (NWAVES * 4096);
    LAS char* lds = (LAS char*)(F.lds + RING_OFF);
    for (int idx = F.vcu; idx < 768; idx += F.G) {
        const bool lat = idx < 256; const int u = lat ? idx : idx - 256;
        const int b = lat ? (u >> 6) : (u >> 4), h = lat ? ((u >> 3) & 7) : ((u >> 1) & 7), qb = lat ? (u & 7) : (u & 1);
        const int m0 = lat ? M_CTX + b * LAT_SEQ : b * CTX_SEQ; const int k0row = lat ? M_CTX + b * KV_LAT : m0;
        att::attn_unit(F.QB + (size_t)(m0 + qb * 128) * DATT + h * 256, F.KB + (size_t)k0row * DATT + h * 256,
                       F.PROJ + (size_t)m0 * LDP + 2 * DATT + h * 256, lat ? LAT_SEQ : CTX_SEQ, F.CV + (size_t)(b & 3) * PAST * DATT + h * 256, lat ? KV_LAT : CTX_SEQ,
                       F.MIX + (size_t)(m0 + qb * 128) * LDX + h * 256, park, F.subln_g, lam, oscale, lds);
    }
}

struct Args { const float* in[22]; float* out; unsigned char* ws; int ph_lo, ph_hi; };
__global__ void __launch_bounds__(NWAVES * 64, 2) mk_fwd(Args args) {
    extern __shared__ __attribute__((aligned(16))) unsigned char lds[];
    Frame F;
    F.lds = (LAS unsigned char*)lds;
    F.MISC = (volatile LAS unsigned*)(F.lds + MISC_OFF);
    F.tid = threadIdx.x; F.lane = F.tid & 63; F.wave = __builtin_amdgcn_readfirstlane(F.tid >> 6);
    F.G = gridDim.x; { const int bx = blockIdx.x; F.vcu = (F.G % 8 == 0) ? (bx % 8) * (F.G / 8) + bx / 8 : bx; }
    unsigned char* ws = args.ws;
    F.ctl = (gu32*)(ws + WS_CTL);
    F.x_prompt = args.in[0]; F.x_sample = args.in[1]; F.cache_k = args.in[2]; F.cache_v = args.in[3]; F.c = args.in[4]; F.c_ctx = args.in[5];
    F.w_ada = args.in[6]; F.b_ada = args.in[7]; F.norm_attn_g = args.in[8]; F.w_in = args.in[9]; F.q_norm_g = args.in[10]; F.k_norm_g = args.in[11];
    F.lq1 = args.in[12]; F.lk1 = args.in[13]; F.lq2 = args.in[14]; F.lk2 = args.in[15]; F.subln_g = args.in[16]; F.conv_w = args.in[17];
    F.w_out = args.in[18]; F.norm_mlp_g = args.in[19]; F.w_mlp_in = args.in[20]; F.w_mlp_out = args.in[21];
    F.out = args.out;
    F.MOD = (float*)(ws + WS_MOD); F.PARK = (float*)(ws + WS_PARK);
    F.Win_t = (bf16*)(ws + WS_WIN); F.Wout_t = (bf16*)(ws + WS_WOUT); F.W1_t = (bf16*)(ws + WS_W1); F.W2_t = (bf16*)(ws + WS_W2);
    F.XN = (bf16*)(ws + WS_XN); F.CV = (bf16*)(ws + WS_CV); F.PROJ = (bf16*)(ws + WS_PROJ); F.QB = (bf16*)(ws + WS_QB); F.KB = (bf16*)(ws + WS_KB);
    F.MIX = (bf16*)(ws + WS_MIX); F.HB = (bf16*)(ws + WS_H); F.X1B = (bf16*)(ws + WS_X1B);
    for (int u = F.tid; u < (LDS_BYTES - LDSCTL_OFF) / 4; u += NWAVES * 64) ((LAS unsigned*)(F.lds + LDSCTL_OFF))[u] = 0u;
    __syncthreads();
    XcdBarrier bar; bar.bar = (unsigned*)(F.ctl + CW_BAR); bar.x = 0; bar.st = nullptr;
    if (N_LAUNCHES == 1) bar = xcd_barrier_post((unsigned*)(F.ctl + CW_BAR), F.MISC + 8);
#define GRID_BAR(seam) do { if (N_LAUNCHES == 1) { xcd_barrier(bar); } } while (0)
    const int lo = args.ph_lo, hi = args.ph_hi;
#ifndef PH_MASK
#define PH_MASK 0x1ff
#endif
#define IN(k) (((PH_MASK >> (k)) & 1) && lo <= (k) && (k) < hi)
#define BOTH(k) (IN(k) && IN((k) + 1))
#define XS_SETUP(S_, gi_) do { (S_).ctr = (unsigned*)(F.ctl + CW_XS) + 64 * (16 * (gi_) + (int)bar.x); (S_).k = 0u; (S_).nloc = (N_LAUNCHES == 1 && lo == 0 && (S_).nwg % F.G == 0) ? F.MISC[8] : 0u; } while (0)
#ifndef PROBE_DUP
#define PROBE_DUP 0
#ifndef PROBE_GROUPED
#define PROBE_GROUPED 1
#endif
#endif
#define DUP(k) ((PROBE_DUP >> (k)) & 1)

    if (IN(0)) { p0_gemv(F); if (DUP(10)) { __syncthreads(); p0_gemv(F); } if (BOTH(0)) GRID_BAR(0); }
    if (IN(1)) { p0_weights<0>(F); norm_mod_phase<0>(F); if (DUP(1)) { __syncthreads(); norm_mod_phase<0>(F); } if (BOTH(1)) GRID_BAR(1); }
    if (IN(2)) {
        pg8::Gemm g{F.XN, F.Win_t, MTOT, NPROJ, DM, LDX, NPROJ + OPAD}; pg8::XcdSyncOrder S; S.init(MTOT, NPROJ, F.G, (int)blockIdx.x); S.grouped = (F.G == 256 && PROBE_GROUPED) ? 1 : 0; XS_SETUP(S, 0);
        pg8::EpiBf16<0> E{F.PROJ, LDP};
        pg8::gemm_phase<pg8::EpiBf16<0>, pg8::XcdSyncOrder, PG8_ALIGN, PG8_SP2>(F.lds + RING_OFF, g, S, E);
        if (DUP(2)) { __syncthreads(); pg8::gemm_phase<pg8::EpiBf16<0>, pg8::XcdSyncOrder, PG8_ALIGN, PG8_SP2>(F.lds + RING_OFF, g, S, E); }
        if (DUP(9)) { __syncthreads(); pg8::EpiNull EN; pg8::gemm_phase<pg8::EpiNull, pg8::XcdSyncOrder, PG8_ALIGN, PG8_SP2>(F.lds + RING_OFF, g, S, EN); }
        if (BOTH(2)) GRID_BAR(2);
    }
    if (IN(3)) { post_proj_phase(F); if (DUP(3)) { __syncthreads(); post_proj_phase(F); } if (BOTH(3)) GRID_BAR(3); }
    if (IN(4)) { attention_phase(F); p0_weights<1>(F); if (DUP(4)) { __syncthreads(); attention_phase(F); } if (BOTH(4)) GRID_BAR(4); }
    if (IN(5)) {
        pg8::Gemm g{F.MIX, F.Wout_t, MTOT, DM, DM, LDX, DM + OPAD}; pg8::XcdSyncOrder S; S.init(MTOT, DM, F.G, (int)blockIdx.x); S.grouped = (F.G == 256 && PROBE_GROUPED) ? 1 : 0; XS_SETUP(S, 1);
        pg8::EpiRes1 E{F.x_prompt, F.x_sample, F.X1B, LDX, F.MOD + 2 * DM};
        pg8::gemm_phase<pg8::EpiRes1, pg8::XcdSyncOrder, PG8_ALIGN, PG8_SP2>(F.lds + RING_OFF, g, S, E);
        if (DUP(5)) { __syncthreads(); pg8::gemm_phase<pg8::EpiRes1, pg8::XcdSyncOrder, PG8_ALIGN, PG8_SP2>(F.lds + RING_OFF, g, S, E); }
        if (BOTH(5)) GRID_BAR(5);
    }
    if (IN(6)) { p0_weights<2>(F); norm_mod_phase<1>(F); if (DUP(6)) { __syncthreads(); norm_mod_phase<1>(F); } if (BOTH(6)) GRID_BAR(6); }
    if (IN(7)) {
#if defined(PROBE_IDLE_US)
        { const unsigned long long t0 = __builtin_amdgcn_s_memrealtime(); while (__builtin_amdgcn_s_memrealtime() - t0 < 100ull * PROBE_IDLE_US) __builtin_amdgcn_s_sleep(32); }
#endif
        pg8::Gemm g{F.XN, F.W1_t, MTOT, DFF, DM, LDX, DFF + OPAD}; pg8::XcdSyncOrder S; S.init(MTOT, DFF, F.G, (int)blockIdx.x); S.grouped = (F.G == 256 && PROBE_GROUPED) ? 2 : 0; XS_SETUP(S, 2);
        pg8::EpiBf16<1> E{F.HB, LDH};
        pg8::gemm_phase<pg8::EpiBf16<1>, pg8::XcdSyncOrder, PG8_ALIGN, PG8_SP2>(F.lds + RING_OFF, g, S, E);
        if (DUP(7)) { __syncthreads(); pg8::gemm_phase<pg8::EpiBf16<1>, pg8::XcdSyncOrder, PG8_ALIGN, PG8_SP2>(F.lds + RING_OFF, g, S, E); }
        if (BOTH(7)) GRID_BAR(7);
    }
    if (IN(8)) {
        pg8::Gemm g{F.HB, F.W2_t, MTOT, DM, DFF, LDH, DM + OPAD}; pg8::XcdSyncOrder S; S.init(MTOT, DM, F.G, (int)blockIdx.x); S.grouped = (F.G == 256 && PROBE_GROUPED) ? 1 : 0; XS_SETUP(S, 3);
        pg8::EpiRes2 E{F.X1B, LDX, F.out, F.MOD + 5 * DM};
        pg8::gemm_phase<pg8::EpiRes2, pg8::XcdSyncOrder, PG8_ALIGN, PG8_SP2>(F.lds + RING_OFF, g, S, E);
        if (DUP(8)) { __syncthreads(); pg8::gemm_phase<pg8::EpiRes2, pg8::XcdSyncOrder, PG8_ALIGN, PG8_SP2>(F.lds + RING_OFF, g, S, E); }
    }
#undef IN
#undef BOTH
}

extern "C" void kernel_launch(void* const* d_in, const int* in_sizes, int n_in, void* d_out, int out_size, void* d_ws, size_t ws_size, hipStream_t stream) {
    static int grid = 0;
    if (grid == 0) {
        if (n_in != 22 || ws_size < WS_END) { fprintf(stderr, "kernel_launch: expected 22 inputs and >= %zu bytes of workspace; got n_in %d, ws %zu; nothing launched\n", (size_t)WS_END, n_in, ws_size); grid = -1; return; }
        int dev = 0, cus = 0, per_cu = 0;
        if (hipGetDevice(&dev) != hipSuccess || hipDeviceGetAttribute(&cus, hipDeviceAttributeMultiprocessorCount, dev) != hipSuccess) { grid = -1; return; }
        if (hipFuncSetAttribute((const void*)mk_fwd, hipFuncAttributeMaxDynamicSharedMemorySize, LDS_BYTES) != hipSuccess) { fprintf(stderr, "kernel_launch: hipFuncSetAttribute failed\n"); grid = -1; return; }
        if (hipOccupancyMaxActiveBlocksPerMultiprocessor(&per_cu, (const void*)mk_fwd, NWAVES * 64, LDS_BYTES) != hipSuccess || per_cu < 1)
            fprintf(stderr, "kernel_launch: note: occupancy query reports %d workgroups per CU\n", per_cu);
        (void)hipGetLastError();
        grid = cus;
    }
    if (grid < 0) return;
    if (hipMemsetAsync((char*)d_ws + WS_CTL, 0, CTL_ZERO_BYTES, stream) != hipSuccess) { fprintf(stderr, "kernel_launch: memset failed\n"); return; }
    Args a{};
    for (int i = 0; i < 22; ++i) a.in[i] = (const float*)d_in[i];
    a.out = (float*)d_out; a.ws = (unsigned char*)d_ws;
    for (int li = 0; li < N_LAUNCHES; ++li) {
        a.ph_lo = (N_LAUNCHES == 1) ? 0 : li; a.ph_hi = (N_LAUNCHES == 1) ? N_PHASES : li + 1;
        hipLaunchKernelGGL(mk_fwd, dim3(grid), dim3(NWAVES * 64), LDS_BYTES, stream, a);
        const hipError_t le = hipPeekAtLastError();
        if (le != hipSuccess) { fprintf(stderr, "kernel_launch: launch %d failed: %s\n", li, hipGetErrorName(le)); break; }
    }
}
```

```cpp
#include <hip/hip_runtime.h>
#include <cstdio>
#include <cstdint>

#ifndef MK_N_LAUNCHES
#define MK_N_LAUNCHES 1
#endif

namespace pg8 {
#define PG8_LAS __attribute__((address_space(3)))
typedef unsigned short bf16_t;
typedef short bf16x8 __attribute__((ext_vector_type(8)));
typedef float f32x4 __attribute__((ext_vector_type(4)));
typedef unsigned u32x4 __attribute__((ext_vector_type(4)));
constexpr int BM = 256, BK = 64, HALF = 128, HTB = HALF * BK * 2  , STAGE_BYTES = 8 * HTB, NXCD = 8, WGM = 8;

__host__ __device__ __forceinline__ int lds_byte(int r, int c) { const int st = (r >> 4) * 2 + (c >> 5), rr = r & 15, cc = c & 31, ob = rr * 64 + cc * 2; return st * 1024 + (ob ^ (((ob >> 9) & 1) << 5)); }
__host__ __device__ __forceinline__ void stage_rc(int b, int& R, int& C) { const int st = b / 1024, sb = b % 1024, swz = sb ^ (((sb >> 9) & 1) << 5); R = (st >> 1) * 16 + swz / 64; C = (st & 1) * 32 + (swz % 64) / 2; }
__host__ __device__ __forceinline__ int perm32(int rho) { const int n = rho >> 4, i = rho & 15; return 8 * (i >> 2) + 4 * n + (i & 3); }

struct Unit { int pm, pn; };
struct Gemm { const bf16_t* A; const bf16_t* Bt; int M, N, K, lda, ldb; };

struct StaticOrder {
    int nM, nN, nwg, G, c;
    __host__ __device__ void init(int M, int N, int G_, int c_) { nM = M / BM; nN = N / BM; nwg = nM * nN; G = G_; c = c_; }
    int grouped = 0;
    __host__ __device__ bool next(int i, Unit& u) const {
        if (grouped == 2) {
            const int x = c & 7, cu = c >> 3, nG = nM >> 3, strip = i / nG, grp = i % nG; if (strip >= (nN >> 5)) return false;
            u.pm = 8 * grp + (cu & 7); u.pn = 4 * (strip * 8 + x) + (cu >> 3); return true; }
        if (grouped) { const int x = c & 7, cu = c >> 3, bpg = nN >> 2, B = i * 8 + x; if (B >= (nM >> 3) * bpg) return false;
            u.pm = 8 * (B / bpg) + (cu & 7); u.pn = 4 * (B % bpg) + (cu >> 3); return true; }
        const long L = (long)i * G + c; if (L >= nwg) return false;
        int wgid = (int)L; { const int q = nwg / NXCD, r = nwg % NXCD, xcd = wgid % NXCD, off = wgid / NXCD; wgid = (xcd < r ? xcd * (q + 1) : r * (q + 1) + (xcd - r) * q) + off; }
        const int nig = WGM * nN, gid = wgid / nig, fm = gid * WGM, gsz = (nM - fm) < WGM ? (nM - fm) : WGM;
        u.pm = fm + ((wgid % nig) % gsz); u.pn = (wgid % nig) / gsz; return true;
    }
    __device__ __forceinline__ void a_ready(const Unit&) const {}
    __device__ __forceinline__ void done(const Unit&) const {}
};
struct XcdSyncOrder : StaticOrder {
    unsigned* ctr; unsigned nloc; mutable unsigned k;
    __device__ __forceinline__ void a_ready(const Unit&) const {
        if (nloc) {
            if (threadIdx.x == 0) { __hip_atomic_fetch_add(ctr, 1u, __ATOMIC_RELAXED, __HIP_MEMORY_SCOPE_AGENT); const unsigned want = nloc * (k + 1u); unsigned sp = 0;
                while (__hip_atomic_load(ctr, __ATOMIC_RELAXED, __HIP_MEMORY_SCOPE_AGENT) < want && ++sp < 4000u) __builtin_amdgcn_s_sleep(1); }
            ++k;
            asm volatile("" ::: "memory"); __builtin_amdgcn_s_barrier(); asm volatile("" ::: "memory");
        }
    }
};

__device__ __forceinline__ unsigned cvt_pk_bf16(float lo, float hi) { unsigned r; asm volatile("v_cvt_pk_bf16_f32 %0, %1, %2" : "=v"(r) : "v"(lo), "v"(hi)); return r; }

template <int ACT  > struct EpiBf16 {
    static constexpr bool PERM = true, AFTER_DRAIN = false;
    bf16_t* O; int ldc;
    __device__ __forceinline__ void operator()(const f32x4 (&acc)[2][2][4][2], const Unit& u, int wr, int wc, int fr, int fq) const {
        const int lane = fq * 16 + fr, fr2 = lane >> 2, fq2 = lane & 3, srcl = ((lane & 3) * 16 + (lane >> 2)) * 4;
        const int row0 = u.pm * BM + wr * 64 + fr2; const int col0 = u.pn * BM + wc * 32 + 8 * fq2;
#pragma unroll
        for (int ai = 0; ai < 2; ++ai)
#pragma unroll
            for (int m = 0; m < 4; ++m) { bf16_t* rowp = O + (size_t)(row0 + ai * HALF + m * 16) * ldc + col0;
#pragma unroll
                for (int bj = 0; bj < 2; ++bj) { f32x4 v0 = acc[ai][bj][m][0], v1 = acc[ai][bj][m][1];
                    if (ACT == 1) {
#pragma unroll
                        for (int j = 0; j < 4; ++j) { const float a = fmaxf(v0[j], 0.f), b = fmaxf(v1[j], 0.f); v0[j] = a * a; v1[j] = b * b; } }
                    u32x4 w; w.x = cvt_pk_bf16(v0[0], v0[1]); w.y = cvt_pk_bf16(v0[2], v0[3]); w.z = cvt_pk_bf16(v1[0], v1[1]); w.w = cvt_pk_bf16(v1[2], v1[3]);
                    u32x4 t; t.x = (unsigned)__builtin_amdgcn_ds_bpermute(srcl, (int)w.x); t.y = (unsigned)__builtin_amdgcn_ds_bpermute(srcl, (int)w.y);
                    t.z = (unsigned)__builtin_amdgcn_ds_bpermute(srcl, (int)w.z); t.w = (unsigned)__builtin_amdgcn_ds_bpermute(srcl, (int)w.w);
                    *(u32x4*)(rowp + bj * HALF) = t; } }
    }
};
struct EpiNull { static constexpr bool PERM = true, AFTER_DRAIN = false;
    __device__ __forceinline__ void operator()(const f32x4 (&acc)[2][2][4][2], const Unit& u, int wr, int wc, int fr, int fq) const { _Pragma("unroll") for (int a = 0; a < 2; ++a) _Pragma("unroll") for (int b = 0; b < 2; ++b) _Pragma("unroll") for (int m = 0; m < 4; ++m) _Pragma("unroll") for (int n = 0; n < 2; ++n) asm volatile("" :: "v"(acc[a][b][m][n])); } };
__device__ __forceinline__ f32x4 lane_tr(const f32x4 v, int srcl) { f32x4 r;
    r.x = __int_as_float(__builtin_amdgcn_ds_bpermute(srcl, __float_as_int(v.x))); r.y = __int_as_float(__builtin_amdgcn_ds_bpermute(srcl, __float_as_int(v.y)));
    r.z = __int_as_float(__builtin_amdgcn_ds_bpermute(srcl, __float_as_int(v.z))); r.w = __int_as_float(__builtin_amdgcn_ds_bpermute(srcl, __float_as_int(v.w))); return r; }
struct EpiRes1 {
    static constexpr bool PERM = true, AFTER_DRAIN = false;
    const float* base_ctx; const float* base_lat; bf16_t* O; int ldo; const float* gate;
    __device__ __forceinline__ void operator()(const f32x4 (&acc)[2][2][4][2], const Unit& u, int wr, int wc, int fr, int fq) const {
        const int lane = fq * 16 + fr, fr2 = lane >> 2, fq2 = lane & 3, srcl = ((lane & 3) * 16 + (lane >> 2)) * 4;
        const int mt = u.pm * BM; const bool lat = mt >= 8192; const int b = lat ? 1 + ((mt - 8192) >> 10) : 0;
        const float* bp = lat ? base_lat + (size_t)(mt - 8192) * 4096 : base_ctx + (size_t)mt * 4096;
        const int rl0 = wr * 64 + fr2, col0 = u.pn * BM + wc * 32 + 8 * fq2;
        bf16_t* op = O + (size_t)mt * ldo;
        f32x4 gv[2][2];
#pragma unroll
        for (int bj = 0; bj < 2; ++bj)
#pragma unroll
            for (int n = 0; n < 2; ++n) gv[bj][n] = *(const f32x4*)(gate + (size_t)b * 24576 + col0 + bj * HALF + n * 4);
#pragma unroll
        for (int ai = 0; ai < 2; ++ai)
#pragma unroll
            for (int m = 0; m < 4; ++m) { const int row = rl0 + ai * HALF + m * 16; const size_t off = (size_t)row * 4096 + col0;
#pragma unroll
                for (int bj = 0; bj < 2; ++bj) { const f32x4 b0 = __builtin_nontemporal_load((const f32x4*)(bp + off + bj * HALF)), b1 = __builtin_nontemporal_load((const f32x4*)(bp + off + bj * HALF + 4));
                    const f32x4 a0 = lane_tr(acc[ai][bj][m][0], srcl), a1 = lane_tr(acc[ai][bj][m][1], srcl);
                    const f32x4 v0 = b0 + gv[bj][0] * a0, v1 = b1 + gv[bj][1] * a1;
                    u32x4 w; w.x = cvt_pk_bf16(v0[0], v0[1]); w.y = cvt_pk_bf16(v0[2], v0[3]); w.z = cvt_pk_bf16(v1[0], v1[1]); w.w = cvt_pk_bf16(v1[2], v1[3]);
                    *(u32x4*)(op + (size_t)row * ldo + col0 + bj * HALF) = w; }
                asm volatile("" ::: "memory"); }
    }
};
struct EpiRes2 {
    static constexpr bool PERM = true, AFTER_DRAIN = false;
    const bf16_t* X; int ldx; float* out; const float* gate;
    __device__ __forceinline__ void operator()(const f32x4 (&acc)[2][2][4][2], const Unit& u, int wr, int wc, int fr, int fq) const {
        const int lane = fq * 16 + fr, fr2 = lane >> 2, fq2 = lane & 3, srcl = ((lane & 3) * 16 + (lane >> 2)) * 4;
        const int mt = u.pm * BM; const bool lat = mt >= 8192; const int b = lat ? 1 + ((mt - 8192) >> 10) : 0;
        const int rl0 = wr * 64 + fr2, col0 = u.pn * BM + wc * 32 + 8 * fq2;
        const bf16_t* xp = X + (size_t)mt * ldx; float* op = out + (size_t)mt * 4096;
        f32x4 gv[2][2];
#pragma unroll
        for (int bj = 0; bj < 2; ++bj)
#pragma unroll
            for (int n = 0; n < 2; ++n) gv[bj][n] = *(const f32x4*)(gate + (size_t)b * 24576 + col0 + bj * HALF + n * 4);
#pragma unroll
        for (int ai = 0; ai < 2; ++ai)
#pragma unroll
            for (int m = 0; m < 4; ++m) { const int row = rl0 + ai * HALF + m * 16; const size_t off = (size_t)row * 4096 + col0;
#pragma unroll
                for (int bj = 0; bj < 2; ++bj) { const u32x4 xb = __builtin_nontemporal_load((const u32x4*)(xp + (size_t)row * ldx + col0 + bj * HALF));
                    const f32x4 a0 = lane_tr(acc[ai][bj][m][0], srcl), a1 = lane_tr(acc[ai][bj][m][1], srcl);
                    const f32x4 b0 = {__uint_as_float(xb.x << 16), __uint_as_float(xb.x & 0xffff0000u), __uint_as_float(xb.y << 16), __uint_as_float(xb.y & 0xffff0000u)};
                    const f32x4 b1 = {__uint_as_float(xb.z << 16), __uint_as_float(xb.z & 0xffff0000u), __uint_as_float(xb.w << 16), __uint_as_float(xb.w & 0xffff0000u)};
                    __builtin_nontemporal_store(b0 + gv[bj][0] * a0, (f32x4*)(op + off + bj * HALF)); __builtin_nontemporal_store(b1 + gv[bj][1] * a1, (f32x4*)(op + off + bj * HALF + 4)); }
                asm volatile("" ::: "memory"); }
    }
};

template <class Epi, class Sched, bool ALIGN_EPI = false, bool SP2 = false>
__device__ __forceinline__ void gemm_phase(PG8_LAS unsigned char* lds, const Gemm g, const Sched& S, const Epi& E) {
    int tid_l = threadIdx.x; asm volatile("" : "+v"(tid_l));
    const int tid = tid_l, wid = __builtin_amdgcn_readfirstlane(tid >> 6), lane = tid & 63, wr = wid >> 2, wc = wid & 3, fr = lane & 15, fq = lane >> 4;
    const int K = g.K, nt = K / BK;
    unsigned voffA[2], voffB[2];
#pragma unroll
    for (int i = 0; i < 2; ++i) { int R, C; stage_rc(tid * 16 + i * 8192, R, C); const int bb = tid * 16 + i * 8192;
        voffA[i] = (unsigned)(R * g.lda + C) * 2u; voffB[i] = (unsigned)((bb >> 11) * g.ldb + ((bb & 2047) >> 4)) * 16u; }
    const size_t kstepA = (size_t)(BK * 2), kstepB = (size_t)(BK / 8) * g.ldb * 16;
    const size_t hstepA = (size_t)HALF * g.lda * 2, hstepB = (size_t)HALF * 16;
    const size_t tstepA = 2 * hstepA, tstepB = 2 * hstepB;
    const unsigned ldsw = (unsigned)wid * 1024u;
    const int aoff = lds_byte(wr * 64 + fr, fq * 8), boff = fq * 2048 + (wc * 32 + fr) * 16;
#define PG8_SA(b, h) (((b) * 2 + (h)) * HTB)
#define PG8_SB(b, h) ((4 + (b) * 2 + (h)) * HTB)
#define PG8_STAGE(bufoff, gbase, voff) do { _Pragma("unroll") for (int _i = 0; _i < 2; ++_i) \
        __builtin_amdgcn_global_load_lds((const unsigned*)((const char*)(gbase) + (voff)[_i]), (PG8_LAS unsigned*)(lds + (bufoff) + ldsw + _i * 8192), 16, 0, 0); } while (0)
#define PG8_LDA(dst, b, h) do { _Pragma("unroll") for (int m = 0; m < 4; ++m) _Pragma("unroll") for (int k = 0; k < 2; ++k) dst[m][k] = *(const PG8_LAS bf16x8*)(lds + PG8_SA(b, h) + aoff + m * 2048 + k * 1024); } while (0)
#define PG8_LDB(dst, b, h) do { _Pragma("unroll") for (int n = 0; n < 2; ++n) _Pragma("unroll") for (int k = 0; k < 2; ++k) dst[n][k] = *(const PG8_LAS bf16x8*)(lds + PG8_SB(b, h) + boff + n * 256 + k * 8192); } while (0)
#define PG8_MMA(ai, bj, At, Bt) do { __builtin_amdgcn_s_setprio(1); _Pragma("unroll") for (int m = 0; m < 4; ++m) _Pragma("unroll") for (int n = 0; n < 2; ++n) _Pragma("unroll") for (int k = 0; k < 2; ++k) \
        acc[ai][bj][m][n] = __builtin_amdgcn_mfma_f32_16x16x32_bf16(Bt[n][k], At[m][k], acc[ai][bj][m][n], 0, 0, 0); __builtin_amdgcn_s_setprio(0); } while (0)
#define PG8_WAIT_V(n) asm volatile("s_waitcnt vmcnt(" #n ")" ::: "memory")
#define PG8_WAIT_L(n) asm volatile("s_waitcnt lgkmcnt(" #n ")" ::: "memory")
#define PG8_BAR __builtin_amdgcn_s_barrier()
#define PG8_SCHED __builtin_amdgcn_sched_barrier(0)
    static_assert(Epi::PERM, "the weight copies are stored with perm32 applied to their column order: every epilogue must use the PERM column map");
    Unit cur, nxt; int ui = 0;
    if (!S.next(0, cur)) return;
    f32x4 acc[2][2][4][2];
#pragma unroll
    for (int a = 0; a < 2; ++a)
#pragma unroll
        for (int b = 0; b < 2; ++b)
#pragma unroll
            for (int m = 0; m < 4; ++m)
#pragma unroll
                for (int n = 0; n < 2; ++n) acc[a][b][m][n] = (f32x4){0.f, 0.f, 0.f, 0.f};
    bf16x8 At[4][2], B0[2][2], B1[2][2];
    const char* cA = (const char*)g.A + (size_t)cur.pm * tstepA; const char* cB = (const char*)g.Bt + (size_t)cur.pn * tstepB;
    S.a_ready(cur);
    if constexpr (SP2) {
        PG8_STAGE(PG8_SB(0, 0), cB, voffB); PG8_STAGE(PG8_SB(0, 1), cB + hstepB, voffB); PG8_STAGE(PG8_SA(0, 0), cA, voffA); PG8_STAGE(PG8_SA(0, 1), cA + hstepA, voffA);
        if (wr == 1) PG8_BAR;
        PG8_WAIT_V(2); PG8_BAR;
        PG8_STAGE(PG8_SB(1, 0), cB + kstepB, voffB); PG8_STAGE(PG8_SA(1, 0), cA + kstepA, voffA); PG8_STAGE(PG8_SB(1, 1), cB + hstepB + kstepB, voffB);
        PG8_WAIT_V(6); PG8_BAR;
    } else {
        PG8_STAGE(PG8_SB(0, 0), cB, voffB); PG8_STAGE(PG8_SA(0, 0), cA, voffA); PG8_STAGE(PG8_SB(0, 1), cB + hstepB, voffB); PG8_STAGE(PG8_SA(0, 1), cA + hstepA, voffA);
        if (wr == 1) PG8_BAR;
        PG8_WAIT_V(4); PG8_BAR;
        PG8_STAGE(PG8_SB(1, 0), cB + kstepB, voffB); PG8_STAGE(PG8_SA(1, 0), cA + kstepA, voffA); PG8_STAGE(PG8_SB(1, 1), cB + hstepB + kstepB, voffB);
        PG8_WAIT_V(6); PG8_BAR;
    }
    for (;;) {
        const bool has_next = S.next(ui + 1, nxt);
        const char* nA = has_next ? (const char*)g.A + (size_t)nxt.pm * tstepA : cA; const char* nB = has_next ? (const char*)g.Bt + (size_t)nxt.pn * tstepB : cB;
        for (int t = 0; t < nt; t += 2) {
            const bool last = (t == nt - 2);
            const char* a1 = cA + (size_t)(t + 1) * kstepA;
            const char* a2 = last ? nA : cA + (size_t)(t + 2) * kstepA; const char* b2 = last ? nB : cB + (size_t)(t + 2) * kstepB;
            const char* a3 = a2 + kstepA; const char* b3 = b2 + kstepB;
            if (last && has_next) S.a_ready(nxt);
            if constexpr (SP2) {
            PG8_LDB(B0, 0, 0); PG8_LDB(B1, 0, 1); PG8_SCHED; PG8_LDA(At, 0, 0); PG8_STAGE(PG8_SA(1, 1), a1 + hstepA, voffA);
            PG8_WAIT_V(8); PG8_WAIT_L(0); PG8_BAR; PG8_MMA(0, 0, At, B0); PG8_MMA(0, 1, At, B1); PG8_BAR; PG8_SCHED;
            PG8_LDA(At, 0, 1); PG8_STAGE(PG8_SB(0, 0), b2, voffB); PG8_STAGE(PG8_SB(0, 1), b2 + hstepB, voffB); PG8_STAGE(PG8_SA(0, 0), a2, voffA);
            PG8_WAIT_V(8); PG8_WAIT_L(0); PG8_BAR; PG8_MMA(1, 0, At, B0); PG8_MMA(1, 1, At, B1); PG8_BAR; PG8_SCHED;
            PG8_LDB(B0, 1, 0); PG8_LDB(B1, 1, 1); PG8_SCHED; PG8_LDA(At, 1, 0); PG8_STAGE(PG8_SA(0, 1), a2 + hstepA, voffA);
            PG8_WAIT_V(8); PG8_WAIT_L(0); PG8_BAR; PG8_MMA(0, 0, At, B0); PG8_MMA(0, 1, At, B1); PG8_BAR; PG8_SCHED;
            PG8_LDA(At, 1, 1); PG8_STAGE(PG8_SB(1, 0), b3, voffB); PG8_STAGE(PG8_SB(1, 1), b3 + hstepB, voffB); PG8_STAGE(PG8_SA(1, 0), a3, voffA);
            PG8_WAIT_V(8); PG8_WAIT_L(0); PG8_BAR; PG8_MMA(1, 0, At, B0); PG8_MMA(1, 1, At, B1); PG8_BAR; PG8_SCHED;
            } else {
            PG8_LDB(B0, 0, 0); PG8_SCHED; PG8_LDA(At, 0, 0); PG8_STAGE(PG8_SA(1, 1), a1 + hstepA, voffA);
            PG8_WAIT_L(8); PG8_BAR; PG8_WAIT_L(0); PG8_MMA(0, 0, At, B0); PG8_BAR; PG8_SCHED;
            PG8_LDB(B1, 0, 1); PG8_STAGE(PG8_SB(0, 0), b2, voffB);
            PG8_BAR; PG8_WAIT_L(0); PG8_MMA(0, 1, At, B1); PG8_BAR;
            PG8_LDA(At, 0, 1); PG8_STAGE(PG8_SA(0, 0), a2, voffA);
            PG8_BAR; PG8_WAIT_L(0); PG8_MMA(1, 0, At, B0); PG8_BAR; PG8_SCHED;
            PG8_STAGE(PG8_SB(0, 1), b2 + hstepB, voffB);
            PG8_WAIT_V(6); PG8_BAR; PG8_MMA(1, 1, At, B1); PG8_BAR;
            PG8_LDB(B0, 1, 0); PG8_SCHED; PG8_LDA(At, 1, 0); PG8_STAGE(PG8_SA(0, 1), a2 + hstepA, voffA);
            PG8_WAIT_L(8); PG8_BAR; PG8_WAIT_L(0); PG8_MMA(0, 0, At, B0); PG8_BAR; PG8_SCHED;
            PG8_LDB(B1, 1, 1); PG8_STAGE(PG8_SB(1, 0), b3, voffB);
            PG8_BAR; PG8_WAIT_L(0); PG8_MMA(0, 1, At, B1); PG8_BAR;
            PG8_LDA(At, 1, 1); PG8_STAGE(PG8_SA(1, 0), a3, voffA);
            PG8_BAR; PG8_WAIT_L(0); PG8_MMA(1, 0, At, B0); PG8_BAR; PG8_SCHED;
            PG8_STAGE(PG8_SB(1, 1), b3 + hstepB, voffB);
            PG8_WAIT_V(6); PG8_BAR; PG8_MMA(1, 1, At, B1); PG8_BAR;
            }
        }
        if constexpr (ALIGN_EPI) { if (wr == 0) PG8_BAR; }
        if constexpr (!Epi::AFTER_DRAIN) { E(acc, cur, wr, wc, fr, fq); S.done(cur); }
        if (!has_next) break;
#pragma unroll
        for (int a = 0; a < 2; ++a)
#pragma unroll
            for (int b = 0; b < 2; ++b)
#pragma unroll
                for (int m = 0; m < 4; ++m)
#pragma unroll
                    for (int n = 0; n < 2; ++n) acc[a][b][m][n] = (f32x4){0.f, 0.f, 0.f, 0.f};
        cur = nxt; cA = nA; cB = nB; ++ui;
        if constexpr (ALIGN_EPI) { if (wr == 1) PG8_BAR; }
    }
    PG8_WAIT_V(0);
    if constexpr (!ALIGN_EPI) { if (wr == 0) PG8_BAR; }
    PG8_BAR;
#undef PG8_SA
#undef PG8_SB
#undef PG8_STAGE
#undef PG8_LDA
#undef PG8_LDB
#undef PG8_MMA
#undef PG8_WAIT_V
#undef PG8_WAIT_L
#undef PG8_BAR
#undef PG8_SCHED
}
}

#ifndef PG8_SP2
#define PG8_SP2 true
#endif
#ifndef PG8_ALIGN
#define PG8_ALIGN true
#endif

constexpr int NWAVES = 8;
constexpr int DM = 4096, M_CTX = 8192, M_LAT = 4096, MTOT = M_CTX + M_LAT, NPROJ = 12288, DFF = 16384, DATT = 2048, NMODW = 6 * DM;
constexpr int LAT_SEQ = 1024, CTX_SEQ = 256, PAST = 256, NHEAD = 8, KV_LAT = LAT_SEQ + PAST;
constexpr int KB_ROWS = M_CTX + 4 * KV_LAT;
constexpr int LDX = DM + 64, LDH = DFF + 64, LDP = NPROJ + 64;
constexpr int OPAD = 272;
constexpr float EPS = 1e-6f;
constexpr int N_PHASES = 9;
constexpr int N_LAUNCHES = MK_N_LAUNCHES;

constexpr size_t MiB = 1u << 20;
constexpr size_t WS_CTL = 0, CTL_ZERO_BYTES = 64 * 1024;
constexpr size_t WS_MOD = 1 * MiB;
constexpr size_t WS_WIN = 2 * MiB;
constexpr size_t WS_WOUT = 102 * MiB;
constexpr size_t WS_W1 = 138 * MiB;
constexpr size_t WS_W2 = 270 * MiB;
constexpr size_t WS_XN = 408 * MiB;
constexpr size_t WS_CV = 506 * MiB;
constexpr size_t WS_PARK = 510 * MiB;
constexpr size_t WS_R = 542 * MiB;
constexpr size_t WS_PROJ = WS_R;
constexpr size_t WS_QB = WS_R + 290 * MiB;
constexpr size_t WS_KB = WS_R + 338 * MiB;
constexpr size_t WS_MIX = WS_R + 390 * MiB;
constexpr size_t WS_H = WS_R;
constexpr size_t WS_X1B = WS_R + 488 * MiB;
constexpr size_t WS_END = WS_X1B + 98 * MiB;
static_assert((size_t)MTOT * LDX * 2 <= 98 * MiB && (size_t)(DM / 8) * (NPROJ + OPAD) * 16 <= 100 * MiB && (size_t)(DM / 8) * (DM + OPAD) * 16 <= 36 * MiB && (size_t)(DM / 8) * (DFF + OPAD) * 16 <= 132 * MiB && (size_t)(DFF / 8) * (DM + OPAD) * 16 <= 138 * MiB && (size_t)MTOT * LDP * 2 <= 290 * MiB, "ws map 1");
static_assert((size_t)KB_ROWS * DATT * 2 <= 52 * MiB && (size_t)MTOT * LDH * 2 <= 386 * MiB && WS_H + 386 * MiB <= WS_MIX, "ws map 2");
constexpr int CW_TMO = 0, CW_CODE = 1;
constexpr int CW_BAR = 4096;
constexpr int CW_XS = 8192;

constexpr int RING_OFF = 0, RING_BYTES = 131072;
constexpr int LDSCTL_OFF = RING_BYTES, MISC_OFF = LDSCTL_OFF + 320;
constexpr int LDS_BYTES = 147456;
static_assert(MISC_OFF + 128 <= LDS_BYTES, "LDS map");

#define GAS __attribute__((address_space(1)))
#define LAS __attribute__((address_space(3)))
typedef unsigned short bf16;
typedef unsigned v4u __attribute__((ext_vector_type(4)));
typedef unsigned v2u __attribute__((ext_vector_type(2)));
typedef float f32x4 __attribute__((ext_vector_type(4)));
typedef short bf16x8 __attribute__((ext_vector_type(8)));
typedef GAS unsigned gu32;
#define RLX_AGENT __ATOMIC_RELAXED, __HIP_MEMORY_SCOPE_AGENT
#define LDS_WAIT() asm volatile("s_waitcnt lgkmcnt(0)" ::: "memory")
#define VM_WAIT() asm volatile("s_waitcnt vmcnt(0)" ::: "memory")
__device__ __forceinline__ unsigned pk2(float lo, float hi) { return pg8::cvt_pk_bf16(lo, hi); }
__device__ __forceinline__ float bflo(unsigned w) { return __uint_as_float(w << 16); }
__device__ __forceinline__ float bfhi(unsigned w) { return __uint_as_float(w & 0xffff0000u); }

#define XB_TMO      128
#define XB_XCNT(j)  (256  + 64 * (j))
#define XB_XSUB(j)  (1280 + 64 * (j))
#define XB_XGEN(j)  (2304 + 64 * (j))
#define XB_TOP      3328
#define XB_TOPGEN   3392
#define XCD_BAR_WORDS 3456
#define XB_SPIN_CAP (1u << 18)

__device__ __forceinline__ unsigned xb_ld(unsigned* p)              { return __hip_atomic_load(p, __ATOMIC_RELAXED, __HIP_MEMORY_SCOPE_AGENT); }
__device__ __forceinline__ unsigned xb_add(unsigned* p, unsigned v) { return __hip_atomic_fetch_add(p, v, __ATOMIC_RELAXED, __HIP_MEMORY_SCOPE_AGENT); }
__device__ __forceinline__ unsigned xb_xcc_id() { return (unsigned)__builtin_amdgcn_s_getreg((3 << 11) | 20) & 0xFu; }
#define XB_SPIN(cond, bar) do { unsigned _sp = 0; while (cond) { __builtin_amdgcn_s_sleep(1); \
    if ((++_sp & 255u) == 0u) { if (xb_ld(&(bar)[XB_TMO])) break; if (_sp > XB_SPIN_CAP) { atomicAdd(&(bar)[XB_TMO], 1u); break; } } } } while (0)

struct XcdBarrier {
    unsigned* bar; unsigned x;
    volatile LAS unsigned* st;
};
__device__ __forceinline__ XcdBarrier xcd_barrier_post(unsigned* bar, volatile LAS unsigned* st) {
    XcdBarrier b; b.bar = bar; b.x = xb_xcc_id(); b.st = st;
    if (threadIdx.x == 0) (void)xb_add(&bar[XB_XCNT(b.x)], 1u);
    return b;
}
__device__ __forceinline__ void xcd_barrier_complete(unsigned* bar, unsigned x, unsigned& nloc, unsigned& nx) {
    const unsigned G = gridDim.x * gridDim.y * gridDim.z;
    unsigned sum, cnt, mine, sp = 0u;
    for (;;) {
        sum = 0u; cnt = 0u; mine = 0u;
#pragma unroll
        for (unsigned j = 0; j < 16; ++j) { const unsigned c = xb_ld(&bar[XB_XCNT(j)]); sum += c; cnt += (c > 0u) ? 1u : 0u; mine = (j == x) ? c : mine; }
        if (sum == G) break;
        __builtin_amdgcn_s_sleep(1);
        if ((++sp & 255u) == 0u) { if (xb_ld(&bar[XB_TMO])) break; if (sp > XB_SPIN_CAP) { atomicAdd(&bar[XB_TMO], 1u); break; } }
    }
    nloc = mine > 0u ? mine : 1u; nx = cnt > 0u ? cnt : 1u;
}
__device__ __forceinline__ void xcd_barrier(const XcdBarrier& b) {
    asm volatile("s_waitcnt vmcnt(0)" ::: "memory");
    __syncthreads();
    if (threadIdx.x == 0) {
        unsigned* bar = b.bar;
        __builtin_amdgcn_s_waitcnt(0);
        unsigned nloc = b.st[0], nx = b.st[1];
        if (nloc == 0u) { xcd_barrier_complete(bar, b.x, nloc, nx); b.st[0] = nloc; b.st[1] = nx; }
        const unsigned old = xb_add(&bar[XB_XSUB(b.x)], 1u);
        const unsigned gen = old / nloc;
        if (old + 1u == (gen + 1u) * nloc) {
            __builtin_amdgcn_fence(__ATOMIC_RELEASE, "agent");
            asm volatile("s_waitcnt vmcnt(0)" ::: "memory");
            const unsigned og = xb_add(&bar[XB_TOP], 1u);
            const unsigned tg = og / nx;
            if (og + 1u == (tg + 1u) * nx) xb_add(&bar[XB_TOPGEN], 1u);
            else XB_SPIN(xb_ld(&bar[XB_TOPGEN]) == tg, bar);
            __builtin_amdgcn_fence(__ATOMIC_ACQUIRE, "agent");
            xb_add(&bar[XB_XGEN(b.x)], 1u);
            asm volatile("s_waitcnt vmcnt(0)" ::: "memory");
        } else {
            XB_SPIN(xb_ld(&bar[XB_XGEN(b.x)]) == gen, bar);
            __builtin_amdgcn_fence(__ATOMIC_ACQUIRE, "agent");
            asm volatile("s_waitcnt vmcnt(0)" ::: "memory");
        }
    }
    __syncthreads();
}

struct Frame {
    LAS unsigned char* lds;
    volatile LAS unsigned* MISC;
    gu32* ctl;
    int tid, lane, wave;
    int vcu, G;
    const float *x_prompt, *x_sample, *cache_k, *cache_v, *c, *c_ctx, *w_ada, *b_ada, *norm_attn_g, *w_in, *q_norm_g, *k_norm_g;
    const float *lq1, *lk1, *lq2, *lk2, *subln_g, *conv_w, *w_out, *norm_mlp_g, *w_mlp_in, *w_mlp_out;
    float* out;
    float* MOD; float* PARK;
    bf16 *Win_t, *Wout_t, *W1_t, *W2_t, *XN, *CV, *PROJ, *QB, *KB, *MIX, *HB, *X1B;
};

#define RELAUNDER(F) do { int t_ = threadIdx.x; asm volatile("" : "+v"(t_)); F.tid = t_; F.lane = t_ & 63; F.wave = __builtin_amdgcn_readfirstlane(t_ >> 6); } while (0)
__device__ __forceinline__ float wave_sum(float v) {
#pragma unroll
    for (int o = 1; o < 64; o <<= 1) v += __shfl_xor(v, o);
    return v;
}

#ifndef SIDE_W2
#define SIDE_W2 1
#endif
__device__ __forceinline__ void p0_transpose_item(const float* W, int K, int N, bf16* WT, LAS float* scr, int item, int lane) {
    const int nblk = N / 32, kb = item / nblk, nb = item % nblk, k0 = 64 * kb, n0 = 32 * nb;
#pragma unroll 8
    for (int i = 0; i < 32; ++i) { const int kk = 2 * i + (lane >> 5); scr[kk * 33 + (lane & 31)] = W[(size_t)(k0 + kk) * N + n0 + (lane & 31)]; }
    LDS_WAIT(); asm volatile("" ::: "memory");
    const int c = lane & 7;
#pragma unroll
    for (int j = 0; j < 4; ++j) { const int n = (lane >> 3) + 8 * j; const LAS float* s = scr + (8 * c) * 33 + n;
        v4u o; o.x = pk2(s[0 * 33], s[1 * 33]); o.y = pk2(s[2 * 33], s[3 * 33]); o.z = pk2(s[4 * 33], s[5 * 33]); o.w = pk2(s[6 * 33], s[7 * 33]);
        *(GAS v4u*)(WT + (size_t)(n0 + n) * K + k0 + 8 * c) = o; }
    LDS_WAIT(); asm volatile("" ::: "memory");
}
__device__ __forceinline__ void cvt_row2048(const float* src, bf16* dst, int lane) {
#pragma unroll
    for (int j = 0; j < 4; ++j) { const int col = 8 * (lane + 64 * j);
        const f32x4 a = *(const GAS f32x4*)(src + col), b = *(const GAS f32x4*)(src + col + 4);
        v4u o; o.x = pk2(a.x, a.y); o.y = pk2(a.z, a.w); o.z = pk2(b.x, b.y); o.w = pk2(b.z, b.w);
        *(GAS v4u*)(dst + col) = o; }
}
__device__ __forceinline__ float silu_f(float v) { return v / (1.f + __expf(-v)); }

__device__ __forceinline__ void p0_gemv(Frame& F) {
    RELAUNDER(F);
    LAS float* sl = (LAS float*)(F.lds);
    LAS float* red = (LAS float*)(F.lds + 81920);
    for (int i = F.tid; i < 5 * DM; i += NWAVES * 64) { const int b = i / DM, k = i % DM; const float v = (b == 0) ? F.c_ctx[k] : F.c[(b - 1) * DM + k]; sl[i] = silu_f(v); }
    __syncthreads();
    for (int jt = blockIdx.x; jt < NMODW / 96; jt += F.G) {
        const int jl = F.lane % 24, rg = F.lane / 24; const bool act = F.lane < 48;
        const float* wp = F.w_ada + (size_t)(2 * F.wave + (act ? rg : 0)) * NMODW + 96 * jt + 4 * jl;
        f32x4 acc[5];
#pragma unroll
        for (int b = 0; b < 5; ++b) acc[b] = (f32x4){0.f, 0.f, 0.f, 0.f};
        for (int it = 0; it < 256; it += 16) {
            f32x4 w[16];
#pragma unroll
            for (int u = 0; u < 16; ++u) w[u] = __builtin_nontemporal_load((const GAS f32x4*)(wp + (size_t)(it + u) * 16 * NMODW));
            __builtin_amdgcn_sched_barrier(0);
#pragma unroll
            for (int u = 0; u < 16; ++u) { const int k = 2 * F.wave + (act ? rg : 0) + 16 * (it + u);
#pragma unroll
                for (int b = 0; b < 5; ++b) { const float s = sl[b * DM + k]; acc[b] += w[u] * s; } }
        }
        if (act) {
#pragma unroll
            for (int b = 0; b < 5; ++b)
#pragma unroll
                for (int e = 0; e < 4; ++e) red[(F.wave * 48 + F.lane) * 20 + b * 4 + e] = acc[b][e];
        }
        __syncthreads();
        RELAUNDER(F);
        if (F.tid < 480) { const int b = F.tid / 96, jj = F.tid % 96, jl2 = jj >> 2, e = jj & 3; float s = 0.f;
#pragma unroll
            for (int w = 0; w < 8; ++w) s += red[(w * 48 + jl2) * 20 + b * 4 + e] + red[(w * 48 + 24 + jl2) * 20 + b * 4 + e];
            F.MOD[(size_t)b * NMODW + 96 * jt + jj] = s + F.b_ada[96 * jt + jj]; }
        __syncthreads();
    }
    __syncthreads();
}
template <int PART> __device__ __forceinline__ void p0_weights(Frame& F) {
    RELAUNDER(F);
    const int gw = F.vcu * NWAVES + F.wave, NGW = F.G * NWAVES;
    constexpr int I_IN = (DM / 8) * (NPROJ / 256), I_O = (DM / 8) * (DM / 256), I_1 = (DM / 8) * (DFF / 256), I_2 = (DFF / 8) * (DM / 256);
    constexpr int NITEMS = I_IN + I_O + I_1 + I_2;
#define P0_DECODE(it_, src_, N_, dst_) do { int r_ = (it_); const float* W_; bf16* T_; \
        if (r_ < I_IN) { W_ = F.w_in; T_ = F.Win_t; N_ = NPROJ; } else { r_ -= I_IN; \
        if (r_ < I_O) { W_ = F.w_out; T_ = F.Wout_t; N_ = DM; } else { r_ -= I_O; \
        if (r_ < I_1) { W_ = F.w_mlp_in; T_ = F.W1_t; N_ = DFF; } else { r_ -= I_1; W_ = F.w_mlp_out; T_ = F.W2_t; N_ = DM; } } } \
        const int nblk_ = N_ / 256, ko_ = r_ / nblk_, nb_ = r_ % nblk_; src_ = W_ + (size_t)(8 * ko_) * N_ + 256 * nb_ + 4 * F.lane; dst_ = T_ + ((size_t)ko_ * (N_ + OPAD) + 256 * nb_ + ((4 * F.lane) & ~31) + 16 * (F.lane & 1) + 4 * ((F.lane & 7) >> 1)) * 8; } while (0)
#define P0_PACK_STORE(r_, dst_) do { _Pragma("unroll") for (int e_ = 0; e_ < 4; ++e_) { v4u o_; o_.x = pk2(r_[0][e_], r_[1][e_]); o_.y = pk2(r_[2][e_], r_[3][e_]); o_.z = pk2(r_[4][e_], r_[5][e_]); o_.w = pk2(r_[6][e_], r_[7][e_]); \
        *(GAS v4u*)((dst_) + 8 * e_) = o_; } } while (0)
    constexpr int IT_LO = (PART == 1) ? I_IN : (PART == 2) ? I_IN + I_O : 0, IT_HI = (PART == 0) ? I_IN : (PART == 1) ? I_IN + I_O : (SIDE_W2 ? I_IN + I_O + I_1 : NITEMS);
    for (int it = IT_LO + gw; it < IT_HI; it += 2 * NGW) {
        const float* s0; const float* s1; bf16* d0; bf16* d1; int N0, N1; const bool two = it + NGW < IT_HI;
        const int ia = (PART == 2) ? IT_LO + IT_HI - 1 - it : it, ib = two ? ((PART == 2) ? ia - NGW : it + NGW) : ia;
        P0_DECODE(ia, s0, N0, d0); P0_DECODE(ib, s1, N1, d1);
        f32x4 ra[8], rb[8];
#pragma unroll
        for (int k = 0; k < 8; ++k) ra[k] = __builtin_nontemporal_load((const GAS f32x4*)(s0 + (size_t)k * N0));
#pragma unroll
        for (int k = 0; k < 8; ++k) rb[k] = __builtin_nontemporal_load((const GAS f32x4*)(s1 + (size_t)k * N1));
        __builtin_amdgcn_sched_barrier(0);
        P0_PACK_STORE(ra, d0);
        if (two) P0_PACK_STORE(rb, d1);
    }
#undef P0_DECODE
#undef P0_PACK_STORE
    if (PART == 0)
    for (int r = gw; r < 2 * 4 * PAST; r += NGW) {
        if (r < 4 * PAST) { const int b = r / PAST, j = r % PAST; cvt_row2048(F.cache_k + (size_t)r * DATT, F.KB + (size_t)(M_CTX + b * KV_LAT + LAT_SEQ + j) * DATT, F.lane); }
        else { const int rr = r - 4 * PAST; cvt_row2048(F.cache_v + (size_t)rr * DATT, F.CV + (size_t)rr * DATT, F.lane); }
    }
}

__device__ __forceinline__ void unpack8(const v4u w, float (&f)[8]) { f[0] = bflo(w.x); f[1] = bfhi(w.x); f[2] = bflo(w.y); f[3] = bfhi(w.y); f[4] = bflo(w.z); f[5] = bfhi(w.z); f[6] = bflo(w.w); f[7] = bfhi(w.w); }
__device__ __forceinline__ v4u pack8(const float (&f)[8]) { v4u o; o.x = pk2(f[0], f[1]); o.y = pk2(f[2], f[3]); o.z = pk2(f[4], f[5]); o.w = pk2(f[6], f[7]); return o; }
template <int WHICH> __device__ __forceinline__ void norm_mod_phase(Frame& F) {
    RELAUNDER(F);
    LAS float* gs = (LAS float*)(F.lds);
    LAS float* sh = (LAS float*)(F.lds + 16384);
    const float* g = WHICH ? F.norm_mlp_g : F.norm_attn_g;
    const int NR = MTOT / 8;
    const int r_lo = (int)(((long)blockIdx.x * NR) / F.G), r_hi = (int)(((long)(blockIdx.x + 1) * NR) / F.G);
    int cur_b = -1;
    for (int r8 = r_lo; r8 < r_hi; ++r8) {
        const int m0 = r8 * 8; const int b = m0 < M_CTX ? 0 : 1 + ((m0 - M_CTX) >> 10);
        if (b != cur_b) {
            __syncthreads();
            const float* scp = F.MOD + (size_t)b * NMODW + (WHICH ? 4 : 1) * DM; const float* shp = F.MOD + (size_t)b * NMODW + (WHICH ? 3 : 0) * DM;
            for (int i = F.tid; i < DM; i += NWAVES * 64) { gs[i] = g[i] * (1.f + scp[i]); sh[i] = shp[i]; }
            __syncthreads(); cur_b = b;
        }
        const int m = m0 + F.wave;
        if (WHICH == 0) {
            const float* xrow = m < M_CTX ? F.x_prompt + (size_t)m * DM : F.x_sample + (size_t)(m - M_CTX) * DM;
            const GAS f32x4* xr = (const GAS f32x4*)xrow + F.lane;
            f32x4 v[16]; float s = 0.f;
#pragma unroll
            for (int j = 0; j < 16; ++j) { v[j] = __builtin_nontemporal_load(xr + 64 * j); }
#pragma unroll
            for (int j = 0; j < 16; ++j) { s += (v[j].x * v[j].x + v[j].y * v[j].y) + (v[j].z * v[j].z + v[j].w * v[j].w); }
            const float rstd = 1.f / sqrtf(wave_sum(s) * (1.f / DM) + EPS);
            GAS v2u* o8 = (GAS v2u*)(F.XN + (size_t)m * LDX) + F.lane;
#pragma unroll
            for (int j = 0; j < 16; ++j) { const f32x4 gg = *(const LAS f32x4*)(gs + 4 * (F.lane + 64 * j)), ss = *(const LAS f32x4*)(sh + 4 * (F.lane + 64 * j));
                const f32x4 y = v[j] * rstd * gg + ss; v2u w; w.x = pk2(y.x, y.y); w.y = pk2(y.z, y.w); o8[64 * j] = w; }
        } else {
            const GAS v4u* xr = (const GAS v4u*)(F.X1B + (size_t)m * LDX) + F.lane;
            v4u xv[8]; float s = 0.f;
#pragma unroll
            for (int j = 0; j < 8; ++j) xv[j] = __builtin_nontemporal_load(xr + 64 * j);
            float f[8][8];
#pragma unroll
            for (int j = 0; j < 8; ++j) { unpack8(xv[j], f[j]);
#pragma unroll
                for (int e = 0; e < 8; ++e) s += f[j][e] * f[j][e]; }
            const float rstd = 1.f / sqrtf(wave_sum(s) * (1.f / DM) + EPS);
            GAS v4u* o16 = (GAS v4u*)(F.XN + (size_t)m * LDX) + F.lane;
#pragma unroll
            for (int j = 0; j < 8; ++j) { const int col = 8 * (F.lane + 64 * j);
                const f32x4 g0 = *(const LAS f32x4*)(gs + col), g1 = *(const LAS f32x4*)(gs + col + 4), s0 = *(const LAS f32x4*)(sh + col), s1 = *(const LAS f32x4*)(sh + col + 4);
                float y[8];
#pragma unroll
                for (int e = 0; e < 4; ++e) { y[e] = f[j][e] * rstd * g0[e] + s0[e]; y[4 + e] = f[j][4 + e] * rstd * g1[e] + s1[e]; }
                o16[64 * j] = pack8(y); }
        }
    }
}


__device__ __forceinline__ void post_proj_phase(Frame& F) {
    RELAUNDER(F);
    float* new_k = F.out + (size_t)MTOT * DM; float* new_v = new_k + (size_t)M_CTX * DATT;
    const int l8 = F.lane & 7, ax = l8 >> 2, i0 = (l8 & 3) * 8;
    float inv[8], gq1[8], gq2[8], gk1[8], gk2[8];
#pragma unroll
    for (int j = 0; j < 8; ++j) { inv[j] = exp2f(-(float)(2 * (i0 + j)) * (13.287712379549449f / 64.f));
        gq1[j] = F.q_norm_g[ax * 64 + i0 + j]; gq2[j] = F.q_norm_g[ax * 64 + 32 + i0 + j]; gk1[j] = F.k_norm_g[ax * 64 + i0 + j]; gk2[j] = F.k_norm_g[ax * 64 + 32 + i0 + j]; }
    const int NR = MTOT / 8;
    const int r_lo = (int)(((long)blockIdx.x * NR) / F.G), r_hi = (int)(((long)(blockIdx.x + 1) * NR) / F.G);
    for (int r8 = r_lo; r8 < r_hi; ++r8) {
        const int m = r8 * 8 + F.wave; const bool lat = m >= M_CTX;
        const int t = lat ? ((m - M_CTX) & (LAT_SEQ - 1)) : (m & (CTX_SEQ - 1)); const int L = lat ? LAT_SEQ : CTX_SEQ;
        const int krow = lat ? (M_CTX + ((m - M_CTX) >> 10) * KV_LAT + t) : m;
        const bf16* prow = F.PROJ + (size_t)m * LDP;
        v4u A[2][2][2]; v2u V8[8];
#pragma unroll
        for (int part = 0; part < 2; ++part)
#pragma unroll
            for (int pass = 0; pass < 2; ++pass) { const int cb = (pass * 8 + (F.lane >> 3)) * 128 + ax * 64 + i0;
                A[part][pass][0] = __builtin_nontemporal_load((const GAS v4u*)(prow + part * DATT + cb)); A[part][pass][1] = __builtin_nontemporal_load((const GAS v4u*)(prow + part * DATT + cb + 32)); }
        if (!lat) {
#pragma unroll
            for (int j = 0; j < 8; ++j) V8[j] = *(const GAS v2u*)(prow + 2 * DATT + 4 * (F.lane + 64 * j));
        }
        __builtin_amdgcn_sched_barrier(0);
#pragma unroll
        for (int part = 0; part < 2; ++part) {
#pragma unroll
            for (int pass = 0; pass < 2; ++pass) {
                const int gidx = pass * 8 + (F.lane >> 3); const int cb = gidx * 128 + ax * 64 + i0;
                float x1[8], x2[8];
                unpack8(A[part][pass][0], x1); unpack8(A[part][pass][1], x2);
                float ss = 0.f;
#pragma unroll
                for (int j = 0; j < 8; ++j) ss += x1[j] * x1[j] + x2[j] * x2[j];
                ss += __shfl_xor(ss, 1); ss += __shfl_xor(ss, 2); ss += __shfl_xor(ss, 4);
                const float rstd = 1.f / sqrtf(ss * (1.f / 128.f) + EPS);
#pragma unroll
                for (int j = 0; j < 8; ++j) { x1[j] = x1[j] * rstd * (part ? gk1[j] : gq1[j]); x2[j] = x2[j] * rstd * (part ? gk2[j] : gq2[j]); }
                if (part == 1 && !lat) {
                    float* nk = new_k + (size_t)m * DATT + cb;
                    __builtin_nontemporal_store((f32x4){x1[0], x1[1], x1[2], x1[3]}, (GAS f32x4*)(nk)); __builtin_nontemporal_store((f32x4){x1[4], x1[5], x1[6], x1[7]}, (GAS f32x4*)(nk + 4));
                    __builtin_nontemporal_store((f32x4){x2[0], x2[1], x2[2], x2[3]}, (GAS f32x4*)(nk + 32)); __builtin_nontemporal_store((f32x4){x2[4], x2[5], x2[6], x2[7]}, (GAS f32x4*)(nk + 36));
                }
                if (lat) {
                    const float pos = (float)(ax == 0 ? (t >> 6) : (t & 63));
#pragma unroll
                    for (int j = 0; j < 8; ++j) { const float ang = pos * inv[j]; const float cs = __cosf(ang), sn = __sinf(ang);
                        const float a = x1[j], b = x2[j]; x1[j] = a * cs - b * sn; x2[j] = a * sn + b * cs; }
                }
                bf16* dst = part ? (F.KB + (size_t)krow * DATT + cb) : (F.QB + (size_t)m * DATT + cb);
                *(GAS v4u*)(dst) = pack8(x1); *(GAS v4u*)(dst + 32) = pack8(x2);
            }
        }
        if (!lat) {
#pragma unroll
            for (int j = 0; j < 8; ++j) { const int col = 4 * (F.lane + 64 * j);
                __builtin_nontemporal_store((f32x4){bflo(V8[j].x), bfhi(V8[j].x), bflo(V8[j].y), bfhi(V8[j].y)}, (GAS f32x4*)(new_v + (size_t)m * DATT + col)); }
        }
        const bool hm = t > 0, hp = t < L - 1;
        const bf16* pm_ = hm ? prow - LDP : prow; const bf16* pp_ = hp ? prow + LDP : prow;
        const float fm = hm ? 1.f : 0.f, fp = hp ? 1.f : 0.f;
#pragma unroll
        for (int pb = 0; pb < 2; ++pb) {
            v4u C[2][7]; f32x4 W[2][6];
#pragma unroll
            for (int q = 0; q < 2; ++q) { const int ch = 8 * (F.lane + 64 * (2 * pb + q));
                C[q][0] = __builtin_nontemporal_load((const GAS v4u*)(prow + 3 * DATT + ch)); C[q][1] = *(const GAS v4u*)(prow + 4 * DATT + ch); C[q][2] = *(const GAS v4u*)(prow + 5 * DATT + ch);
                C[q][3] = *(const GAS v4u*)(pm_ + 4 * DATT + ch); C[q][4] = *(const GAS v4u*)(pm_ + 5 * DATT + ch);
                C[q][5] = *(const GAS v4u*)(pp_ + 4 * DATT + ch); C[q][6] = *(const GAS v4u*)(pp_ + 5 * DATT + ch);
#pragma unroll
                for (int k = 0; k < 3; ++k) { W[q][2 * k] = *(const GAS f32x4*)(F.conv_w + k * DATT + ch); W[q][2 * k + 1] = *(const GAS f32x4*)(F.conv_w + k * DATT + ch + 4); } }
            __builtin_amdgcn_sched_barrier(0);
#pragma unroll
            for (int q = 0; q < 2; ++q) { const int ch = 8 * (F.lane + 64 * (2 * pb + q));
                float bg[8], c0[8], u0[8], cm[8], um[8], cp[8], up[8];
                unpack8(C[q][0], bg); unpack8(C[q][1], c0); unpack8(C[q][2], u0); unpack8(C[q][3], cm); unpack8(C[q][4], um); unpack8(C[q][5], cp); unpack8(C[q][6], up);
                float y[8];
#pragma unroll
                for (int j = 0; j < 8; ++j) { const float w0 = W[q][j >> 2][j & 3], w1 = W[q][2 + (j >> 2)][j & 3], w2 = W[q][4 + (j >> 2)][j & 3];
                    y[j] = bg[j] * (w0 * (cm[j] * um[j]) * fm + w1 * (c0[j] * u0[j]) + w2 * (cp[j] * up[j]) * fp); }
                *(GAS v4u*)(F.MIX + (size_t)m * LDX + DATT + ch) = pack8(y); }
        }
    }
}

typedef float f32x2 __attribute__((ext_vector_type(2)));
struct SideJob { const float* W; bf16* T; int it, end, stride; };
constexpr int SIDE_ITEMS = (DFF / 8) * (DM / 128);
#define SIDE_LOAD(sd, sv, lane_) do { const int r_ = (sd).it, ko_ = r_ >> 5, nbh_ = r_ & 31; const float* sp_ = (sd).W + (size_t)(8 * ko_) * DM + 128 * nbh_ + 2 * (lane_); \
    _Pragma("unroll") for (int k_ = 0; k_ < 8; ++k_) sv[k_] = __builtin_nontemporal_load((const GAS f32x2*)(sp_ + (size_t)k_ * DM)); } while (0)
#define SIDE_STORE(sd, sv, lane_) do { const int r_ = (sd).it, ko_ = r_ >> 5, nbh_ = r_ & 31, cl_ = 128 * (nbh_ & 1) + 2 * (lane_), x_ = cl_ & 31; \
    bf16* dp_ = (sd).T + ((size_t)ko_ * (DM + OPAD) + 256 * (nbh_ >> 1) + 32 * (cl_ >> 5) + 16 * ((x_ >> 2) & 1) + 4 * (x_ >> 3) + (x_ & 3)) * 8; \
    _Pragma("unroll") for (int e_ = 0; e_ < 2; ++e_) { v4u o_; o_.x = pk2(sv[0][e_], sv[1][e_]); o_.y = pk2(sv[2][e_], sv[3][e_]); o_.z = pk2(sv[4][e_], sv[5][e_]); o_.w = pk2(sv[6][e_], sv[7][e_]); \
        *(GAS v4u*)(dp_ + 8 * e_) = o_; } (sd).it += (sd).stride; } while (0)

namespace att {
using s16x4  = __attribute__((ext_vector_type(4))) short;
using f32x16 = __attribute__((ext_vector_type(16))) float;
constexpr int KVBLK = 64;
constexpr float SCALE = 0.088388347648318440f;
constexpr float THR = 8.f;
constexpr int SHM_K = KVBLK * 128 * 2, SHM_V = KVBLK * 256 * 2;
constexpr int OFF_V = 0, OFF_K = 2 * SHM_V, OFF_WS = OFF_K + 2 * SHM_K, OFF_SSQ = OFF_WS + NWAVES * 256, ATT_LDS = OFF_SSQ + 128 * 2 * 4;
static_assert(ATT_LDS <= RING_BYTES, "attention LDS");
#define KSWZ(row, colB) ((row) * 256 + ((colB) ^ (((row) & 7) << 4)))
#define SBAR() __builtin_amdgcn_sched_barrier(0)
__device__ __forceinline__ int crow(int r, int hi) { return (r & 3) + 8 * (r >> 2) + 4 * hi; }
__device__ __forceinline__ unsigned cvtpk(float lo, float hi) { unsigned r; asm volatile("v_cvt_pk_bf16_f32 %0, %1, %2" : "=v"(r) : "v"(lo), "v"(hi)); return r; }

__device__ __forceinline__ void partialSM(f32x16& p0, f32x16& p1, float& m_reg, float& mn, float& alpha) {
  constexpr float C = SCALE * 1.4426950408889634f;
  float pmax = p0[0];
#pragma unroll
  for (int r = 1; r < 16; ++r) pmax = fmaxf(pmax, p0[r]);
#pragma unroll
  for (int r = 0; r < 16; ++r) pmax = fmaxf(pmax, p1[r]);
  { auto rr = __builtin_amdgcn_permlane32_swap(__float_as_uint(pmax), __float_as_uint(pmax), false, false);
    pmax = fmaxf(__uint_as_float(rr[0]), __uint_as_float(rr[1])); }
  if (__builtin_expect(__all(pmax - m_reg <= THR / SCALE), 1)) { mn = m_reg; alpha = 1.f; }
  else { mn = fmaxf(m_reg, pmax); alpha = __builtin_amdgcn_exp2f((m_reg - mn) * C); m_reg = mn; }
  float mnC = -mn * C;
#pragma unroll
  for (int r = 0; r < 16; ++r) p0[r] = fmaf(p0[r], C, mnC);
#pragma unroll
  for (int r = 0; r < 16; ++r) p1[r] = fmaf(p1[r], C, mnC);
#pragma unroll
  for (int r = 0; r < 16; ++r) p0[r] = __builtin_amdgcn_exp2f(p0[r]);
}
__device__ __forceinline__ void finishSM(f32x16& p0, f32x16& p1, float alpha, float& l_reg, bf16x8& pa0, bf16x8& pa1, bf16x8& pa2, bf16x8& pa3) {
#pragma unroll
  for (int r = 0; r < 16; ++r) p1[r] = __builtin_amdgcn_exp2f(p1[r]);
  float ps = 0;
#pragma unroll
  for (int r = 0; r < 16; ++r) ps += p0[r];
#pragma unroll
  for (int r = 0; r < 16; ++r) ps += p1[r];
  { auto rr = __builtin_amdgcn_permlane32_swap(__float_as_uint(ps), __float_as_uint(ps), false, false);
    ps = __uint_as_float(rr[0]) + __uint_as_float(rr[1]); }
  l_reg = l_reg * alpha + ps;
#define PK4(P, BASE, OUT) do { unsigned a0 = cvtpk(P[BASE + 0], P[BASE + 1]), a1 = cvtpk(P[BASE + 2], P[BASE + 3]);   \
    unsigned b0 = cvtpk(P[BASE + 4], P[BASE + 5]), b1 = cvtpk(P[BASE + 6], P[BASE + 7]);                              \
    auto r0 = __builtin_amdgcn_permlane32_swap(a0, b0, false, false); auto r1 = __builtin_amdgcn_permlane32_swap(a1, b1, false, false); \
    v4u w = {r0[0], r1[0], r0[1], r1[1]}; OUT = *reinterpret_cast<bf16x8*>(&w); } while (0)
  PK4(p0, 0, pa0); PK4(p0, 8, pa1); PK4(p1, 0, pa2); PK4(p1, 8, pa3);
#undef PK4
}
__device__ __forceinline__ void qkt(f32x16& p0, f32x16& p1, const LAS char* Ks, const bf16x8* qr, int r32, int hi) {
  p0 = f32x16{}; p1 = f32x16{};
#pragma unroll
  for (int d0 = 0; d0 < 8; ++d0) { int cb = (d0 * 16 + hi * 8) * 2;
    bf16x8 b0 = *reinterpret_cast<const LAS bf16x8*>(Ks + KSWZ(r32, cb));
    bf16x8 b1 = *reinterpret_cast<const LAS bf16x8*>(Ks + KSWZ(32 + r32, cb));
    p0 = __builtin_amdgcn_mfma_f32_32x32x16_bf16(b0, qr[d0], p0, 0, 0, 0);
    p1 = __builtin_amdgcn_mfma_f32_32x32x16_bf16(b1, qr[d0], p1, 0, 0, 0); }
}
__device__ __forceinline__ int v_st(int k, int c) { const int kk = (k & ~0xC) | ((k & 4) << 1) | ((k & 8) >> 1); return ((kk >> 3) * 4 + (c >> 5)) * 512 + ((kk & 7) * 32 + (c & 31)) * 2; }
__device__ __forceinline__ int v_rd_base(int lane) { return ((lane & 3) << 3) | (((lane >> 2) & 3) << 6) | (((lane >> 4) & 1) << 5) | (((lane >> 5) & 1) << 8); }
constexpr int v_rd_off(int d0, int ks, int half) { return d0 * 512 + ks * 4096 + half * 2048; }
template <int OFF> __device__ __forceinline__ s16x4 tr_read(int vb) {
  s16x4 r; asm volatile("ds_read_b64_tr_b16 %0, %1 offset:%2" : "=&v"(r) : "v"(vb), "i"(OFF) : "memory"); return r;
}
template <int D0> __device__ __forceinline__ void pv_one(f32x16& od, int vb, bf16x8 pa0, bf16x8 pa1, bf16x8 pa2, bf16x8 pa3) {
  const s16x4 l0 = tr_read<v_rd_off(D0, 0, 0)>(vb), h0 = tr_read<v_rd_off(D0, 0, 1)>(vb), l1 = tr_read<v_rd_off(D0, 1, 0)>(vb), h1 = tr_read<v_rd_off(D0, 1, 1)>(vb);
  const s16x4 l2 = tr_read<v_rd_off(D0, 2, 0)>(vb), h2 = tr_read<v_rd_off(D0, 2, 1)>(vb), l3 = tr_read<v_rd_off(D0, 3, 0)>(vb), h3 = tr_read<v_rd_off(D0, 3, 1)>(vb);
  asm volatile("s_waitcnt lgkmcnt(0)" ::: "memory"); SBAR();
#define PK(L, H) (bf16x8){L[0], L[1], L[2], L[3], H[0], H[1], H[2], H[3]}
  od = __builtin_amdgcn_mfma_f32_32x32x16_bf16(pa0, PK(l0, h0), od, 0, 0, 0);
  od = __builtin_amdgcn_mfma_f32_32x32x16_bf16(pa1, PK(l1, h1), od, 0, 0, 0);
  od = __builtin_amdgcn_mfma_f32_32x32x16_bf16(pa2, PK(l2, h2), od, 0, 0, 0);
  od = __builtin_amdgcn_mfma_f32_32x32x16_bf16(pa3, PK(l3, h3), od, 0, 0, 0);
#undef PK
}
__device__ __forceinline__ void pv_d0(f32x16* o, int vb, bf16x8 pa0, bf16x8 pa1, bf16x8 pa2, bf16x8 pa3) {
  pv_one<0>(o[0], vb, pa0, pa1, pa2, pa3); pv_one<1>(o[1], vb, pa0, pa1, pa2, pa3); pv_one<2>(o[2], vb, pa0, pa1, pa2, pa3); pv_one<3>(o[3], vb, pa0, pa1, pa2, pa3);
}

__device__ __forceinline__ void attn_unit(const bf16* Qp, const bf16* Kp, const bf16* V0p, int nself, const bf16* V1p, int nkeys, bf16* Op,
                                          float* park, const float* subln_g, float lam, float oscale, LAS char* lds, SideJob& sd) {
  int tid_l = threadIdx.x; asm volatile("" : "+v"(tid_l));
  const int tid = tid_l, wid = __builtin_amdgcn_readfirstlane(tid >> 6), lane = tid & 63, r32 = lane & 31, hi = lane >> 5, rg = wid >> 1, e = wid & 1;
  LAS char* V_lds = lds + OFF_V; LAS char* K_lds = lds + OFF_K;
  LAS float* wsf = (LAS float*)(lds + OFF_WS) + wid * 64; LAS float* li_l = wsf; LAS float* al_l = wsf + 32;
  LAS float* ssq = (LAS float*)(lds + OFF_SSQ);
  const int sr = tid >> 4, sc = (tid & 15) * 8, vst0 = v_st(sr, sc), vst1 = v_st(32 + sr, sc);
  const int vb0 = (int)(unsigned)(uintptr_t)(V_lds + e * (SHM_V / 2)) + v_rd_base(lane);
  const int NT = nkeys / KVBLK;
  const unsigned voS = (unsigned)(sr * LDP + sc), voC = (unsigned)(sr * DATT + sc);
  f32x16 o[4];
  float rli[16];
  for (int c = 0; c < 2; ++c) {
    float m_reg = -1e30f, l_reg = 0;
#pragma unroll
    for (int d = 0; d < 4; ++d) o[d] = f32x16{};
    bf16x8 qr[8];
    { const bf16* Qw = Qp + (size_t)(rg * 32 + r32) * DATT + c * 128 + hi * 8;
#pragma unroll
      for (int d0 = 0; d0 < 8; ++d0) qr[d0] = *(const GAS bf16x8*)(Qw + d0 * 16); }
    const bf16* Kh = Kp + c * 128;
    bf16x8 vs0, vs1, vs2, vs3, ks0, ks1;
#define SLOAD(k0) do { const int kk_ = (k0); const bool self_ = kk_ < nself; \
    const bf16* vu_ = self_ ? V0p + (size_t)kk_ * LDP : V1p + (size_t)(kk_ - nself) * DATT; const unsigned vo_ = self_ ? voS : voC, vst_ = self_ ? 32u * LDP : 32u * DATT; \
    vs0 = *(const GAS bf16x8*)(vu_ + vo_); vs1 = *(const GAS bf16x8*)(vu_ + (vo_ + 128u)); vs2 = *(const GAS bf16x8*)(vu_ + (vo_ + vst_)); vs3 = *(const GAS bf16x8*)(vu_ + (vo_ + vst_ + 128u)); \
    const bf16* ku_ = Kh + (size_t)kk_ * DATT; ks0 = *(const GAS bf16x8*)(ku_ + voC); ks1 = *(const GAS bf16x8*)(ku_ + (voC + 32u * DATT)); } while (0)
#define SWRITE(b) do { LAS char* vb_ = V_lds + (b) * SHM_V; LAS char* kb_ = K_lds + (b) * SHM_K; const int kc = sc * 2; \
    *(LAS bf16x8*)(vb_ + vst0) = vs0; *(LAS bf16x8*)(vb_ + SHM_V / 2 + vst0) = vs1; *(LAS bf16x8*)(vb_ + vst1) = vs2; *(LAS bf16x8*)(vb_ + SHM_V / 2 + vst1) = vs3; \
    *(LAS bf16x8*)(kb_ + KSWZ(sr, kc)) = ks0; *(LAS bf16x8*)(kb_ + KSWZ(32 + sr, kc)) = ks1; } while (0)
#define SWAIT() asm volatile("s_waitcnt vmcnt(0)" ::: "memory")
#define RESC(a) do { if (__any((a) < 1.f)) { if (hi == 0) al_l[r32] = (a); asm volatile("s_waitcnt lgkmcnt(0)" ::: "memory"); \
    _Pragma("unroll") for (int d = 0; d < 4; ++d) _Pragma("unroll") for (int r = 0; r < 16; ++r) o[d][r] *= al_l[crow(r, hi)]; } } while (0)
    f32x16 p0, p1; float mn, al; bf16x8 pa0, pa1, pa2, pa3;
    __syncthreads();
    SLOAD(0); SWAIT(); SWRITE(0); __syncthreads();
    for (int j = 0; j < NT; ++j) {
      const int buf = j & 1; const bool more = j + 1 < NT;
      if (more) SLOAD((j + 1) * KVBLK);
      const bool side = SIDE_W2 && more && sd.it < sd.end; f32x2 sv[8];
      if (side) SIDE_LOAD(sd, sv, lane);
      SBAR(); qkt(p0, p1, K_lds + buf * SHM_K, qr, r32, hi);
      partialSM(p0, p1, m_reg, mn, al);
      RESC(al);
      finishSM(p0, p1, al, l_reg, pa0, pa1, pa2, pa3); SBAR();
      pv_d0(o, vb0 + buf * SHM_V, pa0, pa1, pa2, pa3);
      if (more) { SWAIT(); SWRITE(buf ^ 1); }
      if (side) SIDE_STORE(sd, sv, lane);
      __syncthreads();
    }
#undef SLOAD
#undef SWRITE
#undef SWAIT
#undef RESC
    int hi_ = hi, r32_ = r32, wid_ = wid; asm volatile("" : "+v"(hi_), "+v"(r32_), "+s"(wid_));
    LAS float* li2 = (LAS float*)(lds + OFF_WS) + wid_ * 64;
    if (hi_ == 0) li2[r32_] = l_reg; asm volatile("s_waitcnt lgkmcnt(0)" ::: "memory");
#pragma unroll
    for (int r = 0; r < 16; ++r) rli[r] = __builtin_amdgcn_rcpf(li2[crow(r, hi_)]);
    if (c == 0) {
      float* pk = park + (size_t)wid_ * 4096 + (hi_ * 32 + r32_);
#pragma unroll
      for (int d = 0; d < 4; ++d)
#pragma unroll
        for (int r = 0; r < 16; ++r) pk[(d * 16 + r) * 64] = o[d][r] * rli[r];
    }
  }
  int hi_ = hi, r32_ = r32, wid_ = wid; asm volatile("" : "+v"(hi_), "+v"(r32_), "+s"(wid_));
  const int rg_ = wid_ >> 1, e_ = wid_ & 1;
  const float* pk = park + (size_t)wid_ * 4096 + (hi_ * 32 + r32_);
  asm volatile("s_waitcnt vmcnt(0)" ::: "memory");
  float q[16];
#pragma unroll
  for (int r = 0; r < 16; ++r) q[r] = 0.f;
#pragma unroll
  for (int d = 0; d < 4; ++d) {
#pragma unroll
    for (int r = 0; r < 16; ++r) { const float v = pk[(d * 16 + r) * 64] - lam * (o[d][r] * rli[r]); o[d][r] = v; q[r] += v * v; }
    asm volatile("" ::: "memory"); }
#pragma unroll
  for (int r = 0; r < 16; ++r) { float s = q[r]; s += __shfl_xor(s, 1); s += __shfl_xor(s, 2); s += __shfl_xor(s, 4); s += __shfl_xor(s, 8); s += __shfl_xor(s, 16); q[r] = s; }
  if (r32_ == 0) {
#pragma unroll
    for (int r = 0; r < 16; ++r) ssq[(rg_ * 32 + crow(r, hi_)) * 2 + e_] = q[r];
  }
  __syncthreads();
  float g4[4];
#pragma unroll
  for (int d = 0; d < 4; ++d) g4[d] = subln_g[e_ * 128 + d * 32 + r32_] * oscale;
  bf16* ob = Op + (size_t)(rg_ * 32 + 4 * hi_) * LDX + e_ * 128 + r32_;
  const LAS float* sq = ssq + (rg_ * 32 + 4 * hi_) * 2;
#pragma unroll
  for (int r = 0; r < 16; ++r) { const int rr = (r & 3) + 8 * (r >> 2); const float tot = sq[rr * 2] + sq[rr * 2 + 1]; const float rstd = __builtin_amdgcn_rsqf(tot * (1.f / 256.f) + EPS);
    bf16* orow = ob + (size_t)rr * LDX;
#pragma unroll
    for (int d = 0; d < 4; ++d) { const unsigned w = cvtpk(o[d][r] * rstd * g4[d], 0.f); orow[d * 32] = (bf16)(w & 0xffffu); } }
}
#undef KSWZ
#undef SBAR
}

__device__ __forceinline__ void attention_phase(Frame& F) {
    RELAUNDER(F);
    const float d1 = wave_sum(F.lq1[F.lane] * F.lk1[F.lane] + F.lq1[F.lane + 64] * F.lk1[F.lane + 64]);
    const float d2 = wave_sum(F.lq2[F.lane] * F.lk2[F.lane] + F.lq2[F.lane + 64] * F.lk2[F.lane + 64]);
    const float lam_init = 0.2f; const float lam = __expf(d1) - __expf(d2) + lam_init; const float oscale = 1.f - lam_init;
    float* park = F.PARK + (size_t)blockIdx.x * (NWAVES * 4096);
    LAS char* lds = (LAS char*)(F.lds + RING_OFF);
    SideJob sd{F.w_mlp_out, F.W2_t, F.vcu * NWAVES + F.wave, SIDE_W2 ? SIDE_ITEMS : 0, F.G * NWAVES};
    for (int idx = F.vcu; idx < 768; idx += F.G) {
        const bool lat = idx < 256; const int u = lat ? idx : idx - 256;
        const int b = lat ? (u >> 6) : (u >> 4), h = lat ? ((u >> 3) & 7) : ((u >> 1) & 7), qb = lat ? (u & 7) : (u & 1);
        const int m0 = lat ? M_CTX + b * LAT_SEQ : b * CTX_SEQ; const int k0row = lat ? M_CTX + b * KV_LAT : m0;
        att::attn_unit(F.QB + (size_t)(m0 + qb * 128) * DATT + h * 256, F.KB + (size_t)k0row * DATT + h * 256,
                       F.PROJ + (size_t)m0 * LDP + 2 * DATT + h * 256, lat ? LAT_SEQ : CTX_SEQ, F.CV + (size_t)(b & 3) * PAST * DATT + h * 256, lat ? KV_LAT : CTX_SEQ,
                       F.MIX + (size_t)(m0 + qb * 128) * LDX + h * 256, park, F.subln_g, lam, oscale, lds, sd);
    }
    RELAUNDER(F);
    while (sd.it < sd.end) { f32x2 sv[8]; SIDE_LOAD(sd, sv, F.lane); SIDE_STORE(sd, sv, F.lane); }
}

struct Args { const float* in[22]; float* out; unsigned char* ws; int ph_lo, ph_hi; };
__global__ void __launch_bounds__(NWAVES * 64, 2) mk_fwd(Args args) {
    extern __shared__ __attribute__((aligned(16))) unsigned char lds[];
    Frame F;
    F.lds = (LAS unsigned char*)lds;
    F.MISC = (volatile LAS unsigned*)(F.lds + MISC_OFF);
    F.tid = threadIdx.x; F.lane = F.tid & 63; F.wave = __builtin_amdgcn_readfirstlane(F.tid >> 6);
    F.G = gridDim.x; { const int bx = blockIdx.x; F.vcu = (F.G % 8 == 0) ? (bx % 8) * (F.G / 8) + bx / 8 : bx; }
    unsigned char* ws = args.ws;
    F.ctl = (gu32*)(ws + WS_CTL);
    F.x_prompt = args.in[0]; F.x_sample = args.in[1]; F.cache_k = args.in[2]; F.cache_v = args.in[3]; F.c = args.in[4]; F.c_ctx = args.in[5];
    F.w_ada = args.in[6]; F.b_ada = args.in[7]; F.norm_attn_g = args.in[8]; F.w_in = args.in[9]; F.q_norm_g = args.in[10]; F.k_norm_g = args.in[11];
    F.lq1 = args.in[12]; F.lk1 = args.in[13]; F.lq2 = args.in[14]; F.lk2 = args.in[15]; F.subln_g = args.in[16]; F.conv_w = args.in[17];
    F.w_out = args.in[18]; F.norm_mlp_g = args.in[19]; F.w_mlp_in = args.in[20]; F.w_mlp_out = args.in[21];
    F.out = args.out;
    F.MOD = (float*)(ws + WS_MOD); F.PARK = (float*)(ws + WS_PARK);
    F.Win_t = (bf16*)(ws + WS_WIN); F.Wout_t = (bf16*)(ws + WS_WOUT); F.W1_t = (bf16*)(ws + WS_W1); F.W2_t = (bf16*)(ws + WS_W2);
    F.XN = (bf16*)(ws + WS_XN); F.CV = (bf16*)(ws + WS_CV); F.PROJ = (bf16*)(ws + WS_PROJ); F.QB = (bf16*)(ws + WS_QB); F.KB = (bf16*)(ws + WS_KB);
    F.MIX = (bf16*)(ws + WS_MIX); F.HB = (bf16*)(ws + WS_H); F.X1B = (bf16*)(ws + WS_X1B);
    for (int u = F.tid; u < (LDS_BYTES - LDSCTL_OFF) / 4; u += NWAVES * 64) ((LAS unsigned*)(F.lds + LDSCTL_OFF))[u] = 0u;
    __syncthreads();
    XcdBarrier bar; bar.bar = (unsigned*)(F.ctl + CW_BAR); bar.x = 0; bar.st = nullptr;
    if (N_LAUNCHES == 1) bar = xcd_barrier_post((unsigned*)(F.ctl + CW_BAR), F.MISC + 8);
#define GRID_BAR(seam) do { if (N_LAUNCHES == 1) { xcd_barrier(bar); } } while (0)
    const int lo = args.ph_lo, hi = args.ph_hi;
#ifndef PH_MASK
#define PH_MASK 0x1ff
#endif
#define IN(k) (((PH_MASK >> (k)) & 1) && lo <= (k) && (k) < hi)
#define BOTH(k) (IN(k) && IN((k) + 1))
#define XS_SETUP(S_, gi_) do { (S_).ctr = (unsigned*)(F.ctl + CW_XS) + 64 * (16 * (gi_) + (int)bar.x); (S_).k = 0u; (S_).nloc = (N_LAUNCHES == 1 && lo == 0 && (S_).nwg % F.G == 0) ? F.MISC[8] : 0u; } while (0)
#ifndef PROBE_DUP
#define PROBE_DUP 0
#ifndef PROBE_GROUPED
#define PROBE_GROUPED 1
#endif
#endif
#define DUP(k) ((PROBE_DUP >> (k)) & 1)

    if (IN(0)) { p0_gemv(F); if (DUP(10)) { __syncthreads(); p0_gemv(F); } if (BOTH(0)) GRID_BAR(0); }
    if (IN(1)) { p0_weights<0>(F); norm_mod_phase<0>(F); if (DUP(1)) { __syncthreads(); norm_mod_phase<0>(F); } if (BOTH(1)) GRID_BAR(1); }
    if (IN(2)) {
        pg8::Gemm g{F.XN, F.Win_t, MTOT, NPROJ, DM, LDX, NPROJ + OPAD}; pg8::XcdSyncOrder S; S.init(MTOT, NPROJ, F.G, (int)blockIdx.x); S.grouped = (F.G == 256 && PROBE_GROUPED) ? 1 : 0; XS_SETUP(S, 0);
        pg8::EpiBf16<0> E{F.PROJ, LDP};
        pg8::gemm_phase<pg8::EpiBf16<0>, pg8::XcdSyncOrder, PG8_ALIGN, PG8_SP2>(F.lds + RING_OFF, g, S, E);
        if (DUP(2)) { __syncthreads(); pg8::gemm_phase<pg8::EpiBf16<0>, pg8::XcdSyncOrder, PG8_ALIGN, PG8_SP2>(F.lds + RING_OFF, g, S, E); }
        if (DUP(9)) { __syncthreads(); pg8::EpiNull EN; pg8::gemm_phase<pg8::EpiNull, pg8::XcdSyncOrder, PG8_ALIGN, PG8_SP2>(F.lds + RING_OFF, g, S, EN); }
        if (BOTH(2)) GRID_BAR(2);
    }
    if (IN(3)) { post_proj_phase(F); if (DUP(3)) { __syncthreads(); post_proj_phase(F); } if (BOTH(3)) GRID_BAR(3); }
    if (IN(4)) { attention_phase(F); p0_weights<1>(F); if (DUP(4)) { __syncthreads(); attention_phase(F); } if (BOTH(4)) GRID_BAR(4); }
    if (IN(5)) {
        pg8::Gemm g{F.MIX, F.Wout_t, MTOT, DM, DM, LDX, DM + OPAD}; pg8::XcdSyncOrder S; S.init(MTOT, DM, F.G, (int)blockIdx.x); S.grouped = (F.G == 256 && PROBE_GROUPED) ? 1 : 0; XS_SETUP(S, 1);
        pg8::EpiRes1 E{F.x_prompt, F.x_sample, F.X1B, LDX, F.MOD + 2 * DM};
        pg8::gemm_phase<pg8::EpiRes1, pg8::XcdSyncOrder, PG8_ALIGN, PG8_SP2>(F.lds + RING_OFF, g, S, E);
        if (DUP(5)) { __syncthreads(); pg8::gemm_phase<pg8::EpiRes1, pg8::XcdSyncOrder, PG8_ALIGN, PG8_SP2>(F.lds + RING_OFF, g, S, E); }
        if (BOTH(5)) GRID_BAR(5);
    }
    if (IN(6)) { p0_weights<2>(F); norm_mod_phase<1>(F); if (DUP(6)) { __syncthreads(); norm_mod_phase<1>(F); } if (BOTH(6)) GRID_BAR(6); }
    if (IN(7)) {
#if defined(PROBE_IDLE_US)
        { const unsigned long long t0 = __builtin_amdgcn_s_memrealtime(); while (__builtin_amdgcn_s_memrealtime() - t0 < 100ull * PROBE_IDLE_US) __builtin_amdgcn_s_sleep(32); }
#endif
        pg8::Gemm g{F.XN, F.W1_t, MTOT, DFF, DM, LDX, DFF + OPAD}; pg8::XcdSyncOrder S; S.init(MTOT, DFF, F.G, (int)blockIdx.x); S.grouped = (F.G == 256 && PROBE_GROUPED) ? 2 : 0; XS_SETUP(S, 2);
        pg8::EpiBf16<1> E{F.HB, LDH};
        pg8::gemm_phase<pg8::EpiBf16<1>, pg8::XcdSyncOrder, PG8_ALIGN, PG8_SP2>(F.lds + RING_OFF, g, S, E);
        if (DUP(7)) { __syncthreads(); pg8::gemm_phase<pg8::EpiBf16<1>, pg8::XcdSyncOrder, PG8_ALIGN, PG8_SP2>(F.lds + RING_OFF, g, S, E); }
        if (BOTH(7)) GRID_BAR(7);
    }
    if (IN(8)) {
        pg8::Gemm g{F.HB, F.W2_t, MTOT, DM, DFF, LDH, DM + OPAD}; pg8::XcdSyncOrder S; S.init(MTOT, DM, F.G, (int)blockIdx.x); S.grouped = (F.G == 256 && PROBE_GROUPED) ? 1 : 0; XS_SETUP(S, 3);
        pg8::EpiRes2 E{F.X1B, LDX, F.out, F.MOD + 5 * DM};
        pg8::gemm_phase<pg8::EpiRes2, pg8::XcdSyncOrder, PG8_ALIGN, PG8_SP2>(F.lds + RING_OFF, g, S, E);
        if (DUP(8)) { __syncthreads(); pg8::gemm_phase<pg8::EpiRes2, pg8::XcdSyncOrder, PG8_ALIGN, PG8_SP2>(F.lds + RING_OFF, g, S, E); }
    }
#undef IN
#undef BOTH
}

extern "C" void kernel_launch(void* const* d_in, const int* in_sizes, int n_in, void* d_out, int out_size, void* d_ws, size_t ws_size, hipStream_t stream) {
    static int grid = 0;
    if (grid == 0) {
        if (n_in != 22 || ws_size < WS_END) { fprintf(stderr, "kernel_launch: expected 22 inputs and >= %zu bytes of workspace; got n_in %d, ws %zu; nothing launched\n", (size_t)WS_END, n_in, ws_size); grid = -1; return; }
        int dev = 0, cus = 0, per_cu = 0;
        if (hipGetDevice(&dev) != hipSuccess || hipDeviceGetAttribute(&cus, hipDeviceAttributeMultiprocessorCount, dev) != hipSuccess) { grid = -1; return; }
        if (hipFuncSetAttribute((const void*)mk_fwd, hipFuncAttributeMaxDynamicSharedMemorySize, LDS_BYTES) != hipSuccess) { fprintf(stderr, "kernel_launch: hipFuncSetAttribute failed\n"); grid = -1; return; }
        if (hipOccupancyMaxActiveBlocksPerMultiprocessor(&per_cu, (const void*)mk_fwd, NWAVES * 64, LDS_BYTES) != hipSuccess || per_cu < 1)
            fprintf(stderr, "kernel_launch: note: occupancy query reports %d workgroups per CU\n", per_cu);
        (void)hipGetLastError();
        grid = cus;
    }
    if (grid < 0) return;
    if (hipMemsetAsync((char*)d_ws + WS_CTL, 0, CTL_ZERO_BYTES, stream) != hipSuccess) { fprintf(stderr, "kernel_launch: memset failed\n"); return; }
    Args a{};
    for (int i = 0; i < 22; ++i) a.in[i] = (const float*)d_in[i];
    a.out = (float*)d_out; a.ws = (unsigned char*)d_ws;
    for (int li = 0; li < N_LAUNCHES; ++li) {
        a.ph_lo = (N_LAUNCHES == 1) ? 0 : li; a.ph_hi = (N_LAUNCHES == 1) ? N_PHASES : li + 1;
        hipLaunchKernelGGL(mk_fwd, dim3(grid), dim3(NWAVES * 64), LDS_BYTES, stream, a);
        const hipError_t le = hipPeekAtLastError();
        if (le != hipSuccess) { fprintf(stderr, "kernel_launch: launch %d failed: %s\n", li, hipGetErrorName(le)); break; }
    }
}
```

```cpp
#include <hip/hip_runtime.h>
#include <cstdio>
#include <cstdint>

#ifndef MK_N_LAUNCHES
#define MK_N_LAUNCHES 1
#endif

namespace pg8 {
#define PG8_LAS __attribute__((address_space(3)))
typedef unsigned short bf16_t;
typedef short bf16x8 __attribute__((ext_vector_type(8)));
typedef float f32x4 __attribute__((ext_vector_type(4)));
typedef unsigned u32x4 __attribute__((ext_vector_type(4)));
constexpr int BM = 256, BK = 64, HALF = 128, HTB = HALF * BK * 2  , STAGE_BYTES = 8 * HTB, NXCD = 8, WGM = 8;

__host__ __device__ __forceinline__ int lds_byte(int r, int c) { const int st = (r >> 4) * 2 + (c >> 5), rr = r & 15, cc = c & 31, ob = rr * 64 + cc * 2; return st * 1024 + (ob ^ (((ob >> 9) & 1) << 5)); }
__host__ __device__ __forceinline__ void stage_rc(int b, int& R, int& C) { const int st = b / 1024, sb = b % 1024, swz = sb ^ (((sb >> 9) & 1) << 5); R = (st >> 1) * 16 + swz / 64; C = (st & 1) * 32 + (swz % 64) / 2; }
__host__ __device__ __forceinline__ int perm32(int rho) { const int n = rho >> 4, i = rho & 15; return 8 * (i >> 2) + 4 * n + (i & 3); }

struct Unit { int pm, pn; };
struct Gemm { const bf16_t* A; const bf16_t* Bt; int M, N, K, lda, ldb; };

struct StaticOrder {
    int nM, nN, nwg, G, c;
    __host__ __device__ void init(int M, int N, int G_, int c_) { nM = M / BM; nN = N / BM; nwg = nM * nN; G = G_; c = c_; }
    int grouped = 0;
    __host__ __device__ bool next(int i, Unit& u) const {
        if (grouped == 2) {
            const int x = c & 7, cu = c >> 3, nG = nM >> 3, strip = i / nG, grp = i % nG; if (strip >= (nN >> 5)) return false;
            u.pm = 8 * grp + (cu & 7); u.pn = 4 * (strip * 8 + x) + (cu >> 3); return true; }
        if (grouped) { const int x = c & 7, cu = c >> 3, bpg = nN >> 2, B = i * 8 + x; if (B >= (nM >> 3) * bpg) return false;
            u.pm = 8 * (B / bpg) + (cu & 7); u.pn = 4 * (B % bpg) + (cu >> 3); return true; }
        const long L = (long)i * G + c; if (L >= nwg) return false;
        int wgid = (int)L; { const int q = nwg / NXCD, r = nwg % NXCD, xcd = wgid % NXCD, off = wgid / NXCD; wgid = (xcd < r ? xcd * (q + 1) : r * (q + 1) + (xcd - r) * q) + off; }
        const int nig = WGM * nN, gid = wgid / nig, fm = gid * WGM, gsz = (nM - fm) < WGM ? (nM - fm) : WGM;
        u.pm = fm + ((wgid % nig) % gsz); u.pn = (wgid % nig) / gsz; return true;
    }
    __device__ __forceinline__ void a_ready(const Unit&) const {}
    __device__ __forceinline__ void done(const Unit&) const {}
};
struct XcdSyncOrder : StaticOrder {
    unsigned* ctr; unsigned nloc; mutable unsigned k;
    __device__ __forceinline__ void a_ready(const Unit&) const {
        if (nloc) {
            if (threadIdx.x == 0) { __hip_atomic_fetch_add(ctr, 1u, __ATOMIC_RELAXED, __HIP_MEMORY_SCOPE_AGENT); const unsigned want = nloc * (k + 1u); unsigned sp = 0;
                while (__hip_atomic_load(ctr, __ATOMIC_RELAXED, __HIP_MEMORY_SCOPE_AGENT) < want && ++sp < 4000u) __builtin_amdgcn_s_sleep(1); }
            ++k;
            asm volatile("" ::: "memory"); __builtin_amdgcn_s_barrier(); asm volatile("" ::: "memory");
        }
    }
};

__device__ __forceinline__ unsigned cvt_pk_bf16(float lo, float hi) { unsigned r; asm volatile("v_cvt_pk_bf16_f32 %0, %1, %2" : "=v"(r) : "v"(lo), "v"(hi)); return r; }

template <int ACT  > struct EpiBf16 {
    static constexpr bool PERM = true, AFTER_DRAIN = false;
    bf16_t* O; int ldc;
    __device__ __forceinline__ void operator()(const f32x4 (&acc)[2][2][4][2], const Unit& u, int wr, int wc, int fr, int fq) const {
        const int lane = fq * 16 + fr, fr2 = lane >> 2, fq2 = lane & 3, srcl = ((lane & 3) * 16 + (lane >> 2)) * 4;
        const int row0 = u.pm * BM + wr * 64 + fr2; const int col0 = u.pn * BM + wc * 32 + 8 * fq2;
#pragma unroll
        for (int ai = 0; ai < 2; ++ai)
#pragma unroll
            for (int m = 0; m < 4; ++m) { bf16_t* rowp = O + (size_t)(row0 + ai * HALF + m * 16) * ldc + col0;
#pragma unroll
                for (int bj = 0; bj < 2; ++bj) { f32x4 v0 = acc[ai][bj][m][0], v1 = acc[ai][bj][m][1];
                    if (ACT == 1) {
#pragma unroll
                        for (int j = 0; j < 4; ++j) { const float a = fmaxf(v0[j], 0.f), b = fmaxf(v1[j], 0.f); v0[j] = a * a; v1[j] = b * b; } }
                    u32x4 w; w.x = cvt_pk_bf16(v0[0], v0[1]); w.y = cvt_pk_bf16(v0[2], v0[3]); w.z = cvt_pk_bf16(v1[0], v1[1]); w.w = cvt_pk_bf16(v1[2], v1[3]);
                    u32x4 t; t.x = (unsigned)__builtin_amdgcn_ds_bpermute(srcl, (int)w.x); t.y = (unsigned)__builtin_amdgcn_ds_bpermute(srcl, (int)w.y);
                    t.z = (unsigned)__builtin_amdgcn_ds_bpermute(srcl, (int)w.z); t.w = (unsigned)__builtin_amdgcn_ds_bpermute(srcl, (int)w.w);
                    *(u32x4*)(rowp + bj * HALF) = t; } }
    }
};
struct EpiNull { static constexpr bool PERM = true, AFTER_DRAIN = false;
    __device__ __forceinline__ void operator()(const f32x4 (&acc)[2][2][4][2], const Unit& u, int wr, int wc, int fr, int fq) const { _Pragma("unroll") for (int a = 0; a < 2; ++a) _Pragma("unroll") for (int b = 0; b < 2; ++b) _Pragma("unroll") for (int m = 0; m < 4; ++m) _Pragma("unroll") for (int n = 0; n < 2; ++n) asm volatile("" :: "v"(acc[a][b][m][n])); } };
__device__ __forceinline__ f32x4 lane_tr(const f32x4 v, int srcl) { f32x4 r;
    r.x = __int_as_float(__builtin_amdgcn_ds_bpermute(srcl, __float_as_int(v.x))); r.y = __int_as_float(__builtin_amdgcn_ds_bpermute(srcl, __float_as_int(v.y)));
    r.z = __int_as_float(__builtin_amdgcn_ds_bpermute(srcl, __float_as_int(v.z))); r.w = __int_as_float(__builtin_amdgcn_ds_bpermute(srcl, __float_as_int(v.w))); return r; }
struct EpiRes1 {
    static constexpr bool PERM = true, AFTER_DRAIN = false;
    const float* base_ctx; const float* base_lat; bf16_t* O; int ldo; const float* gate;
    __device__ __forceinline__ void operator()(const f32x4 (&acc)[2][2][4][2], const Unit& u, int wr, int wc, int fr, int fq) const {
        const int lane = fq * 16 + fr, fr2 = lane >> 2, fq2 = lane & 3, srcl = ((lane & 3) * 16 + (lane >> 2)) * 4;
        const int mt = u.pm * BM; const bool lat = mt >= 8192; const int b = lat ? 1 + ((mt - 8192) >> 10) : 0;
        const float* bp = lat ? base_lat + (size_t)(mt - 8192) * 4096 : base_ctx + (size_t)mt * 4096;
        const int rl0 = wr * 64 + fr2, col0 = u.pn * BM + wc * 32 + 8 * fq2;
        bf16_t* op = O + (size_t)mt * ldo;
        f32x4 gv[2][2];
#pragma unroll
        for (int bj = 0; bj < 2; ++bj)
#pragma unroll
            for (int n = 0; n < 2; ++n) gv[bj][n] = *(const f32x4*)(gate + (size_t)b * 24576 + col0 + bj * HALF + n * 4);
#pragma unroll
        for (int ai = 0; ai < 2; ++ai)
#pragma unroll
            for (int m = 0; m < 4; ++m) { const int row = rl0 + ai * HALF + m * 16; const size_t off = (size_t)row * 4096 + col0;
#pragma unroll
                for (int bj = 0; bj < 2; ++bj) { const f32x4 b0 = __builtin_nontemporal_load((const f32x4*)(bp + off + bj * HALF)), b1 = __builtin_nontemporal_load((const f32x4*)(bp + off + bj * HALF + 4));
                    const f32x4 a0 = lane_tr(acc[ai][bj][m][0], srcl), a1 = lane_tr(acc[ai][bj][m][1], srcl);
                    const f32x4 v0 = b0 + gv[bj][0] * a0, v1 = b1 + gv[bj][1] * a1;
                    u32x4 w; w.x = cvt_pk_bf16(v0[0], v0[1]); w.y = cvt_pk_bf16(v0[2], v0[3]); w.z = cvt_pk_bf16(v1[0], v1[1]); w.w = cvt_pk_bf16(v1[2], v1[3]);
                    *(u32x4*)(op + (size_t)row * ldo + col0 + bj * HALF) = w; }
                asm volatile("" ::: "memory"); }
    }
};
struct EpiRes2 {
    static constexpr bool PERM = true, AFTER_DRAIN = false;
    const bf16_t* X; int ldx; float* out; const float* gate;
    __device__ __forceinline__ void operator()(const f32x4 (&acc)[2][2][4][2], const Unit& u, int wr, int wc, int fr, int fq) const {
        const int lane = fq * 16 + fr, fr2 = lane >> 2, fq2 = lane & 3, srcl = ((lane & 3) * 16 + (lane >> 2)) * 4;
        const int mt = u.pm * BM; const bool lat = mt >= 8192; const int b = lat ? 1 + ((mt - 8192) >> 10) : 0;
        const int rl0 = wr * 64 + fr2, col0 = u.pn * BM + wc * 32 + 8 * fq2;
        const bf16_t* xp = X + (size_t)mt * ldx; float* op = out + (size_t)mt * 4096;
        f32x4 gv[2][2];
#pragma unroll
        for (int bj = 0; bj < 2; ++bj)
#pragma unroll
            for (int n = 0; n < 2; ++n) gv[bj][n] = *(const f32x4*)(gate + (size_t)b * 24576 + col0 + bj * HALF + n * 4);
#pragma unroll
        for (int ai = 0; ai < 2; ++ai)
#pragma unroll
            for (int m = 0; m < 4; ++m) { const int row = rl0 + ai * HALF + m * 16; const size_t off = (size_t)row * 4096 + col0;
#pragma unroll
                for (int bj = 0; bj < 2; ++bj) { const u32x4 xb = __builtin_nontemporal_load((const u32x4*)(xp + (size_t)row * ldx + col0 + bj * HALF));
                    const f32x4 a0 = lane_tr(acc[ai][bj][m][0], srcl), a1 = lane_tr(acc[ai][bj][m][1], srcl);
                    const f32x4 b0 = {__uint_as_float(xb.x << 16), __uint_as_float(xb.x & 0xffff0000u), __uint_as_float(xb.y << 16), __uint_as_float(xb.y & 0xffff0000u)};
                    const f32x4 b1 = {__uint_as_float(xb.z << 16), __uint_as_float(xb.z & 0xffff0000u), __uint_as_float(xb.w << 16), __uint_as_float(xb.w & 0xffff0000u)};
                    __builtin_nontemporal_store(b0 + gv[bj][0] * a0, (f32x4*)(op + off + bj * HALF)); __builtin_nontemporal_store(b1 + gv[bj][1] * a1, (f32x4*)(op + off + bj * HALF + 4)); }
                asm volatile("" ::: "memory"); }
    }
};

template <class Epi, class Sched, bool ALIGN_EPI = false, bool SP2 = false>
__device__ __forceinline__ void gemm_phase(PG8_LAS unsigned char* lds, const Gemm g, const Sched& S, const Epi& E) {
    int tid_l = threadIdx.x; asm volatile("" : "+v"(tid_l));
    const int tid = tid_l, wid = __builtin_amdgcn_readfirstlane(tid >> 6), lane = tid & 63, wr = wid >> 2, wc = wid & 3, fr = lane & 15, fq = lane >> 4;
    const int K = g.K, nt = K / BK;
    unsigned voffA[2], voffB[2];
#pragma unroll
    for (int i = 0; i < 2; ++i) { int R, C; stage_rc(tid * 16 + i * 8192, R, C); const int bb = tid * 16 + i * 8192;
        voffA[i] = (unsigned)(R * g.lda + C) * 2u; voffB[i] = (unsigned)((bb >> 11) * g.ldb + ((bb & 2047) >> 4)) * 16u; }
    const size_t kstepA = (size_t)(BK * 2), kstepB = (size_t)(BK / 8) * g.ldb * 16;
    const size_t hstepA = (size_t)HALF * g.lda * 2, hstepB = (size_t)HALF * 16;
    const size_t tstepA = 2 * hstepA, tstepB = 2 * hstepB;
    const unsigned ldsw = (unsigned)wid * 1024u;
    const int aoff = lds_byte(wr * 64 + fr, fq * 8), boff = fq * 2048 + (wc * 32 + fr) * 16;
#define PG8_SA(b, h) (((b) * 2 + (h)) * HTB)
#define PG8_SB(b, h) ((4 + (b) * 2 + (h)) * HTB)
#define PG8_STAGE(bufoff, gbase, voff) do { _Pragma("unroll") for (int _i = 0; _i < 2; ++_i) \
        __builtin_amdgcn_global_load_lds((const unsigned*)((const char*)(gbase) + (voff)[_i]), (PG8_LAS unsigned*)(lds + (bufoff) + ldsw + _i * 8192), 16, 0, 0); } while (0)
#define PG8_LDA(dst, b, h) do { _Pragma("unroll") for (int m = 0; m < 4; ++m) _Pragma("unroll") for (int k = 0; k < 2; ++k) dst[m][k] = *(const PG8_LAS bf16x8*)(lds + PG8_SA(b, h) + aoff + m * 2048 + k * 1024); } while (0)
#define PG8_LDB(dst, b, h) do { _Pragma("unroll") for (int n = 0; n < 2; ++n) _Pragma("unroll") for (int k = 0; k < 2; ++k) dst[n][k] = *(const PG8_LAS bf16x8*)(lds + PG8_SB(b, h) + boff + n * 256 + k * 8192); } while (0)
#define PG8_MMA(ai, bj, At, Bt) do { __builtin_amdgcn_s_setprio(1); _Pragma("unroll") for (int m = 0; m < 4; ++m) _Pragma("unroll") for (int n = 0; n < 2; ++n) _Pragma("unroll") for (int k = 0; k < 2; ++k) \
        acc[ai][bj][m][n] = __builtin_amdgcn_mfma_f32_16x16x32_bf16(Bt[n][k], At[m][k], acc[ai][bj][m][n], 0, 0, 0); __builtin_amdgcn_s_setprio(0); } while (0)
#define PG8_WAIT_V(n) asm volatile("s_waitcnt vmcnt(" #n ")" ::: "memory")
#define PG8_WAIT_L(n) asm volatile("s_waitcnt lgkmcnt(" #n ")" ::: "memory")
#define PG8_BAR __builtin_amdgcn_s_barrier()
#define PG8_SCHED __builtin_amdgcn_sched_barrier(0)
    static_assert(Epi::PERM, "the weight copies are stored with perm32 applied to their column order: every epilogue must use the PERM column map");
    Unit cur, nxt; int ui = 0;
    if (!S.next(0, cur)) return;
    f32x4 acc[2][2][4][2];
#pragma unroll
    for (int a = 0; a < 2; ++a)
#pragma unroll
        for (int b = 0; b < 2; ++b)
#pragma unroll
            for (int m = 0; m < 4; ++m)
#pragma unroll
                for (int n = 0; n < 2; ++n) acc[a][b][m][n] = (f32x4){0.f, 0.f, 0.f, 0.f};
    bf16x8 At[4][2], B0[2][2], B1[2][2];
    const char* cA = (const char*)g.A + (size_t)cur.pm * tstepA; const char* cB = (const char*)g.Bt + (size_t)cur.pn * tstepB;
    S.a_ready(cur);
    if constexpr (SP2) {
        PG8_STAGE(PG8_SB(0, 0), cB, voffB); PG8_STAGE(PG8_SB(0, 1), cB + hstepB, voffB); PG8_STAGE(PG8_SA(0, 0), cA, voffA); PG8_STAGE(PG8_SA(0, 1), cA + hstepA, voffA);
        if (wr == 1) PG8_BAR;
        PG8_WAIT_V(2); PG8_BAR;
        PG8_STAGE(PG8_SB(1, 0), cB + kstepB, voffB); PG8_STAGE(PG8_SA(1, 0), cA + kstepA, voffA); PG8_STAGE(PG8_SB(1, 1), cB + hstepB + kstepB, voffB);
        PG8_WAIT_V(6); PG8_BAR;
    } else {
        PG8_STAGE(PG8_SB(0, 0), cB, voffB); PG8_STAGE(PG8_SA(0, 0), cA, voffA); PG8_STAGE(PG8_SB(0, 1), cB + hstepB, voffB); PG8_STAGE(PG8_SA(0, 1), cA + hstepA, voffA);
        if (wr == 1) PG8_BAR;
        PG8_WAIT_V(4); PG8_BAR;
        PG8_STAGE(PG8_SB(1, 0), cB + kstepB, voffB); PG8_STAGE(PG8_SA(1, 0), cA + kstepA, voffA); PG8_STAGE(PG8_SB(1, 1), cB + hstepB + kstepB, voffB);
        PG8_WAIT_V(6); PG8_BAR;
    }
    for (;;) {
        const bool has_next = S.next(ui + 1, nxt);
        const char* nA = has_next ? (const char*)g.A + (size_t)nxt.pm * tstepA : cA; const char* nB = has_next ? (const char*)g.Bt + (size_t)nxt.pn * tstepB : cB;
        for (int t = 0; t < nt; t += 2) {
            const bool last = (t == nt - 2);
            const char* a1 = cA + (size_t)(t + 1) * kstepA;
            const char* a2 = last ? nA : cA + (size_t)(t + 2) * kstepA; const char* b2 = last ? nB : cB + (size_t)(t + 2) * kstepB;
            const char* a3 = a2 + kstepA; const char* b3 = b2 + kstepB;
            if (last && has_next) S.a_ready(nxt);
            if constexpr (SP2) {
            PG8_LDB(B0, 0, 0); PG8_LDB(B1, 0, 1); PG8_SCHED; PG8_LDA(At, 0, 0); PG8_STAGE(PG8_SA(1, 1), a1 + hstepA, voffA);
            PG8_WAIT_V(8); PG8_WAIT_L(0); PG8_BAR; PG8_MMA(0, 0, At, B0); PG8_MMA(0, 1, At, B1); PG8_BAR; PG8_SCHED;
            PG8_LDA(At, 0, 1); PG8_STAGE(PG8_SB(0, 0), b2, voffB); PG8_STAGE(PG8_SB(0, 1), b2 + hstepB, voffB); PG8_STAGE(PG8_SA(0, 0), a2, voffA);
            PG8_WAIT_V(8); PG8_WAIT_L(0); PG8_BAR; PG8_MMA(1, 0, At, B0); PG8_MMA(1, 1, At, B1); PG8_BAR; PG8_SCHED;
            PG8_LDB(B0, 1, 0); PG8_LDB(B1, 1, 1); PG8_SCHED; PG8_LDA(At, 1, 0); PG8_STAGE(PG8_SA(0, 1), a2 + hstepA, voffA);
            PG8_WAIT_V(8); PG8_WAIT_L(0); PG8_BAR; PG8_MMA(0, 0, At, B0); PG8_MMA(0, 1, At, B1); PG8_BAR; PG8_SCHED;
            PG8_LDA(At, 1, 1); PG8_STAGE(PG8_SB(1, 0), b3, voffB); PG8_STAGE(PG8_SB(1, 1), b3 + hstepB, voffB); PG8_STAGE(PG8_SA(1, 0), a3, voffA);
            PG8_WAIT_V(8); PG8_WAIT_L(0); PG8_BAR; PG8_MMA(1, 0, At, B0); PG8_MMA(1, 1, At, B1); PG8_BAR; PG8_SCHED;
            } else {
            PG8_LDB(B0, 0, 0); PG8_SCHED; PG8_LDA(At, 0, 0); PG8_STAGE(PG8_SA(1, 1), a1 + hstepA, voffA);
            PG8_WAIT_L(8); PG8_BAR; PG8_WAIT_L(0); PG8_MMA(0, 0, At, B0); PG8_BAR; PG8_SCHED;
            PG8_LDB(B1, 0, 1); PG8_STAGE(PG8_SB(0, 0), b2, voffB);
            PG8_BAR; PG8_WAIT_L(0); PG8_MMA(0, 1, At, B1); PG8_BAR;
            PG8_LDA(At, 0, 1); PG8_STAGE(PG8_SA(0, 0), a2, voffA);
            PG8_BAR; PG8_WAIT_L(0); PG8_MMA(1, 0, At, B0); PG8_BAR; PG8_SCHED;
            PG8_STAGE(PG8_SB(0, 1), b2 + hstepB, voffB);
            PG8_WAIT_V(6); PG8_BAR; PG8_MMA(1, 1, At, B1); PG8_BAR;
            PG8_LDB(B0, 1, 0); PG8_SCHED; PG8_LDA(At, 1, 0); PG8_STAGE(PG8_SA(0, 1), a2 + hstepA, voffA);
            PG8_WAIT_L(8); PG8_BAR; PG8_WAIT_L(0); PG8_MMA(0, 0, At, B0); PG8_BAR; PG8_SCHED;
            PG8_LDB(B1, 1, 1); PG8_STAGE(PG8_SB(1, 0), b3, voffB);
            PG8_BAR; PG8_WAIT_L(0); PG8_MMA(0, 1, At, B1); PG8_BAR;
            PG8_LDA(At, 1, 1); PG8_STAGE(PG8_SA(1, 0), a3, voffA);
            PG8_BAR; PG8_WAIT_L(0); PG8_MMA(1, 0, At, B0); PG8_BAR; PG8_SCHED;
            PG8_STAGE(PG8_SB(1, 1), b3 + hstepB, voffB);
            PG8_WAIT_V(6); PG8_BAR; PG8_MMA(1, 1, At, B1); PG8_BAR;
            }
        }
        if constexpr (ALIGN_EPI) { if (wr == 0) PG8_BAR; }
        if constexpr (!Epi::AFTER_DRAIN) { E(acc, cur, wr, wc, fr, fq); S.done(cur); }
        if (!has_next) break;
#pragma unroll
        for (int a = 0; a < 2; ++a)
#pragma unroll
            for (int b = 0; b < 2; ++b)
#pragma unroll
                for (int m = 0; m < 4; ++m)
#pragma unroll
                    for (int n = 0; n < 2; ++n) acc[a][b][m][n] = (f32x4){0.f, 0.f, 0.f, 0.f};
        cur = nxt; cA = nA; cB = nB; ++ui;
        if constexpr (ALIGN_EPI) { if (wr == 1) PG8_BAR; }
    }
    PG8_WAIT_V(0);
    if constexpr (!ALIGN_EPI) { if (wr == 0) PG8_BAR; }
    PG8_BAR;
#undef PG8_SA
#undef PG8_SB
#undef PG8_STAGE
#undef PG8_LDA
#undef PG8_LDB
#undef PG8_MMA
#undef PG8_WAIT_V
#undef PG8_WAIT_L
#undef PG8_BAR
#undef PG8_SCHED
}
}

#ifndef PG8_SP2
#define PG8_SP2 true
#endif
#ifndef PG8_ALIGN
#define PG8_ALIGN true
#endif

constexpr int NWAVES = 8;
constexpr int DM = 4096, M_CTX = 8192, M_LAT = 4096, MTOT = M_CTX + M_LAT, NPROJ = 12288, DFF = 16384, DATT = 2048, NMODW = 6 * DM;
constexpr int LAT_SEQ = 1024, CTX_SEQ = 256, PAST = 256, NHEAD = 8, KV_LAT = LAT_SEQ + PAST;
constexpr int KB_ROWS = M_CTX + 4 * KV_LAT;
constexpr int LDX = DM + 64, LDH = DFF + 64, LDP = NPROJ + 64;
constexpr int OPAD = 272;
constexpr float EPS = 1e-6f;
constexpr int N_PHASES = 9;
constexpr int N_LAUNCHES = MK_N_LAUNCHES;

constexpr size_t MiB = 1u << 20;
constexpr size_t WS_CTL = 0, CTL_ZERO_BYTES = 64 * 1024;
constexpr size_t WS_MOD = 1 * MiB;
constexpr size_t WS_WIN = 2 * MiB;
constexpr size_t WS_WOUT = 102 * MiB;
constexpr size_t WS_W1 = 138 * MiB;
constexpr size_t WS_W2 = 270 * MiB;
constexpr size_t WS_XN = 408 * MiB;
constexpr size_t WS_CV = 506 * MiB;
constexpr size_t WS_PARK = 510 * MiB;
constexpr size_t WS_R = 542 * MiB;
constexpr size_t WS_PROJ = WS_R;
constexpr size_t WS_QB = WS_R + 290 * MiB;
constexpr size_t WS_KB = WS_R + 338 * MiB;
constexpr size_t WS_MIX = WS_R + 390 * MiB;
constexpr size_t WS_H = WS_R;
constexpr size_t WS_X1B = WS_R + 488 * MiB;
constexpr size_t WS_END = WS_X1B + 98 * MiB;
static_assert((size_t)MTOT * LDX * 2 <= 98 * MiB && (size_t)(DM / 8) * (NPROJ + OPAD) * 16 <= 100 * MiB && (size_t)(DM / 8) * (DM + OPAD) * 16 <= 36 * MiB && (size_t)(DM / 8) * (DFF + OPAD) * 16 <= 132 * MiB && (size_t)(DFF / 8) * (DM + OPAD) * 16 <= 138 * MiB && (size_t)MTOT * LDP * 2 <= 290 * MiB, "ws map 1");
static_assert((size_t)KB_ROWS * DATT * 2 <= 52 * MiB && (size_t)MTOT * LDH * 2 <= 386 * MiB && WS_H + 386 * MiB <= WS_MIX, "ws map 2");
constexpr int CW_TMO = 0, CW_CODE = 1;
constexpr int CW_BAR = 4096;
constexpr int CW_XS = 8192;

constexpr int RING_OFF = 0, RING_BYTES = 131072;
constexpr int LDSCTL_OFF = RING_BYTES, MISC_OFF = LDSCTL_OFF + 320;
constexpr int LDS_BYTES = 147456;
static_assert(MISC_OFF + 128 <= LDS_BYTES, "LDS map");

#define GAS __attribute__((address_space(1)))
#define LAS __attribute__((address_space(3)))
typedef unsigned short bf16;
typedef unsigned v4u __attribute__((ext_vector_type(4)));
typedef unsigned v2u __attribute__((ext_vector_type(2)));
typedef float f32x4 __attribute__((ext_vector_type(4)));
typedef short bf16x8 __attribute__((ext_vector_type(8)));
typedef GAS unsigned gu32;
#define RLX_AGENT __ATOMIC_RELAXED, __HIP_MEMORY_SCOPE_AGENT
#define LDS_WAIT() asm volatile("s_waitcnt lgkmcnt(0)" ::: "memory")
#define VM_WAIT() asm volatile("s_waitcnt vmcnt(0)" ::: "memory")
__device__ __forceinline__ unsigned pk2(float lo, float hi) { return pg8::cvt_pk_bf16(lo, hi); }
__device__ __forceinline__ float bflo(unsigned w) { return __uint_as_float(w << 16); }
__device__ __forceinline__ float bfhi(unsigned w) { return __uint_as_float(w & 0xffff0000u); }

#define XB_TMO      128
#define XB_XCNT(j)  (256  + 64 * (j))
#define XB_XSUB(j)  (1280 + 64 * (j))
#define XB_XGEN(j)  (2304 + 64 * (j))
#define XB_TOP      3328
#define XB_TOPGEN   3392
#define XCD_BAR_WORDS 3456
#define XB_SPIN_CAP (1u << 18)

__device__ __forceinline__ unsigned xb_ld(unsigned* p)              { return __hip_atomic_load(p, __ATOMIC_RELAXED, __HIP_MEMORY_SCOPE_AGENT); }
__device__ __forceinline__ unsigned xb_add(unsigned* p, unsigned v) { return __hip_atomic_fetch_add(p, v, __ATOMIC_RELAXED, __HIP_MEMORY_SCOPE_AGENT); }
__device__ __forceinline__ unsigned xb_xcc_id() { return (unsigned)__builtin_amdgcn_s_getreg((3 << 11) | 20) & 0xFu; }
#define XB_SPIN(cond, bar) do { unsigned _sp = 0; while (cond) { __builtin_amdgcn_s_sleep(1); \
    if ((++_sp & 255u) == 0u) { if (xb_ld(&(bar)[XB_TMO])) break; if (_sp > XB_SPIN_CAP) { atomicAdd(&(bar)[XB_TMO], 1u); break; } } } } while (0)

struct XcdBarrier {
    unsigned* bar; unsigned x;
    volatile LAS unsigned* st;
};
__device__ __forceinline__ XcdBarrier xcd_barrier_post(unsigned* bar, volatile LAS unsigned* st) {
    XcdBarrier b; b.bar = bar; b.x = xb_xcc_id(); b.st = st;
    if (threadIdx.x == 0) (void)xb_add(&bar[XB_XCNT(b.x)], 1u);
    return b;
}
__device__ __forceinline__ void xcd_barrier_complete(unsigned* bar, unsigned x, unsigned& nloc, unsigned& nx) {
    const unsigned G = gridDim.x * gridDim.y * gridDim.z;
    unsigned sum, cnt, mine, sp = 0u;
    for (;;) {
        sum = 0u; cnt = 0u; mine = 0u;
#pragma unroll
        for (unsigned j = 0; j < 16; ++j) { const unsigned c = xb_ld(&bar[XB_XCNT(j)]); sum += c; cnt += (c > 0u) ? 1u : 0u; mine = (j == x) ? c : mine; }
        if (sum == G) break;
        __builtin_amdgcn_s_sleep(1);
        if ((++sp & 255u) == 0u) { if (xb_ld(&bar[XB_TMO])) break; if (sp > XB_SPIN_CAP) { atomicAdd(&bar[XB_TMO], 1u); break; } }
    }
    nloc = mine > 0u ? mine : 1u; nx = cnt > 0u ? cnt : 1u;
}
__device__ __forceinline__ void xcd_barrier(const XcdBarrier& b) {
    asm volatile("s_waitcnt vmcnt(0)" ::: "memory");
    __syncthreads();
    if (threadIdx.x == 0) {
        unsigned* bar = b.bar;
        __builtin_amdgcn_s_waitcnt(0);
        unsigned nloc = b.st[0], nx = b.st[1];
        if (nloc == 0u) { xcd_barrier_complete(bar, b.x, nloc, nx); b.st[0] = nloc; b.st[1] = nx; }
        const unsigned old = xb_add(&bar[XB_XSUB(b.x)], 1u);
        const unsigned gen = old / nloc;
        if (old + 1u == (gen + 1u) * nloc) {
            __builtin_amdgcn_fence(__ATOMIC_RELEASE, "agent");
            asm volatile("s_waitcnt vmcnt(0)" ::: "memory");
            const unsigned og = xb_add(&bar[XB_TOP], 1u);
            const unsigned tg = og / nx;
            if (og + 1u == (tg + 1u) * nx) xb_add(&bar[XB_TOPGEN], 1u);
            else XB_SPIN(xb_ld(&bar[XB_TOPGEN]) == tg, bar);
            __builtin_amdgcn_fence(__ATOMIC_ACQUIRE, "agent");
            xb_add(&bar[XB_XGEN(b.x)], 1u);
            asm volatile("s_waitcnt vmcnt(0)" ::: "memory");
        } else {
            XB_SPIN(xb_ld(&bar[XB_XGEN(b.x)]) == gen, bar);
            __builtin_amdgcn_fence(__ATOMIC_ACQUIRE, "agent");
            asm volatile("s_waitcnt vmcnt(0)" ::: "memory");
        }
    }
    __syncthreads();
}

struct Frame {
    LAS unsigned char* lds;
    volatile LAS unsigned* MISC;
    gu32* ctl;
    int tid, lane, wave;
    int vcu, G;
    const float *x_prompt, *x_sample, *cache_k, *cache_v, *c, *c_ctx, *w_ada, *b_ada, *norm_attn_g, *w_in, *q_norm_g, *k_norm_g;
    const float *lq1, *lk1, *lq2, *lk2, *subln_g, *conv_w, *w_out, *norm_mlp_g, *w_mlp_in, *w_mlp_out;
    float* out;
    float* MOD; float* PARK;
    bf16 *Win_t, *Wout_t, *W1_t, *W2_t, *XN, *CV, *PROJ, *QB, *KB, *MIX, *HB, *X1B;
};

#define RELAUNDER(F) do { int t_ = threadIdx.x; asm volatile("" : "+v"(t_)); F.tid = t_; F.lane = t_ & 63; F.wave = __builtin_amdgcn_readfirstlane(t_ >> 6); } while (0)
__device__ __forceinline__ float wave_sum(float v) {
#pragma unroll
    for (int o = 1; o < 64; o <<= 1) v += __shfl_xor(v, o);
    return v;
}

#ifndef SIDE_W2
#define SIDE_W2 1
#endif
__device__ __forceinline__ void p0_transpose_item(const float* W, int K, int N, bf16* WT, LAS float* scr, int item, int lane) {
    const int nblk = N / 32, kb = item / nblk, nb = item % nblk, k0 = 64 * kb, n0 = 32 * nb;
#pragma unroll 8
    for (int i = 0; i < 32; ++i) { const int kk = 2 * i + (lane >> 5); scr[kk * 33 + (lane & 31)] = W[(size_t)(k0 + kk) * N + n0 + (lane & 31)]; }
    LDS_WAIT(); asm volatile("" ::: "memory");
    const int c = lane & 7;
#pragma unroll
    for (int j = 0; j < 4; ++j) { const int n = (lane >> 3) + 8 * j; const LAS float* s = scr + (8 * c) * 33 + n;
        v4u o; o.x = pk2(s[0 * 33], s[1 * 33]); o.y = pk2(s[2 * 33], s[3 * 33]); o.z = pk2(s[4 * 33], s[5 * 33]); o.w = pk2(s[6 * 33], s[7 * 33]);
        *(GAS v4u*)(WT + (size_t)(n0 + n) * K + k0 + 8 * c) = o; }
    LDS_WAIT(); asm volatile("" ::: "memory");
}
__device__ __forceinline__ void cvt_row2048(const float* src, bf16* dst, int lane) {
#pragma unroll
    for (int j = 0; j < 4; ++j) { const int col = 8 * (lane + 64 * j);
        const f32x4 a = *(const GAS f32x4*)(src + col), b = *(const GAS f32x4*)(src + col + 4);
        v4u o; o.x = pk2(a.x, a.y); o.y = pk2(a.z, a.w); o.z = pk2(b.x, b.y); o.w = pk2(b.z, b.w);
        *(GAS v4u*)(dst + col) = o; }
}
__device__ __forceinline__ float silu_f(float v) { return v / (1.f + __expf(-v)); }

__device__ __forceinline__ void p0_gemv(Frame& F) {
    RELAUNDER(F);
    LAS float* sl = (LAS float*)(F.lds);
    LAS float* red = (LAS float*)(F.lds + 81920);
    for (int i = F.tid; i < 5 * DM; i += NWAVES * 64) { const int b = i / DM, k = i % DM; const float v = (b == 0) ? F.c_ctx[k] : F.c[(b - 1) * DM + k]; sl[i] = silu_f(v); }
    __syncthreads();
    for (int jt = blockIdx.x; jt < NMODW / 96; jt += F.G) {
        const int jl = F.lane % 24, rg = F.lane / 24; const bool act = F.lane < 48;
        const float* wp = F.w_ada + (size_t)(2 * F.wave + (act ? rg : 0)) * NMODW + 96 * jt + 4 * jl;
        f32x4 acc[5];
#pragma unroll
        for (int b = 0; b < 5; ++b) acc[b] = (f32x4){0.f, 0.f, 0.f, 0.f};
        for (int it = 0; it < 256; it += 16) {
            f32x4 w[16];
#pragma unroll
            for (int u = 0; u < 16; ++u) w[u] = __builtin_nontemporal_load((const GAS f32x4*)(wp + (size_t)(it + u) * 16 * NMODW));
            __builtin_amdgcn_sched_barrier(0);
#pragma unroll
            for (int u = 0; u < 16; ++u) { const int k = 2 * F.wave + (act ? rg : 0) + 16 * (it + u);
#pragma unroll
                for (int b = 0; b < 5; ++b) { const float s = sl[b * DM + k]; acc[b] += w[u] * s; } }
        }
        if (act) {
#pragma unroll
            for (int b = 0; b < 5; ++b)
#pragma unroll
                for (int e = 0; e < 4; ++e) red[(F.wave * 48 + F.lane) * 20 + b * 4 + e] = acc[b][e];
        }
        __syncthreads();
        RELAUNDER(F);
        if (F.tid < 480) { const int b = F.tid / 96, jj = F.tid % 96, jl2 = jj >> 2, e = jj & 3; float s = 0.f;
#pragma unroll
            for (int w = 0; w < 8; ++w) s += red[(w * 48 + jl2) * 20 + b * 4 + e] + red[(w * 48 + 24 + jl2) * 20 + b * 4 + e];
            F.MOD[(size_t)b * NMODW + 96 * jt + jj] = s + F.b_ada[96 * jt + jj]; }
        __syncthreads();
    }
    __syncthreads();
}
template <int PART> __device__ __forceinline__ void p0_weights(Frame& F) {
    RELAUNDER(F);
    const int gw = F.vcu * NWAVES + F.wave, NGW = F.G * NWAVES;
    constexpr int I_IN = (DM / 8) * (NPROJ / 256), I_O = (DM / 8) * (DM / 256), I_1 = (DM / 8) * (DFF / 256), I_2 = (DFF / 8) * (DM / 256);
    constexpr int NITEMS = I_IN + I_O + I_1 + I_2;
#define P0_DECODE(it_, src_, N_, dst_) do { int r_ = (it_); const float* W_; bf16* T_; \
        if (r_ < I_IN) { W_ = F.w_in; T_ = F.Win_t; N_ = NPROJ; } else { r_ -= I_IN; \
        if (r_ < I_O) { W_ = F.w_out; T_ = F.Wout_t; N_ = DM; } else { r_ -= I_O; \
        if (r_ < I_1) { W_ = F.w_mlp_in; T_ = F.W1_t; N_ = DFF; } else { r_ -= I_1; W_ = F.w_mlp_out; T_ = F.W2_t; N_ = DM; } } } \
        const int nblk_ = N_ / 256, ko_ = r_ / nblk_, nb_ = r_ % nblk_; src_ = W_ + (size_t)(8 * ko_) * N_ + 256 * nb_ + 4 * F.lane; dst_ = T_ + ((size_t)ko_ * (N_ + OPAD) + 256 * nb_ + ((4 * F.lane) & ~31) + 16 * (F.lane & 1) + 4 * ((F.lane & 7) >> 1)) * 8; } while (0)
#define P0_PACK_STORE(r_, dst_) do { _Pragma("unroll") for (int e_ = 0; e_ < 4; ++e_) { v4u o_; o_.x = pk2(r_[0][e_], r_[1][e_]); o_.y = pk2(r_[2][e_], r_[3][e_]); o_.z = pk2(r_[4][e_], r_[5][e_]); o_.w = pk2(r_[6][e_], r_[7][e_]); \
        *(GAS v4u*)((dst_) + 8 * e_) = o_; } } while (0)
    constexpr int IT_LO = (PART == 1) ? I_IN : (PART == 2) ? I_IN + I_O : 0, IT_HI = (PART == 0) ? I_IN : (PART == 1) ? I_IN + I_O : (SIDE_W2 ? I_IN + I_O + I_1 : NITEMS);
    for (int it = IT_LO + gw; it < IT_HI; it += 2 * NGW) {
        const float* s0; const float* s1; bf16* d0; bf16* d1; int N0, N1; const bool two = it + NGW < IT_HI;
        const int ia = (PART == 2) ? IT_LO + IT_HI - 1 - it : it, ib = two ? ((PART == 2) ? ia - NGW : it + NGW) : ia;
        P0_DECODE(ia, s0, N0, d0); P0_DECODE(ib, s1, N1, d1);
        f32x4 ra[8], rb[8];
#pragma unroll
        for (int k = 0; k < 8; ++k) ra[k] = __builtin_nontemporal_load((const GAS f32x4*)(s0 + (size_t)k * N0));
#pragma unroll
        for (int k = 0; k < 8; ++k) rb[k] = __builtin_nontemporal_load((const GAS f32x4*)(s1 + (size_t)k * N1));
        __builtin_amdgcn_sched_barrier(0);
        P0_PACK_STORE(ra, d0);
        if (two) P0_PACK_STORE(rb, d1);
    }
#undef P0_DECODE
#undef P0_PACK_STORE
    if (PART == 0)
    for (int r = gw; r < 2 * 4 * PAST; r += NGW) {
        if (r < 4 * PAST) { const int b = r / PAST, j = r % PAST; cvt_row2048(F.cache_k + (size_t)r * DATT, F.KB + (size_t)(M_CTX + b * KV_LAT + LAT_SEQ + j) * DATT, F.lane); }
        else { const int rr = r - 4 * PAST; cvt_row2048(F.cache_v + (size_t)rr * DATT, F.CV + (size_t)rr * DATT, F.lane); }
    }
}

__device__ __forceinline__ void unpack8(const v4u w, float (&f)[8]) { f[0] = bflo(w.x); f[1] = bfhi(w.x); f[2] = bflo(w.y); f[3] = bfhi(w.y); f[4] = bflo(w.z); f[5] = bfhi(w.z); f[6] = bflo(w.w); f[7] = bfhi(w.w); }
__device__ __forceinline__ v4u pack8(const float (&f)[8]) { v4u o; o.x = pk2(f[0], f[1]); o.y = pk2(f[2], f[3]); o.z = pk2(f[4], f[5]); o.w = pk2(f[6], f[7]); return o; }
template <int WHICH> __device__ __forceinline__ void norm_mod_phase(Frame& F) {
    RELAUNDER(F);
    LAS float* gs = (LAS float*)(F.lds);
    LAS float* sh = (LAS float*)(F.lds + 16384);
    const float* g = WHICH ? F.norm_mlp_g : F.norm_attn_g;
    const int NR = MTOT / 8;
    const int r_lo = (int)(((long)blockIdx.x * NR) / F.G), r_hi = (int)(((long)(blockIdx.x + 1) * NR) / F.G);
    int cur_b = -1;
    for (int r8 = r_lo; r8 < r_hi; ++r8) {
        const int m0 = r8 * 8; const int b = m0 < M_CTX ? 0 : 1 + ((m0 - M_CTX) >> 10);
        if (b != cur_b) {
            __syncthreads();
            const float* scp = F.MOD + (size_t)b * NMODW + (WHICH ? 4 : 1) * DM; const float* shp = F.MOD + (size_t)b * NMODW + (WHICH ? 3 : 0) * DM;
            for (int i = F.tid; i < DM; i += NWAVES * 64) { gs[i] = g[i] * (1.f + scp[i]); sh[i] = shp[i]; }
            __syncthreads(); cur_b = b;
        }
        const int m = m0 + F.wave;
        if (WHICH == 0) {
            const float* xrow = m < M_CTX ? F.x_prompt + (size_t)m * DM : F.x_sample + (size_t)(m - M_CTX) * DM;
            const GAS f32x4* xr = (const GAS f32x4*)xrow + F.lane;
            f32x4 v[16]; float s = 0.f;
#pragma unroll
            for (int j = 0; j < 16; ++j) { v[j] = __builtin_nontemporal_load(xr + 64 * j); }
#pragma unroll
            for (int j = 0; j < 16; ++j) { s += (v[j].x * v[j].x + v[j].y * v[j].y) + (v[j].z * v[j].z + v[j].w * v[j].w); }
            const float rstd = 1.f / sqrtf(wave_sum(s) * (1.f / DM) + EPS);
            GAS v2u* o8 = (GAS v2u*)(F.XN + (size_t)m * LDX) + F.lane;
#pragma unroll
            for (int j = 0; j < 16; ++j) { const f32x4 gg = *(const LAS f32x4*)(gs + 4 * (F.lane + 64 * j)), ss = *(const LAS f32x4*)(sh + 4 * (F.lane + 64 * j));
                const f32x4 y = v[j] * rstd * gg + ss; v2u w; w.x = pk2(y.x, y.y); w.y = pk2(y.z, y.w); o8[64 * j] = w; }
        } else {
            const GAS v4u* xr = (const GAS v4u*)(F.X1B + (size_t)m * LDX) + F.lane;
            v4u xv[8]; float s = 0.f;
#pragma unroll
            for (int j = 0; j < 8; ++j) xv[j] = __builtin_nontemporal_load(xr + 64 * j);
            float f[8][8];
#pragma unroll
            for (int j = 0; j < 8; ++j) { unpack8(xv[j], f[j]);
#pragma unroll
                for (int e = 0; e < 8; ++e) s += f[j][e] * f[j][e]; }
            const float rstd = 1.f / sqrtf(wave_sum(s) * (1.f / DM) + EPS);
            GAS v4u* o16 = (GAS v4u*)(F.XN + (size_t)m * LDX) + F.lane;
#pragma unroll
            for (int j = 0; j < 8; ++j) { const int col = 8 * (F.lane + 64 * j);
                const f32x4 g0 = *(const LAS f32x4*)(gs + col), g1 = *(const LAS f32x4*)(gs + col + 4), s0 = *(const LAS f32x4*)(sh + col), s1 = *(const LAS f32x4*)(sh + col + 4);
                float y[8];
#pragma unroll
                for (int e = 0; e < 4; ++e) { y[e] = f[j][e] * rstd * g0[e] + s0[e]; y[4 + e] = f[j][4 + e] * rstd * g1[e] + s1[e]; }
                o16[64 * j] = pack8(y); }
        }
    }
}


__device__ __forceinline__ void post_proj_phase(Frame& F) {
    RELAUNDER(F);
    float* new_k = F.out + (size_t)MTOT * DM; float* new_v = new_k + (size_t)M_CTX * DATT;
    const int l8 = F.lane & 7, ax = l8 >> 2, i0 = (l8 & 3) * 8;
    float inv[8], gq1[8], gq2[8], gk1[8], gk2[8];
#pragma unroll
    for (int j = 0; j < 8; ++j) { inv[j] = exp2f(-(float)(2 * (i0 + j)) * (13.287712379549449f / 64.f));
        gq1[j] = F.q_norm_g[ax * 64 + i0 + j]; gq2[j] = F.q_norm_g[ax * 64 + 32 + i0 + j]; gk1[j] = F.k_norm_g[ax * 64 + i0 + j]; gk2[j] = F.k_norm_g[ax * 64 + 32 + i0 + j]; }
    const int NR = MTOT / 8;
    const int r_lo = (int)(((long)blockIdx.x * NR) / F.G), r_hi = (int)(((long)(blockIdx.x + 1) * NR) / F.G);
    for (int r8 = r_lo; r8 < r_hi; ++r8) {
        const int m = r8 * 8 + F.wave; const bool lat = m >= M_CTX;
        const int t = lat ? ((m - M_CTX) & (LAT_SEQ - 1)) : (m & (CTX_SEQ - 1)); const int L = lat ? LAT_SEQ : CTX_SEQ;
        const int krow = lat ? (M_CTX + ((m - M_CTX) >> 10) * KV_LAT + t) : m;
        const bf16* prow = F.PROJ + (size_t)m * LDP;
        v4u A[2][2][2]; v2u V8[8];
#pragma unroll
        for (int part = 0; part < 2; ++part)
#pragma unroll
            for (int pass = 0; pass < 2; ++pass) { const int cb = (pass * 8 + (F.lane >> 3)) * 128 + ax * 64 + i0;
                A[part][pass][0] = __builtin_nontemporal_load((const GAS v4u*)(prow + part * DATT + cb)); A[part][pass][1] = __builtin_nontemporal_load((const GAS v4u*)(prow + part * DATT + cb + 32)); }
        if (!lat) {
#pragma unroll
            for (int j = 0; j < 8; ++j) V8[j] = *(const GAS v2u*)(prow + 2 * DATT + 4 * (F.lane + 64 * j));
        }
        __builtin_amdgcn_sched_barrier(0);
#pragma unroll
        for (int part = 0; part < 2; ++part) {
#pragma unroll
            for (int pass = 0; pass < 2; ++pass) {
                const int gidx = pass * 8 + (F.lane >> 3); const int cb = gidx * 128 + ax * 64 + i0;
                float x1[8], x2[8];
                unpack8(A[part][pass][0], x1); unpack8(A[part][pass][1], x2);
                float ss = 0.f;
#pragma unroll
                for (int j = 0; j < 8; ++j) ss += x1[j] * x1[j] + x2[j] * x2[j];
                ss += __shfl_xor(ss, 1); ss += __shfl_xor(ss, 2); ss += __shfl_xor(ss, 4);
                const float rstd = 1.f / sqrtf(ss * (1.f / 128.f) + EPS);
#pragma unroll
                for (int j = 0; j < 8; ++j) { x1[j] = x1[j] * rstd * (part ? gk1[j] : gq1[j]); x2[j] = x2[j] * rstd * (part ? gk2[j] : gq2[j]); }
                if (part == 1 && !lat) {
                    float* nk = new_k + (size_t)m * DATT + cb;
                    __builtin_nontemporal_store((f32x4){x1[0], x1[1], x1[2], x1[3]}, (GAS f32x4*)(nk)); __builtin_nontemporal_store((f32x4){x1[4], x1[5], x1[6], x1[7]}, (GAS f32x4*)(nk + 4));
                    __builtin_nontemporal_store((f32x4){x2[0], x2[1], x2[2], x2[3]}, (GAS f32x4*)(nk + 32)); __builtin_nontemporal_store((f32x4){x2[4], x2[5], x2[6], x2[7]}, (GAS f32x4*)(nk + 36));
                }
                if (lat) {
                    const float pos = (float)(ax == 0 ? (t >> 6) : (t & 63));
#pragma unroll
                    for (int j = 0; j < 8; ++j) { const float ang = pos * inv[j]; const float cs = __cosf(ang), sn = __sinf(ang);
                        const float a = x1[j], b = x2[j]; x1[j] = a * cs - b * sn; x2[j] = a * sn + b * cs; }
                }
                bf16* dst = part ? (F.KB + (size_t)krow * DATT + cb) : (F.QB + (size_t)m * DATT + cb);
                *(GAS v4u*)(dst) = pack8(x1); *(GAS v4u*)(dst + 32) = pack8(x2);
            }
        }
        if (!lat) {
#pragma unroll
            for (int j = 0; j < 8; ++j) { const int col = 4 * (F.lane + 64 * j);
                __builtin_nontemporal_store((f32x4){bflo(V8[j].x), bfhi(V8[j].x), bflo(V8[j].y), bfhi(V8[j].y)}, (GAS f32x4*)(new_v + (size_t)m * DATT + col)); }
        }
        const bool hm = t > 0, hp = t < L - 1;
        const bf16* pm_ = hm ? prow - LDP : prow; const bf16* pp_ = hp ? prow + LDP : prow;
        const float fm = hm ? 1.f : 0.f, fp = hp ? 1.f : 0.f;
#pragma unroll
        for (int pb = 0; pb < 2; ++pb) {
            v4u C[2][7]; f32x4 W[2][6];
#pragma unroll
            for (int q = 0; q < 2; ++q) { const int ch = 8 * (F.lane + 64 * (2 * pb + q));
                C[q][0] = __builtin_nontemporal_load((const GAS v4u*)(prow + 3 * DATT + ch)); C[q][1] = *(const GAS v4u*)(prow + 4 * DATT + ch); C[q][2] = *(const GAS v4u*)(prow + 5 * DATT + ch);
                C[q][3] = *(const GAS v4u*)(pm_ + 4 * DATT + ch); C[q][4] = *(const GAS v4u*)(pm_ + 5 * DATT + ch);
                C[q][5] = *(const GAS v4u*)(pp_ + 4 * DATT + ch); C[q][6] = *(const GAS v4u*)(pp_ + 5 * DATT + ch);
#pragma unroll
                for (int k = 0; k < 3; ++k) { W[q][2 * k] = *(const GAS f32x4*)(F.conv_w + k * DATT + ch); W[q][2 * k + 1] = *(const GAS f32x4*)(F.conv_w + k * DATT + ch + 4); } }
            __builtin_amdgcn_sched_barrier(0);
#pragma unroll
            for (int q = 0; q < 2; ++q) { const int ch = 8 * (F.lane + 64 * (2 * pb + q));
                float bg[8], c0[8], u0[8], cm[8], um[8], cp[8], up[8];
                unpack8(C[q][0], bg); unpack8(C[q][1], c0); unpack8(C[q][2], u0); unpack8(C[q][3], cm); unpack8(C[q][4], um); unpack8(C[q][5], cp); unpack8(C[q][6], up);
                float y[8];
#pragma unroll
                for (int j = 0; j < 8; ++j) { const float w0 = W[q][j >> 2][j & 3], w1 = W[q][2 + (j >> 2)][j & 3], w2 = W[q][4 + (j >> 2)][j & 3];
                    y[j] = bg[j] * (w0 * (cm[j] * um[j]) * fm + w1 * (c0[j] * u0[j]) + w2 * (cp[j] * up[j]) * fp); }
                *(GAS v4u*)(F.MIX + (size_t)m * LDX + DATT + ch) = pack8(y); }
        }
    }
}

typedef float f32x2 __attribute__((ext_vector_type(2)));
struct SideJob { const float* W; bf16* T; const float* Wb; bf16* Tb; int it, end, stride; };
constexpr int SIDE_ITEMS = (DFF / 8) * (DM / 128), SIDE_END = SIDE_ITEMS + (DM / 8) * (DM / 128);
#define SIDE_LOAD(sd, sv, lane_) do { const bool wo_ = (sd).it >= SIDE_ITEMS; const int r_ = wo_ ? (sd).it - SIDE_ITEMS : (sd).it, ko_ = r_ >> 5, nbh_ = r_ & 31; const float* sp_ = (wo_ ? (sd).Wb : (sd).W) + (size_t)(8 * ko_) * DM + 128 * nbh_ + 2 * (lane_); \
    _Pragma("unroll") for (int k_ = 0; k_ < 8; ++k_) sv[k_] = __builtin_nontemporal_load((const GAS f32x2*)(sp_ + (size_t)k_ * DM)); } while (0)
#define SIDE_STORE(sd, sv, lane_) do { const bool wo_ = (sd).it >= SIDE_ITEMS; const int r_ = wo_ ? (sd).it - SIDE_ITEMS : (sd).it, ko_ = r_ >> 5, nbh_ = r_ & 31, cl_ = 128 * (nbh_ & 1) + 2 * (lane_), x_ = cl_ & 31; \
    bf16* dp_ = (wo_ ? (sd).Tb : (sd).T) + ((size_t)ko_ * (DM + OPAD) + 256 * (nbh_ >> 1) + 32 * (cl_ >> 5) + 16 * ((x_ >> 2) & 1) + 4 * (x_ >> 3) + (x_ & 3)) * 8; \
    _Pragma("unroll") for (int e_ = 0; e_ < 2; ++e_) { v4u o_; o_.x = pk2(sv[0][e_], sv[1][e_]); o_.y = pk2(sv[2][e_], sv[3][e_]); o_.z = pk2(sv[4][e_], sv[5][e_]); o_.w = pk2(sv[6][e_], sv[7][e_]); \
        *(GAS v4u*)(dp_ + 8 * e_) = o_; } (sd).it += (sd).stride; } while (0)

namespace att {
using s16x4  = __attribute__((ext_vector_type(4))) short;
using f32x16 = __attribute__((ext_vector_type(16))) float;
constexpr int KVBLK = 64;
constexpr float SCALE = 0.088388347648318440f;
constexpr float THR = 8.f;
constexpr int SHM_K = KVBLK * 128 * 2, SHM_V = KVBLK * 256 * 2;
constexpr int OFF_V = 0, OFF_K = 2 * SHM_V, OFF_WS = OFF_K + 2 * SHM_K, OFF_SSQ = OFF_WS + NWAVES * 256, ATT_LDS = OFF_SSQ + 128 * 2 * 4;
static_assert(ATT_LDS <= RING_BYTES, "attention LDS");
#define KSWZ(row, colB) ((row) * 256 + ((colB) ^ (((row) & 7) << 4)))
#define SBAR() __builtin_amdgcn_sched_barrier(0)
__device__ __forceinline__ int crow(int r, int hi) { return (r & 3) + 8 * (r >> 2) + 4 * hi; }
__device__ __forceinline__ unsigned cvtpk(float lo, float hi) { unsigned r; asm volatile("v_cvt_pk_bf16_f32 %0, %1, %2" : "=v"(r) : "v"(lo), "v"(hi)); return r; }

__device__ __forceinline__ void partialSM(f32x16& p0, f32x16& p1, float& m_reg, float& mn, float& alpha) {
  constexpr float C = SCALE * 1.4426950408889634f;
  float pmax = p0[0];
#pragma unroll
  for (int r = 1; r < 16; ++r) pmax = fmaxf(pmax, p0[r]);
#pragma unroll
  for (int r = 0; r < 16; ++r) pmax = fmaxf(pmax, p1[r]);
  { auto rr = __builtin_amdgcn_permlane32_swap(__float_as_uint(pmax), __float_as_uint(pmax), false, false);
    pmax = fmaxf(__uint_as_float(rr[0]), __uint_as_float(rr[1])); }
  if (__builtin_expect(__all(pmax - m_reg <= THR / SCALE), 1)) { mn = m_reg; alpha = 1.f; }
  else { mn = fmaxf(m_reg, pmax); alpha = __builtin_amdgcn_exp2f((m_reg - mn) * C); m_reg = mn; }
  float mnC = -mn * C;
#pragma unroll
  for (int r = 0; r < 16; ++r) p0[r] = fmaf(p0[r], C, mnC);
#pragma unroll
  for (int r = 0; r < 16; ++r) p1[r] = fmaf(p1[r], C, mnC);
#pragma unroll
  for (int r = 0; r < 16; ++r) p0[r] = __builtin_amdgcn_exp2f(p0[r]);
}
__device__ __forceinline__ void finishSM(f32x16& p0, f32x16& p1, float alpha, float& l_reg, bf16x8& pa0, bf16x8& pa1, bf16x8& pa2, bf16x8& pa3) {
#pragma unroll
  for (int r = 0; r < 16; ++r) p1[r] = __builtin_amdgcn_exp2f(p1[r]);
  float ps = 0;
#pragma unroll
  for (int r = 0; r < 16; ++r) ps += p0[r];
#pragma unroll
  for (int r = 0; r < 16; ++r) ps += p1[r];
  { auto rr = __builtin_amdgcn_permlane32_swap(__float_as_uint(ps), __float_as_uint(ps), false, false);
    ps = __uint_as_float(rr[0]) + __uint_as_float(rr[1]); }
  l_reg = l_reg * alpha + ps;
#define PK4(P, BASE, OUT) do { unsigned a0 = cvtpk(P[BASE + 0], P[BASE + 1]), a1 = cvtpk(P[BASE + 2], P[BASE + 3]);   \
    unsigned b0 = cvtpk(P[BASE + 4], P[BASE + 5]), b1 = cvtpk(P[BASE + 6], P[BASE + 7]);                              \
    auto r0 = __builtin_amdgcn_permlane32_swap(a0, b0, false, false); auto r1 = __builtin_amdgcn_permlane32_swap(a1, b1, false, false); \
    v4u w = {r0[0], r1[0], r0[1], r1[1]}; OUT = *reinterpret_cast<bf16x8*>(&w); } while (0)
  PK4(p0, 0, pa0); PK4(p0, 8, pa1); PK4(p1, 0, pa2); PK4(p1, 8, pa3);
#undef PK4
}
__device__ __forceinline__ void qkt(f32x16& p0, f32x16& p1, const LAS char* Ks, const bf16x8* qr, int r32, int hi) {
  p0 = f32x16{}; p1 = f32x16{};
#pragma unroll
  for (int d0 = 0; d0 < 8; ++d0) { int cb = (d0 * 16 + hi * 8) * 2;
    bf16x8 b0 = *reinterpret_cast<const LAS bf16x8*>(Ks + KSWZ(r32, cb));
    bf16x8 b1 = *reinterpret_cast<const LAS bf16x8*>(Ks + KSWZ(32 + r32, cb));
    p0 = __builtin_amdgcn_mfma_f32_32x32x16_bf16(b0, qr[d0], p0, 0, 0, 0);
    p1 = __builtin_amdgcn_mfma_f32_32x32x16_bf16(b1, qr[d0], p1, 0, 0, 0); }
}
__device__ __forceinline__ int v_st(int k, int c) { const int kk = (k & ~0xC) | ((k & 4) << 1) | ((k & 8) >> 1); return ((kk >> 3) * 4 + (c >> 5)) * 512 + ((kk & 7) * 32 + (c & 31)) * 2; }
__device__ __forceinline__ int v_rd_base(int lane) { return ((lane & 3) << 3) | (((lane >> 2) & 3) << 6) | (((lane >> 4) & 1) << 5) | (((lane >> 5) & 1) << 8); }
constexpr int v_rd_off(int d0, int ks, int half) { return d0 * 512 + ks * 4096 + half * 2048; }
template <int OFF> __device__ __forceinline__ s16x4 tr_read(int vb) {
  s16x4 r; asm volatile("ds_read_b64_tr_b16 %0, %1 offset:%2" : "=&v"(r) : "v"(vb), "i"(OFF) : "memory"); return r;
}
template <int D0> __device__ __forceinline__ void pv_one(f32x16& od, int vb, bf16x8 pa0, bf16x8 pa1, bf16x8 pa2, bf16x8 pa3) {
  const s16x4 l0 = tr_read<v_rd_off(D0, 0, 0)>(vb), h0 = tr_read<v_rd_off(D0, 0, 1)>(vb), l1 = tr_read<v_rd_off(D0, 1, 0)>(vb), h1 = tr_read<v_rd_off(D0, 1, 1)>(vb);
  const s16x4 l2 = tr_read<v_rd_off(D0, 2, 0)>(vb), h2 = tr_read<v_rd_off(D0, 2, 1)>(vb), l3 = tr_read<v_rd_off(D0, 3, 0)>(vb), h3 = tr_read<v_rd_off(D0, 3, 1)>(vb);
  asm volatile("s_waitcnt lgkmcnt(0)" ::: "memory"); SBAR();
#define PK(L, H) (bf16x8){L[0], L[1], L[2], L[3], H[0], H[1], H[2], H[3]}
  od = __builtin_amdgcn_mfma_f32_32x32x16_bf16(pa0, PK(l0, h0), od, 0, 0, 0);
  od = __builtin_amdgcn_mfma_f32_32x32x16_bf16(pa1, PK(l1, h1), od, 0, 0, 0);
  od = __builtin_amdgcn_mfma_f32_32x32x16_bf16(pa2, PK(l2, h2), od, 0, 0, 0);
  od = __builtin_amdgcn_mfma_f32_32x32x16_bf16(pa3, PK(l3, h3), od, 0, 0, 0);
#undef PK
}
__device__ __forceinline__ void pv_d0(f32x16* o, int vb, bf16x8 pa0, bf16x8 pa1, bf16x8 pa2, bf16x8 pa3) {
  pv_one<0>(o[0], vb, pa0, pa1, pa2, pa3); pv_one<1>(o[1], vb, pa0, pa1, pa2, pa3); pv_one<2>(o[2], vb, pa0, pa1, pa2, pa3); pv_one<3>(o[3], vb, pa0, pa1, pa2, pa3);
}

__device__ __forceinline__ void attn_unit(const bf16* Qp, const bf16* Kp, const bf16* V0p, int nself, const bf16* V1p, int nkeys, bf16* Op,
                                          float* park, const float* subln_g, float lam, float oscale, LAS char* lds, SideJob& sd) {
  int tid_l = threadIdx.x; asm volatile("" : "+v"(tid_l));
  const int tid = tid_l, wid = __builtin_amdgcn_readfirstlane(tid >> 6), lane = tid & 63, r32 = lane & 31, hi = lane >> 5, rg = wid >> 1, e = wid & 1;
  LAS char* V_lds = lds + OFF_V; LAS char* K_lds = lds + OFF_K;
  LAS float* wsf = (LAS float*)(lds + OFF_WS) + wid * 64; LAS float* li_l = wsf; LAS float* al_l = wsf + 32;
  LAS float* ssq = (LAS float*)(lds + OFF_SSQ);
  const int sr = tid >> 4, sc = (tid & 15) * 8, vst0 = v_st(sr, sc), vst1 = v_st(32 + sr, sc);
  const int vb0 = (int)(unsigned)(uintptr_t)(V_lds + e * (SHM_V / 2)) + v_rd_base(lane);
  const int NT = nkeys / KVBLK;
  const unsigned voS = (unsigned)(sr * LDP + sc), voC = (unsigned)(sr * DATT + sc);
  f32x16 o[4];
  float rli[16];
  for (int c = 0; c < 2; ++c) {
    float m_reg = -1e30f, l_reg = 0;
#pragma unroll
    for (int d = 0; d < 4; ++d) o[d] = f32x16{};
    bf16x8 qr[8];
    { const bf16* Qw = Qp + (size_t)(rg * 32 + r32) * DATT + c * 128 + hi * 8;
#pragma unroll
      for (int d0 = 0; d0 < 8; ++d0) qr[d0] = *(const GAS bf16x8*)(Qw + d0 * 16); }
    const bf16* Kh = Kp + c * 128;
    bf16x8 vs0, vs1, vs2, vs3, ks0, ks1;
#define SLOAD(k0) do { const int kk_ = (k0); const bool self_ = kk_ < nself; \
    const bf16* vu_ = self_ ? V0p + (size_t)kk_ * LDP : V1p + (size_t)(kk_ - nself) * DATT; const unsigned vo_ = self_ ? voS : voC, vst_ = self_ ? 32u * LDP : 32u * DATT; \
    vs0 = *(const GAS bf16x8*)(vu_ + vo_); vs1 = *(const GAS bf16x8*)(vu_ + (vo_ + 128u)); vs2 = *(const GAS bf16x8*)(vu_ + (vo_ + vst_)); vs3 = *(const GAS bf16x8*)(vu_ + (vo_ + vst_ + 128u)); \
    const bf16* ku_ = Kh + (size_t)kk_ * DATT; ks0 = *(const GAS bf16x8*)(ku_ + voC); ks1 = *(const GAS bf16x8*)(ku_ + (voC + 32u * DATT)); } while (0)
#define SWRITE(b) do { LAS char* vb_ = V_lds + (b) * SHM_V; LAS char* kb_ = K_lds + (b) * SHM_K; const int kc = sc * 2; \
    *(LAS bf16x8*)(vb_ + vst0) = vs0; *(LAS bf16x8*)(vb_ + SHM_V / 2 + vst0) = vs1; *(LAS bf16x8*)(vb_ + vst1) = vs2; *(LAS bf16x8*)(vb_ + SHM_V / 2 + vst1) = vs3; \
    *(LAS bf16x8*)(kb_ + KSWZ(sr, kc)) = ks0; *(LAS bf16x8*)(kb_ + KSWZ(32 + sr, kc)) = ks1; } while (0)
#define SWAIT() asm volatile("s_waitcnt vmcnt(0)" ::: "memory")
#define RESC(a) do { if (__any((a) < 1.f)) { if (hi == 0) al_l[r32] = (a); asm volatile("s_waitcnt lgkmcnt(0)" ::: "memory"); \
    _Pragma("unroll") for (int d = 0; d < 4; ++d) _Pragma("unroll") for (int r = 0; r < 16; ++r) o[d][r] *= al_l[crow(r, hi)]; } } while (0)
    f32x16 p0, p1; float mn, al; bf16x8 pa0, pa1, pa2, pa3;
    __syncthreads();
    SLOAD(0); SWAIT(); SWRITE(0); __syncthreads();
    for (int j = 0; j < NT; ++j) {
      const int buf = j & 1; const bool more = j + 1 < NT;
      if (more) SLOAD((j + 1) * KVBLK);
      const bool side = SIDE_W2 && more && sd.it < sd.end; f32x2 sv[8];
      if (side) SIDE_LOAD(sd, sv, lane);
      SBAR(); qkt(p0, p1, K_lds + buf * SHM_K, qr, r32, hi);
      partialSM(p0, p1, m_reg, mn, al);
      RESC(al);
      finishSM(p0, p1, al, l_reg, pa0, pa1, pa2, pa3); SBAR();
      pv_d0(o, vb0 + buf * SHM_V, pa0, pa1, pa2, pa3);
      if (more) { SWAIT(); SWRITE(buf ^ 1); }
      if (side) SIDE_STORE(sd, sv, lane);
      __syncthreads();
    }
#undef SLOAD
#undef SWRITE
#undef SWAIT
#undef RESC
    int hi_ = hi, r32_ = r32, wid_ = wid; asm volatile("" : "+v"(hi_), "+v"(r32_), "+s"(wid_));
    LAS float* li2 = (LAS float*)(lds + OFF_WS) + wid_ * 64;
    if (hi_ == 0) li2[r32_] = l_reg; asm volatile("s_waitcnt lgkmcnt(0)" ::: "memory");
#pragma unroll
    for (int r = 0; r < 16; ++r) rli[r] = __builtin_amdgcn_rcpf(li2[crow(r, hi_)]);
    if (c == 0) {
      float* pk = park + (size_t)wid_ * 4096 + (hi_ * 32 + r32_);
#pragma unroll
      for (int d = 0; d < 4; ++d)
#pragma unroll
        for (int r = 0; r < 16; ++r) pk[(d * 16 + r) * 64] = o[d][r] * rli[r];
    }
  }
  int hi_ = hi, r32_ = r32, wid_ = wid; asm volatile("" : "+v"(hi_), "+v"(r32_), "+s"(wid_));
  const int rg_ = wid_ >> 1, e_ = wid_ & 1;
  const float* pk = park + (size_t)wid_ * 4096 + (hi_ * 32 + r32_);
  asm volatile("s_waitcnt vmcnt(0)" ::: "memory");
  float q[16];
#pragma unroll
  for (int r = 0; r < 16; ++r) q[r] = 0.f;
#pragma unroll
  for (int d = 0; d < 4; ++d) {
#pragma unroll
    for (int r = 0; r < 16; ++r) { const float v = pk[(d * 16 + r) * 64] - lam * (o[d][r] * rli[r]); o[d][r] = v; q[r] += v * v; }
    asm volatile("" ::: "memory"); }
#pragma unroll
  for (int r = 0; r < 16; ++r) { float s = q[r]; s += __shfl_xor(s, 1); s += __shfl_xor(s, 2); s += __shfl_xor(s, 4); s += __shfl_xor(s, 8); s += __shfl_xor(s, 16); q[r] = s; }
  if (r32_ == 0) {
#pragma unroll
    for (int r = 0; r < 16; ++r) ssq[(rg_ * 32 + crow(r, hi_)) * 2 + e_] = q[r];
  }
  __syncthreads();
  float g4[4];
#pragma unroll
  for (int d = 0; d < 4; ++d) g4[d] = subln_g[e_ * 128 + d * 32 + r32_] * oscale;
  bf16* ob = Op + (size_t)(rg_ * 32 + 4 * hi_) * LDX + e_ * 128 + r32_;
  const LAS float* sq = ssq + (rg_ * 32 + 4 * hi_) * 2;
#pragma unroll
  for (int r = 0; r < 16; ++r) { const int rr = (r & 3) + 8 * (r >> 2); const float tot = sq[rr * 2] + sq[rr * 2 + 1]; const float rstd = __builtin_amdgcn_rsqf(tot * (1.f / 256.f) + EPS);
    bf16* orow = ob + (size_t)rr * LDX;
#pragma unroll
    for (int d = 0; d < 4; ++d) { const unsigned w = cvtpk(o[d][r] * rstd * g4[d], 0.f); orow[d * 32] = (bf16)(w & 0xffffu); } }
}
#undef KSWZ
#undef SBAR
}

__device__ __forceinline__ void attention_phase(Frame& F) {
    RELAUNDER(F);
    const float d1 = wave_sum(F.lq1[F.lane] * F.lk1[F.lane] + F.lq1[F.lane + 64] * F.lk1[F.lane + 64]);
    const float d2 = wave_sum(F.lq2[F.lane] * F.lk2[F.lane] + F.lq2[F.lane + 64] * F.lk2[F.lane + 64]);
    const float lam_init = 0.2f; const float lam = __expf(d1) - __expf(d2) + lam_init; const float oscale = 1.f - lam_init;
    float* park = F.PARK + (size_t)blockIdx.x * (NWAVES * 4096);
    LAS char* lds = (LAS char*)(F.lds + RING_OFF);
    SideJob sd{F.w_mlp_out, F.W2_t, F.w_out, F.Wout_t, F.vcu * NWAVES + F.wave, SIDE_W2 ? SIDE_END : 0, F.G * NWAVES};
    for (int idx = F.vcu; idx < 768; idx += F.G) {
        const bool lat = idx < 256; const int u = lat ? idx : idx - 256;
        const int b = lat ? (u >> 6) : (u >> 4), h = lat ? ((u >> 3) & 7) : ((u >> 1) & 7), qb = lat ? (u & 7) : (u & 1);
        const int m0 = lat ? M_CTX + b * LAT_SEQ : b * CTX_SEQ; const int k0row = lat ? M_CTX + b * KV_LAT : m0;
        att::attn_unit(F.QB + (size_t)(m0 + qb * 128) * DATT + h * 256, F.KB + (size_t)k0row * DATT + h * 256,
                       F.PROJ + (size_t)m0 * LDP + 2 * DATT + h * 256, lat ? LAT_SEQ : CTX_SEQ, F.CV + (size_t)(b & 3) * PAST * DATT + h * 256, lat ? KV_LAT : CTX_SEQ,
                       F.MIX + (size_t)(m0 + qb * 128) * LDX + h * 256, park, F.subln_g, lam, oscale, lds, sd);
    }
    RELAUNDER(F);
    while (sd.it < sd.end) { f32x2 sv[8]; SIDE_LOAD(sd, sv, F.lane); SIDE_STORE(sd, sv, F.lane); }
}

struct Args { const float* in[22]; float* out; unsigned char* ws; int ph_lo, ph_hi; };
__global__ void __launch_bounds__(NWAVES * 64, 2) mk_fwd(Args args) {
    extern __shared__ __attribute__((aligned(16))) unsigned char lds[];
    Frame F;
    F.lds = (LAS unsigned char*)lds;
    F.MISC = (volatile LAS unsigned*)(F.lds + MISC_OFF);
    F.tid = threadIdx.x; F.lane = F.tid & 63; F.wave = __builtin_amdgcn_readfirstlane(F.tid >> 6);
    F.G = gridDim.x; { const int bx = blockIdx.x; F.vcu = (F.G % 8 == 0) ? (bx % 8) * (F.G / 8) + bx / 8 : bx; }
    unsigned char* ws = args.ws;
    F.ctl = (gu32*)(ws + WS_CTL);
    F.x_prompt = args.in[0]; F.x_sample = args.in[1]; F.cache_k = args.in[2]; F.cache_v = args.in[3]; F.c = args.in[4]; F.c_ctx = args.in[5];
    F.w_ada = args.in[6]; F.b_ada = args.in[7]; F.norm_attn_g = args.in[8]; F.w_in = args.in[9]; F.q_norm_g = args.in[10]; F.k_norm_g = args.in[11];
    F.lq1 = args.in[12]; F.lk1 = args.in[13]; F.lq2 = args.in[14]; F.lk2 = args.in[15]; F.subln_g = args.in[16]; F.conv_w = args.in[17];
    F.w_out = args.in[18]; F.norm_mlp_g = args.in[19]; F.w_mlp_in = args.in[20]; F.w_mlp_out = args.in[21];
    F.out = args.out;
    F.MOD = (float*)(ws + WS_MOD); F.PARK = (float*)(ws + WS_PARK);
    F.Win_t = (bf16*)(ws + WS_WIN); F.Wout_t = (bf16*)(ws + WS_WOUT); F.W1_t = (bf16*)(ws + WS_W1); F.W2_t = (bf16*)(ws + WS_W2);
    F.XN = (bf16*)(ws + WS_XN); F.CV = (bf16*)(ws + WS_CV); F.PROJ = (bf16*)(ws + WS_PROJ); F.QB = (bf16*)(ws + WS_QB); F.KB = (bf16*)(ws + WS_KB);
    F.MIX = (bf16*)(ws + WS_MIX); F.HB = (bf16*)(ws + WS_H); F.X1B = (bf16*)(ws + WS_X1B);
    for (int u = F.tid; u < (LDS_BYTES - LDSCTL_OFF) / 4; u += NWAVES * 64) ((LAS unsigned*)(F.lds + LDSCTL_OFF))[u] = 0u;
    __syncthreads();
    XcdBarrier bar; bar.bar = (unsigned*)(F.ctl + CW_BAR); bar.x = 0; bar.st = nullptr;
    if (N_LAUNCHES == 1) bar = xcd_barrier_post((unsigned*)(F.ctl + CW_BAR), F.MISC + 8);
#define GRID_BAR(seam) do { if (N_LAUNCHES == 1) { xcd_barrier(bar); } } while (0)
    const int lo = args.ph_lo, hi = args.ph_hi;
#ifndef PH_MASK
#define PH_MASK 0x1ff
#endif
#define IN(k) (((PH_MASK >> (k)) & 1) && lo <= (k) && (k) < hi)
#define BOTH(k) (IN(k) && IN((k) + 1))
#define XS_SETUP(S_, gi_) do { (S_).ctr = (unsigned*)(F.ctl + CW_XS) + 64 * (16 * (gi_) + (int)bar.x); (S_).k = 0u; (S_).nloc = (N_LAUNCHES == 1 && lo == 0 && (S_).nwg % F.G == 0) ? F.MISC[8] : 0u; } while (0)
#ifndef PROBE_DUP
#define PROBE_DUP 0
#ifndef PROBE_GROUPED
#define PROBE_GROUPED 1
#endif
#endif
#define DUP(k) ((PROBE_DUP >> (k)) & 1)

    if (IN(0)) { p0_gemv(F); if (DUP(10)) { __syncthreads(); p0_gemv(F); } if (BOTH(0)) GRID_BAR(0); }
    if (IN(1)) { p0_weights<0>(F); norm_mod_phase<0>(F); if (DUP(1)) { __syncthreads(); norm_mod_phase<0>(F); } if (BOTH(1)) GRID_BAR(1); }
    if (IN(2)) {
        pg8::Gemm g{F.XN, F.Win_t, MTOT, NPROJ, DM, LDX, NPROJ + OPAD}; pg8::XcdSyncOrder S; S.init(MTOT, NPROJ, F.G, (int)blockIdx.x); S.grouped = (F.G == 256 && PROBE_GROUPED) ? 1 : 0; XS_SETUP(S, 0);
        pg8::EpiBf16<0> E{F.PROJ, LDP};
        pg8::gemm_phase<pg8::EpiBf16<0>, pg8::XcdSyncOrder, PG8_ALIGN, PG8_SP2>(F.lds + RING_OFF, g, S, E);
        if (DUP(2)) { __syncthreads(); pg8::gemm_phase<pg8::EpiBf16<0>, pg8::XcdSyncOrder, PG8_ALIGN, PG8_SP2>(F.lds + RING_OFF, g, S, E); }
        if (DUP(9)) { __syncthreads(); pg8::EpiNull EN; pg8::gemm_phase<pg8::EpiNull, pg8::XcdSyncOrder, PG8_ALIGN, PG8_SP2>(F.lds + RING_OFF, g, S, EN); }
        if (BOTH(2)) GRID_BAR(2);
    }
    if (IN(3)) { post_proj_phase(F); if (DUP(3)) { __syncthreads(); post_proj_phase(F); } if (BOTH(3)) GRID_BAR(3); }
    if (IN(4)) { attention_phase(F); if (!SIDE_W2) p0_weights<1>(F); if (DUP(4)) { __syncthreads(); attention_phase(F); } if (BOTH(4)) GRID_BAR(4); }
    if (IN(5)) {
        pg8::Gemm g{F.MIX, F.Wout_t, MTOT, DM, DM, LDX, DM + OPAD}; pg8::XcdSyncOrder S; S.init(MTOT, DM, F.G, (int)blockIdx.x); S.grouped = (F.G == 256 && PROBE_GROUPED) ? 1 : 0; XS_SETUP(S, 1);
        pg8::EpiRes1 E{F.x_prompt, F.x_sample, F.X1B, LDX, F.MOD + 2 * DM};
        pg8::gemm_phase<pg8::EpiRes1, pg8::XcdSyncOrder, PG8_ALIGN, PG8_SP2>(F.lds + RING_OFF, g, S, E);
        if (DUP(5)) { __syncthreads(); pg8::gemm_phase<pg8::EpiRes1, pg8::XcdSyncOrder, PG8_ALIGN, PG8_SP2>(F.lds + RING_OFF, g, S, E); }
        if (BOTH(5)) GRID_BAR(5);
    }
    if (IN(6)) { p0_weights<2>(F); norm_mod_phase<1>(F); if (DUP(6)) { __syncthreads(); norm_mod_phase<1>(F); } if (BOTH(6)) GRID_BAR(6); }
    if (IN(7)) {
#if defined(PROBE_IDLE_US)
        { const unsigned long long t0 = __builtin_amdgcn_s_memrealtime(); while (__builtin_amdgcn_s_memrealtime() - t0 < 100ull * PROBE_IDLE_US) __builtin_amdgcn_s_sleep(32); }
#endif
        pg8::Gemm g{F.XN, F.W1_t, MTOT, DFF, DM, LDX, DFF + OPAD}; pg8::XcdSyncOrder S; S.init(MTOT, DFF, F.G, (int)blockIdx.x); S.grouped = (F.G == 256 && PROBE_GROUPED) ? 2 : 0; XS_SETUP(S, 2);
        pg8::EpiBf16<1> E{F.HB, LDH};
        pg8::gemm_phase<pg8::EpiBf16<1>, pg8::XcdSyncOrder, PG8_ALIGN, PG8_SP2>(F.lds + RING_OFF, g, S, E);
        if (DUP(7)) { __syncthreads(); pg8::gemm_phase<pg8::EpiBf16<1>, pg8::XcdSyncOrder, PG8_ALIGN, PG8_SP2>(F.lds + RING_OFF, g, S, E); }
        if (BOTH(7)) GRID_BAR(7);
    }
    if (IN(8)) {
        pg8::Gemm g{F.HB, F.W2_t, MTOT, DM, DFF, LDH, DM + OPAD}; pg8::XcdSyncOrder S; S.init(MTOT, DM, F.G, (int)blockIdx.x); S.grouped = (F.G == 256 && PROBE_GROUPED) ? 1 : 0; XS_SETUP(S, 3);
        pg8::EpiRes2 E{F.X1B, LDX, F.out, F.MOD + 5 * DM};
        pg8::gemm_phase<pg8::EpiRes2, pg8::XcdSyncOrder, PG8_ALIGN, PG8_SP2>(F.lds + RING_OFF, g, S, E);
        if (DUP(8)) { __syncthreads(); pg8::gemm_phase<pg8::EpiRes2, pg8::XcdSyncOrder, PG8_ALIGN, PG8_SP2>(F.lds + RING_OFF, g, S, E); }
    }
#undef IN
#undef BOTH
}

extern "C" void kernel_launch(void* const* d_in, const int* in_sizes, int n_in, void* d_out, int out_size, void* d_ws, size_t ws_size, hipStream_t stream) {
    static int grid = 0;
    if (grid == 0) {
        if (n_in != 22 || ws_size < WS_END) { fprintf(stderr, "kernel_launch: expected 22 inputs and >= %zu bytes of workspace; got n_in %d, ws %zu; nothing launched\n", (size_t)WS_END, n_in, ws_size); grid = -1; return; }
        int dev = 0, cus = 0, per_cu = 0;
        if (hipGetDevice(&dev) != hipSuccess || hipDeviceGetAttribute(&cus, hipDeviceAttributeMultiprocessorCount, dev) != hipSuccess) { grid = -1; return; }
        if (hipFuncSetAttribute((const void*)mk_fwd, hipFuncAttributeMaxDynamicSharedMemorySize, LDS_BYTES) != hipSuccess) { fprintf(stderr, "kernel_launch: hipFuncSetAttribute failed\n"); grid = -1; return; }
        if (hipOccupancyMaxActiveBlocksPerMultiprocessor(&per_cu, (const void*)mk_fwd, NWAVES * 64, LDS_BYTES) != hipSuccess || per_cu < 1)
            fprintf(stderr, "kernel_launch: note: occupancy query reports %d workgroups per CU\n", per_cu);
        (void)hipGetLastError();
        grid = cus;
    }
    if (grid < 0) return;
    if (hipMemsetAsync((char*)d_ws + WS_CTL, 0, CTL_ZERO_BYTES, stream) != hipSuccess) { fprintf(stderr, "kernel_launch: memset failed\n"); return; }
    Args a{};
    for (int i = 0; i < 22; ++i) a.in[i] = (const float*)d_in[i];
    a.out = (float*)d_out; a.ws = (unsigned char*)d_ws;
    for (int li = 0; li < N_LAUNCHES; ++li) {
        a.ph_lo = (N_LAUNCHES == 1) ? 0 : li; a.ph_hi = (N_LAUNCHES == 1) ? N_PHASES : li + 1;
        hipLaunchKernelGGL(mk_fwd, dim3(grid), dim3(NWAVES * 64), LDS_BYTES, stream, a);
        const hipError_t le = hipPeekAtLastError();
        if (le != hipSuccess) { fprintf(stderr, "kernel_launch: launch %d failed: %s\n", li, hipGetErrorName(le)); break; }
    }
}
```
